# Optimizing an MI355X kernel written in HIP

```python
import math
import jax
import jax.numpy as jnp
from jax import lax
import numpy as np

D_MODEL = 1024
BATCH = 1
SEQ = 16384
DEPTH = 4

GRID_W = 64
CTX_LEN = 256
N_BRANCH = 3
BRANCH_WIDTH = 512
EPS = 1e-6

LRU_WIDTH = 512
LRU_HEADS = 8
LRU_HEAD_DIM = LRU_WIDTH // LRU_HEADS
LRU_C = 8.0
CONV_W = 4
CONV_LEFT = 2
CONV_RIGHT = CONV_W - 1 - CONV_LEFT

RWKV_WIDTH = 512
RWKV_HEAD_DIM = 64
RWKV_HEADS = RWKV_WIDTH // RWKV_HEAD_DIM
DECAY_LORA = 64
ICLR_LORA = 64
GATE_LORA = 128
RWKV_IN = 3 * RWKV_WIDTH + 2 * DECAY_LORA + 2 * ICLR_LORA + GATE_LORA
RWKV_GN_EPS = 64e-5

S5_WIDTH = 512
S5_GROUP = 16
S5_GROUPS = S5_WIDTH // S5_GROUP
S5_STATE = 64

N_IN = 2 * LRU_WIDTH + RWKV_IN + S5_WIDTH + N_BRANCH * D_MODEL

FFN_HIDDEN = -(-8 * D_MODEL // (3 * 256)) * 256

kernel_name = 'hybrid_rglru_rwkv7_s5_prefix_ctx_dit'


def rms_norm(x, g):
    xf = x.astype(jnp.float32)
    y = xf * lax.rsqrt(jnp.mean(xf * xf, axis=-1, keepdims=True) + EPS)
    return (y * g.astype(jnp.float32)).astype(x.dtype)


def modulate(xn, shift, scale):
    return xn * (1.0 + scale) + shift


def to_col_major(t, rows):
    b, l, ch = t.shape
    return t.reshape(b, rows, GRID_W, ch).transpose(0, 2, 1, 3).reshape(b, l, ch)


def to_raster(t, rows):
    b, l, ch = t.shape
    return t.reshape(b, GRID_W, rows, ch).transpose(0, 2, 1, 3).reshape(b, l, ch)


def conv_centred(x, w, bias):
    l = x.shape[1]
    xp = jnp.pad(x, ((0, 0), (CONV_LEFT, CONV_RIGHT), (0, 0)))
    out = bias + w[0] * xp[:, 0:l]
    for j in range(1, CONV_W):
        out = out + w[j] * xp[:, j:j + l]
    return out


def _lin_combine(e1, e2):
    a1, b1 = e1
    a2, b2 = e2
    return a1 * a2, a2 * b1 + b2


def linear_scan(a, b, h0, reverse):
    j = -1 if reverse else 0
    b = b.at[:, j].add(a[:, j] * h0)
    _, h = lax.associative_scan(_lin_combine, (a, b), reverse=reverse, axis=1)
    return h, h[:, 0] if reverse else h[:, -1]


def _complex_combine(e1, e2):
    ar1, ai1, br1, bi1 = e1
    ar2, ai2, br2, bi2 = e2
    return (ar2 * ar1 - ai2 * ai1, ar2 * ai1 + ai2 * ar1,
            ar2 * br1 - ai2 * bi1 + br2, ar2 * bi1 + ai2 * br1 + bi2)


def complex_linear_scan(a_re, a_im, b_re, b_im, h0_re, h0_im, reverse):
    j = -1 if reverse else 0
    b_re = b_re.at[:, j].add(a_re[:, j] * h0_re - a_im[:, j] * h0_im)
    b_im = b_im.at[:, j].add(a_re[:, j] * h0_im + a_im[:, j] * h0_re)
    _, _, h_re, h_im = lax.associative_scan(_complex_combine, (a_re, a_im, b_re, b_im), reverse=reverse, axis=1)
    k = 0 if reverse else -1
    return h_re, h_im, h_re[:, k], h_im[:, k]


def rglru_direction(xc, w_a, b_a, w_x, b_x, lam, h0, reverse):
    b, l, _ = xc.shape
    xh = xc.reshape(b, l, LRU_HEADS, LRU_HEAD_DIM)
    gate_r = jax.nn.sigmoid(jnp.einsum('blhi,hij->blhj', xh, w_a).reshape(b, l, LRU_WIDTH) + b_a)
    gate_i = jax.nn.sigmoid(jnp.einsum('blhi,hij->blhj', xh, w_x).reshape(b, l, LRU_WIDTH) + b_x)
    log_a = -LRU_C * gate_r * jax.nn.softplus(-lam)
    a = jnp.exp(log_a)
    u = jnp.sqrt(-jnp.expm1(2.0 * log_a)) * (gate_i * xc)
    return linear_scan(a, u, h0, reverse)


def mixer_rglru(xa, ga, conv_w, conv_b, w_a, b_a, w_x, b_x, lam, h0):
    xc = conv_centred(xa, conv_w, conv_b)
    hs, fins = [], []
    for d in range(2):
        h, f = rglru_direction(xc, w_a[d], b_a[d], w_x[d], b_x[d], lam[d], h0[d], d == 1)
        hs.append(h)
        fins.append(f)
    return jax.nn.gelu(ga) * (hs[0] + hs[1]), jnp.stack(fins)


def token_shift(z, mu):
    zp = jnp.pad(z, ((0, 0), (1, 1), (0, 0)))
    return z + mu * (0.5 * (zp[:, :-2] + zp[:, 2:]) - z)


def wkv7_scan(r, w, k, v, kk, iclr, s0, reverse):
    def step(s, inp):
        r_t, w_t, k_t, v_t, kk_t, a_t = inp
        sa = jnp.einsum('bhvk,bhk->bhv', s, kk_t)
        s = (s * w_t[:, :, None, :] - sa[..., None] * (kk_t * a_t)[:, :, None, :]
             + v_t[..., None] * k_t[:, :, None, :])
        return s, jnp.einsum('bhvk,bhk->bhv', s, r_t)
    xs = tuple(jnp.moveaxis(t, 1, 0) for t in (r, w, k, v, kk, iclr))
    s_fin, y = lax.scan(step, s0, xs, reverse=reverse)
    return jnp.moveaxis(y, 0, 1), s_fin


def mixer_rwkv7(zb, mu, w0, w2, a0, a2, g2, k_k, k_a, r_k, ln_w, ln_b, s0):
    b, l, _ = zb.shape
    zb = token_shift(zb, mu)
    wdt = RWKV_WIDTH
    r, k, v, wd, ad, gd = jnp.split(
        zb, [wdt, 2 * wdt, 3 * wdt, 3 * wdt + 2 * DECAY_LORA, 3 * wdt + 2 * DECAY_LORA + 2 * ICLR_LORA], axis=-1)

    def heads(t):
        return t.reshape(b, l, RWKV_HEADS, RWKV_HEAD_DIM)

    kk = heads(k * k_k)
    kk = kk * lax.rsqrt(jnp.sum(kk * kk, axis=-1, keepdims=True) + 1e-12)
    r_h, v_h = heads(r), heads(v)
    wd = wd.reshape(b, l, 2, DECAY_LORA)
    ad = ad.reshape(b, l, 2, ICLR_LORA)
    ys, bonuses, fins = [], [], []
    for d in range(2):
        w_log = -jax.nn.softplus(-(w0[d] + jnp.tanh(wd[:, :, d]) @ w2[d])) - 0.5
        decay = jnp.exp(-jnp.exp(w_log))
        iclr = jax.nn.sigmoid(a0[d] + ad[:, :, d] @ a2[d])
        k_d = heads(k * (1.0 + (iclr - 1.0) * k_a))
        y_d, s_d = wkv7_scan(r_h, heads(decay), k_d, v_h, kk, heads(iclr), s0[d], d == 1)
        ys.append(y_d)
        bonuses.append(jnp.sum(r_h * k_d * r_k, axis=-1, keepdims=True) * v_h)
        fins.append(s_d)
    y = ys[0] + ys[1]
    mean = jnp.mean(y, axis=-1, keepdims=True)
    var = jnp.mean(jnp.square(y - mean), axis=-1, keepdims=True)
    y = ((y - mean) * lax.rsqrt(var + RWKV_GN_EPS)).reshape(b, l, wdt) * ln_w + ln_b
    y = y + (bonuses[0] + bonuses[1]).reshape(b, l, wdt)
    g = jax.nn.sigmoid(gd) @ g2
    return y * g, jnp.stack(fins)


def s5_direction(u, lam_re, lam_im, log_step, b_re, b_im, c_re, c_im, h0_re, h0_im, reverse):
    step = jnp.exp(log_step)[:, None]
    x_re, ang = lam_re * step, lam_im * step
    mag = jnp.exp(x_re)
    lb_re, lb_im = mag * jnp.cos(ang), mag * jnp.sin(ang)
    nr = jnp.expm1(x_re) * jnp.cos(ang) - 2.0 * jnp.square(jnp.sin(0.5 * ang))
    den = lam_re * lam_re + lam_im * lam_im
    f_re = (nr * lam_re + lb_im * lam_im) / den
    f_im = (lb_im * lam_re - nr * lam_im) / den
    bb_re = f_re[..., None] * b_re - f_im[..., None] * b_im
    bb_im = f_re[..., None] * b_im + f_im[..., None] * b_re
    bu_re = jnp.einsum('blgc,gpc->blgp', u, bb_re)
    bu_im = jnp.einsum('blgc,gpc->blgp', u, bb_im)
    a_re = jnp.broadcast_to(lb_re, bu_re.shape)
    a_im = jnp.broadcast_to(lb_im, bu_im.shape)
    h_re, h_im, fin_re, fin_im = complex_linear_scan(a_re, a_im, bu_re, bu_im, h0_re, h0_im, reverse)
    y = jnp.einsum('blgp,gcp->blgc', h_re, c_re) - jnp.einsum('blgp,gcp->blgc', h_im, c_im)
    return y, jnp.stack([fin_re, fin_im])


def mixer_s5(u, lam_re, lam_im, log_step, b_re, b_im, c_re, c_im, d_skip, w_glu, b_glu, h0):
    b, l, _ = u.shape
    ug = u.reshape(b, l, S5_GROUPS, S5_GROUP)
    ys, fins = [], []
    for d in range(2):
        y_d, f_d = s5_direction(ug, lam_re[d], lam_im[d], log_step[d], b_re[d], b_im[d],
                                c_re[d], c_im[d], h0[d, 0], h0[d, 1], d == 1)
        ys.append(y_d)
        fins.append(f_d)
    y = jax.nn.gelu((ys[0] + ys[1]).reshape(b, l, S5_WIDTH) + d_skip * u)
    return y * jax.nn.sigmoid(y @ w_glu + b_glu), jnp.stack(fins)


def token_mixers(z, lp, h_lru, s_rwkv, h_s5, rows):
    z = z.astype(jnp.float32)
    o1 = LRU_WIDTH
    o2 = 2 * LRU_WIDTH
    o3 = o2 + RWKV_IN
    o4 = o3 + S5_WIDTH
    xa, ga, zb, uc, zg = jnp.split(z, [o1, o2, o3, o4], axis=-1)
    y_a, fin_lru = mixer_rglru(xa, ga, lp['lru_conv_w'], lp['lru_conv_b'], lp['lru_wa'], lp['lru_ba'],
                               lp['lru_wx'], lp['lru_bx'], lp['lru_lam'], h_lru)
    y_b, fin_rwkv = mixer_rwkv7(zb, lp['rwkv_mu'], lp['rwkv_w0'], lp['rwkv_w2'], lp['rwkv_a0'], lp['rwkv_a2'],
                                lp['rwkv_g2'], lp['rwkv_kk'], lp['rwkv_ka'], lp['rwkv_rk'],
                                lp['rwkv_lnw'], lp['rwkv_lnb'], s_rwkv)
    if rows is not None:
        uc = to_col_major(uc, rows)
    y_c, fin_s5 = mixer_s5(uc, lp['s5_lam_re'], lp['s5_lam_im'], lp['s5_log_step'], lp['s5_b_re'],
                           lp['s5_b_im'], lp['s5_c_re'], lp['s5_c_im'], lp['s5_d'], lp['s5_w_glu'],
                           lp['s5_b_glu'], h_s5)
    if rows is not None:
        y_c = to_raster(y_c, rows)
    ys = jnp.stack([y_a, y_b, y_c], axis=2)
    return ys, zg, (fin_lru, fin_rwkv, fin_s5)


def merge_project(ys, zg, w_branch, w_out):
    b, l = ys.shape[:2]
    g = jax.nn.sigmoid(zg).reshape(b, l, N_BRANCH, D_MODEL)
    proj = jnp.einsum('blkw,kwd->blkd', ys, w_branch)
    return jnp.sum(g * proj, axis=2) @ w_out


def swiglu(xn, w_in, w_out):
    gate, up = jnp.split(xn @ w_in, 2, axis=-1)
    return (jax.nn.silu(gate) * up) @ w_out


def setup_inputs(seed: int = 0) -> dict:
    key = jax.random.key(seed)
    keys = iter(jax.random.split(key, 64))
    f32 = jnp.float32

    def nrm(shape, scale):
        return jax.random.normal(next(keys), shape, f32) * scale

    def gain(shape):
        return 1.0 + nrm(shape, 0.02)

    s = jax.random.uniform(next(keys), (DEPTH, 2, LRU_WIDTH), f32, 0.9, 0.999) ** (1.0 / LRU_C)
    lru_lam = jnp.log(s) - jnp.log1p(-s)
    rwkv_w0 = jnp.linspace(-6.0, -1.0, RWKV_WIDTH, dtype=f32) + nrm((DEPTH, 2, RWKV_WIDTH), 0.1)
    s5_shape = (DEPTH, 2, S5_GROUPS, S5_STATE)
    s5_lam_re = -0.5 + nrm(s5_shape, 0.01)
    s5_lam_im = math.pi * jnp.arange(S5_STATE, dtype=f32) + nrm(s5_shape, 0.01)
    s5_log_step = jax.random.uniform(next(keys), (DEPTH, 2, S5_GROUPS), f32, math.log(1e-3), math.log(1e-1))
    blk = (DEPTH, 2, LRU_HEADS, LRU_HEAD_DIM, LRU_HEAD_DIM)
    return {
        'x': nrm((BATCH, SEQ, D_MODEL), 1.0),
        'c': nrm((BATCH, D_MODEL), 1.0),
        'ctx': nrm((BATCH, CTX_LEN, D_MODEL), 1.0),
        'c_ctx': nrm((D_MODEL,), 1.0),
        'w_mod': nrm((DEPTH, D_MODEL, 6 * D_MODEL), 0.5 * D_MODEL ** -0.5),
        'b_mod': nrm((DEPTH, 6 * D_MODEL), 0.02),
        'norm1': gain((DEPTH, D_MODEL)),
        'norm2': gain((DEPTH, D_MODEL)),
        'norm_f': gain((D_MODEL,)),
        'w_in': nrm((DEPTH, D_MODEL, N_IN), D_MODEL ** -0.5),
        'lru_conv_w': nrm((DEPTH, CONV_W, LRU_WIDTH), CONV_W ** -0.5),
        'lru_conv_b': nrm((DEPTH, LRU_WIDTH), 0.02),
        'lru_wa': nrm(blk, LRU_HEAD_DIM ** -0.5),
        'lru_ba': nrm((DEPTH, 2, LRU_WIDTH), 0.02),
        'lru_wx': nrm(blk, LRU_HEAD_DIM ** -0.5),
        'lru_bx': nrm((DEPTH, 2, LRU_WIDTH), 0.02),
        'lru_lam': lru_lam,
        'rwkv_mu': jax.random.uniform(next(keys), (DEPTH, RWKV_IN), f32),
        'rwkv_w0': rwkv_w0,
        'rwkv_w2': nrm((DEPTH, 2, DECAY_LORA, RWKV_WIDTH), 0.1),
        'rwkv_a0': nrm((DEPTH, 2, RWKV_WIDTH), 0.1),
        'rwkv_a2': nrm((DEPTH, 2, ICLR_LORA, RWKV_WIDTH), 0.1),
        'rwkv_g2': nrm((DEPTH, GATE_LORA, RWKV_WIDTH), GATE_LORA ** -0.5),
        'rwkv_kk': 0.85 + nrm((DEPTH, RWKV_WIDTH), 0.02),
        'rwkv_ka': gain((DEPTH, RWKV_WIDTH)),
        'rwkv_rk': nrm((DEPTH, RWKV_HEADS, RWKV_HEAD_DIM), 0.1),
        'rwkv_lnw': gain((DEPTH, RWKV_WIDTH)),
        'rwkv_lnb': nrm((DEPTH, RWKV_WIDTH), 0.02),
        's5_lam_re': s5_lam_re,
        's5_lam_im': s5_lam_im,
        's5_log_step': s5_log_step,
        's5_b_re': nrm((DEPTH, 2, S5_GROUPS, S5_STATE, S5_GROUP), (2 * S5_GROUP) ** -0.5),
        's5_b_im': nrm((DEPTH, 2, S5_GROUPS, S5_STATE, S5_GROUP), (2 * S5_GROUP) ** -0.5),
        's5_c_re': nrm((DEPTH, 2, S5_GROUPS, S5_GROUP, S5_STATE), (2 * S5_STATE) ** -0.5),
        's5_c_im': nrm((DEPTH, 2, S5_GROUPS, S5_GROUP, S5_STATE), (2 * S5_STATE) ** -0.5),
        's5_d': nrm((DEPTH, S5_WIDTH), 1.0),
        's5_w_glu': nrm((DEPTH, S5_WIDTH, S5_WIDTH), S5_WIDTH ** -0.5),
        's5_b_glu': nrm((DEPTH, S5_WIDTH), 0.02),
        'w_branch': nrm((DEPTH, N_BRANCH, BRANCH_WIDTH, D_MODEL), BRANCH_WIDTH ** -0.5),
        'w_out': nrm((DEPTH, D_MODEL, D_MODEL), D_MODEL ** -0.5),
        'w_ffn_in': nrm((DEPTH, D_MODEL, 2 * FFN_HIDDEN), D_MODEL ** -0.5),
        'w_ffn_out': nrm((DEPTH, FFN_HIDDEN, D_MODEL), FFN_HIDDEN ** -0.5),
    }


def reference(x, c, ctx, c_ctx, w_mod, b_mod, norm1, norm2, norm_f, w_in,
              lru_conv_w, lru_conv_b, lru_wa, lru_ba, lru_wx, lru_bx, lru_lam,
              rwkv_mu, rwkv_w0, rwkv_w2, rwkv_a0, rwkv_a2, rwkv_g2, rwkv_kk, rwkv_ka, rwkv_rk,
              rwkv_lnw, rwkv_lnb,
              s5_lam_re, s5_lam_im, s5_log_step, s5_b_re, s5_b_im, s5_c_re, s5_c_im, s5_d,
              s5_w_glu, s5_b_glu,
              w_branch, w_out, w_ffn_in, w_ffn_out):
    f32 = jnp.float32
    bsz, n_tok, _ = x.shape
    rows = n_tok // GRID_W
    h_lat, h_ctx = x, ctx
    cond_lat = jax.nn.silu(c)
    cond_ctx = jax.nn.silu(c_ctx)
    zero_lru = jnp.zeros((2, bsz, LRU_WIDTH), f32)
    zero_rwkv = jnp.zeros((2, bsz, RWKV_HEADS, RWKV_HEAD_DIM, RWKV_HEAD_DIM), f32)
    zero_s5 = jnp.zeros((2, 2, bsz, S5_GROUPS, S5_STATE), f32)
    for i in range(DEPTH):
        last = i == DEPTH - 1
        m_lat = (cond_lat @ w_mod[i] + b_mod[i])[:, None, :]
        m_ctx = cond_ctx @ w_mod[i] + b_mod[i]
        sh1l, sc1l, gt1l, sh2l, sc2l, gt2l = jnp.split(m_lat, 6, axis=-1)
        sh1c, sc1c, gt1c, sh2c, sc2c, gt2c = jnp.split(m_ctx, 6, axis=-1)
        lp = dict(lru_conv_w=lru_conv_w[i], lru_conv_b=lru_conv_b[i], lru_wa=lru_wa[i], lru_ba=lru_ba[i],
                  lru_wx=lru_wx[i], lru_bx=lru_bx[i], lru_lam=lru_lam[i],
                  rwkv_mu=rwkv_mu[i], rwkv_w0=rwkv_w0[i], rwkv_w2=rwkv_w2[i], rwkv_a0=rwkv_a0[i],
                  rwkv_a2=rwkv_a2[i], rwkv_g2=rwkv_g2[i], rwkv_kk=rwkv_kk[i], rwkv_ka=rwkv_ka[i],
                  rwkv_rk=rwkv_rk[i], rwkv_lnw=rwkv_lnw[i], rwkv_lnb=rwkv_lnb[i],
                  s5_lam_re=s5_lam_re[i], s5_lam_im=s5_lam_im[i], s5_log_step=s5_log_step[i],
                  s5_b_re=s5_b_re[i], s5_b_im=s5_b_im[i], s5_c_re=s5_c_re[i], s5_c_im=s5_c_im[i],
                  s5_d=s5_d[i], s5_w_glu=s5_w_glu[i], s5_b_glu=s5_b_glu[i])
        z_ctx = modulate(rms_norm(h_ctx, norm1[i]), sh1c, sc1c) @ w_in[i]
        z_lat = modulate(rms_norm(h_lat, norm1[i]), sh1l, sc1l) @ w_in[i]
        ys_c, zg_c, (st_lru, st_rwkv, st_s5) = token_mixers(z_ctx, lp, zero_lru, zero_rwkv, zero_s5, None)
        ys_l, zg_l, _ = token_mixers(z_lat, lp, st_lru, st_rwkv, st_s5, rows)
        h_lat = h_lat + (gt1l * merge_project(ys_l, zg_l, w_branch[i], w_out[i])).astype(h_lat.dtype)
        h_lat = h_lat + (gt2l * swiglu(modulate(rms_norm(h_lat, norm2[i]), sh2l, sc2l),
                                       w_ffn_in[i], w_ffn_out[i])).astype(h_lat.dtype)
        if not last:
            h_ctx = h_ctx + (gt1c * merge_project(ys_c, zg_c, w_branch[i], w_out[i])).astype(h_ctx.dtype)
            h_ctx = h_ctx + (gt2c * swiglu(modulate(rms_norm(h_ctx, norm2[i]), sh2c, sc2c),
                                           w_ffn_in[i], w_ffn_out[i])).astype(h_ctx.dtype)
    return rms_norm(h_lat, norm_f)
```

```cpp
#define TID_MBCNT 1
#include <hip/hip_runtime.h>
#include <hip/hip_cooperative_groups.h>
#include <cstdio>
namespace cg = cooperative_groups;

#define LAS __attribute__((address_space(3)))
#define UNR _Pragma("unroll")
typedef unsigned short bf16_t;
typedef short bf16x8 __attribute__((ext_vector_type(8)));
typedef float f32x4 __attribute__((ext_vector_type(4)));
typedef unsigned u32x2 __attribute__((ext_vector_type(2)));
typedef unsigned u32x4 __attribute__((ext_vector_type(4)));

constexpr int TOK = 16640, NLAYER = 4;
#ifndef SINGLE_LAUNCH
#define SINGLE_LAUNCH 1
#endif
constexpr int NTHR = 512;
constexpr int LDS_BYTES = 131072;

constexpr size_t SZ_TB512 = (size_t)TOK * 512 * 2;
constexpr size_t OFF_H = 0;
constexpr size_t OFF_HN = OFF_H + (size_t)TOK * 1024 * 4;
constexpr size_t OFF_W1 = OFF_HN + (size_t)TOK * 1024 * 2;
constexpr size_t W_INA = OFF_W1;
constexpr size_t W_LRU = W_INA + (size_t)3584 * 1024 * 2;
constexpr size_t W_LORA = W_LRU + (size_t)2048 * 512 * 2;
constexpr size_t W_S5Y = W_LORA + (size_t)2560 * 384 * 2;
constexpr size_t W_S5E = W_S5Y + (size_t)32 * 256 * 512 * 2;
constexpr size_t W_GLU = W_S5E + (size_t)32 * 256 * 256 * 2;
constexpr size_t OFF_YS = W_GLU + (size_t)512 * 512 * 2;
constexpr size_t OFF_ZB = OFF_YS + 3 * SZ_TB512;
constexpr size_t OFF_MISC = OFF_ZB + (size_t)TOK * 2048 * 2;
constexpr size_t M_MODV = OFF_MISC;
constexpr size_t M_PW = M_MODV + (size_t)4 * 2 * 6144 * 4;
constexpr size_t M_BB = M_PW + (size_t)4 * 2 * 32 * 64 * 17 * 2 * 4;
constexpr size_t M_CA = M_BB + (size_t)4 * 2 * 32 * 64 * 16 * 2 * 4;
constexpr size_t M_CB = M_CA + (size_t)2 * 260 * 512 * 4;
constexpr size_t M_HIN = M_CB + (size_t)2 * 260 * 512 * 4;
constexpr size_t M_BAR = OFF_MISC + 8388608 - 4096;
constexpr size_t OFF_X = OFF_MISC + 8388608;
constexpr size_t X_ZA = OFF_X;
constexpr size_t X_XC = X_ZA + (size_t)TOK * 1536 * 2;
constexpr size_t X_LA = X_XC + SZ_TB512;
constexpr size_t X_LU = X_LA + 2 * SZ_TB512;
constexpr size_t X_A5 = X_LU + 2 * SZ_TB512;
constexpr size_t X_LW = OFF_X;
constexpr size_t X_IC = X_LW + 2 * SZ_TB512;
constexpr size_t X_G = X_IC + 2 * SZ_TB512;
constexpr size_t X_YD1 = X_G + SZ_TB512;
constexpr size_t X_LORAA = X_YD1 + SZ_TB512;
constexpr size_t X_PQ = X_LORAA + (size_t)TOK * 384 * 2;
constexpr size_t X_SC = X_PQ + (size_t)16 * 80 * 8192 * 4;
constexpr size_t X_ZG = OFF_X;
constexpr size_t X_ACT = OFF_X;
constexpr size_t W_INZG = X_PQ;
constexpr size_t W_BR = W_INZG + (size_t)3072 * 1024 * 2;
constexpr size_t W_OUT = W_BR + (size_t)3 * 1024 * 512 * 2;
constexpr size_t W_FIN = W_OUT + (size_t)1024 * 1024 * 2;
constexpr size_t W_FOUT = W_FIN + (size_t)5632 * 1024 * 2;
constexpr size_t X_M = W_FOUT + (size_t)1024 * 2816 * 2;
constexpr size_t WS_END = X_M + (size_t)TOK * 1024 * 2 + 1048576;

struct Params { const float* in[42]; float* out; unsigned char* ws; };

enum { I_X = 0, I_C, I_CTX, I_CCTX, I_WMOD, I_BMOD, I_NORM1, I_NORM2, I_NORMF, I_WIN, I_CONVW, I_CONVB, I_WA, I_BA, I_WX, I_BX, I_LAM,
       I_MU, I_W0, I_W2, I_A0, I_A2, I_G2, I_KK, I_KA, I_RK, I_LNW, I_LNB, I_S5LRE, I_S5LIM, I_S5STEP, I_S5BRE, I_S5BIM, I_S5CRE, I_S5CIM,
       I_S5D, I_WGLU, I_BGLU, I_WBR, I_WOUT, I_WFIN, I_WFOUT };

__device__ __forceinline__ bf16_t f2bf(float f) { unsigned u = __float_as_uint(f); u += 0x7FFFu + ((u >> 16) & 1u); return (bf16_t)(u >> 16); }
__device__ __forceinline__ float bf2f(bf16_t b) { return __uint_as_float(((unsigned)b) << 16); }
typedef __bf16 bf16x2_t __attribute__((ext_vector_type(2)));
typedef float f32x2_t __attribute__((ext_vector_type(2)));
__device__ __forceinline__ unsigned pack2(float a, float b) { f32x2_t v = {a, b}; bf16x2_t r = __builtin_convertvector(v, bf16x2_t); return __builtin_bit_cast(unsigned, r); }
__device__ __forceinline__ void st4bf(bf16_t* p, float a, float b, float c, float d) { u32x2 w; w.x = pack2(a, b); w.y = pack2(c, d); *(u32x2*)p = w; }
__device__ __forceinline__ void ld4bf(const bf16_t* p, float (&o)[4]) { u32x2 w = *(const u32x2*)p; o[0] = __uint_as_float(w.x << 16); o[1] = __uint_as_float(w.x & 0xFFFF0000u); o[2] = __uint_as_float(w.y << 16); o[3] = __uint_as_float(w.y & 0xFFFF0000u); }
#ifdef OLD_SIGM
__device__ __forceinline__ float sigm(float x) { return 1.0f / (1.0f + __expf(-x)); }
#else
__device__ __forceinline__ float sigm(float x) { return __builtin_amdgcn_rcpf(1.0f + __expf(-x)); }
#endif
__device__ __forceinline__ float softplusf(float x) { return x > 15.f ? x : __logf(1.0f + __expf(x)); }
__device__ __forceinline__ float gelu_t(float x) { float t = tanhf(0.7978845608028654f * (x + 0.044715f * x * x * x)); return 0.5f * x * (1.0f + t); }
__device__ __forceinline__ float silu(float x) { return x * sigm(x); }
__device__ __forceinline__ int tok_of(int dir, int p) { return dir == 0 ? p : (p < 256 ? 255 - p : 16895 - p); }
__device__ __forceinline__ int s5_tok(int p) { if (p < 256) return p; int q = p - 256; return 256 + (q & 255) * 64 + (q >> 8); }
__device__ __forceinline__ float shx(float v, int o, int lane) { return __int_as_float(__builtin_amdgcn_ds_bpermute((lane ^ o) << 2, __float_as_int(v))); }
__device__ __forceinline__ float wave_sum(float v, int lane) {
#pragma unroll
    for (int o = 32; o >= 1; o >>= 1) v += shx(v, o, lane);
    return v;
}
__device__ __forceinline__ float zshift(const bf16_t* ZB, int tk, int col, float mu) {
    const int lo = tk < 256 ? 0 : 256, hi = tk < 256 ? 256 : TOK;
    const float z = bf2f(ZB[(size_t)tk * 2048 + col]);
    const float zp = (tk - 1 >= lo) ? bf2f(ZB[(size_t)(tk - 1) * 2048 + col]) : 0.f;
    const float zn = (tk + 1 < hi) ? bf2f(ZB[(size_t)(tk + 1) * 2048 + col]) : 0.f;
    return z + mu * (0.5f * (zp + zn) - z);
}

constexpr int BM = 256, BK = 64, HALF = 128, HTB = HALF * BK * 2, NXCD = 8, WGM = 8;
__device__ __forceinline__ int lds_byte(int r, int c) { const int st = (r >> 4) * 2 + (c >> 5), rr = r & 15, cc = c & 31, ob = rr * 64 + cc * 2; return st * 1024 + (ob ^ (((ob >> 9) & 1) << 5)); }
__device__ __forceinline__ void stage_rc(int b, int& R, int& C) { const int st = b / 1024, sb = b % 1024, swz = sb ^ (((sb >> 9) & 1) << 5); R = (st >> 1) * 16 + swz / 64; C = (st & 1) * 32 + (swz % 64) / 2; }

struct Unit { int pm, pn, g; };
struct GemmArgs { const bf16_t* A; const bf16_t* Bt; int lda, ldb, K; };

struct StaticOrder {
    int nM, nN, nwg, G, c;
    __device__ void init(int M, int N, int bid_l) { nM = M / BM; nN = N / BM; nwg = nM * nN; G = gridDim.x; c = bid_l; }
    __device__ bool next(int i, Unit& u) const {
        const long L = (long)i * G + c; if (L >= nwg) return false;
        int wgid = (int)L; { const int q = nwg / NXCD, r = nwg % NXCD, xcd = wgid % NXCD, off = wgid / NXCD; wgid = (xcd < r ? xcd * (q + 1) : r * (q + 1) + (xcd - r) * q) + off; }
        const int nig = WGM * nN, gid = wgid / nig, fm = gid * WGM, gsz = (nM - fm) < WGM ? (nM - fm) : WGM;
        u.pm = fm + ((wgid % nig) % gsz); u.pn = (wgid % nig) / gsz; u.g = 0; return true;
    }
    __device__ const char* aptr(const GemmArgs& g, const Unit& u) const { return (const char*)g.A + (size_t)u.pm * 256 * g.lda * 2; }
    __device__ const char* bptr(const GemmArgs& g, const Unit& u) const { return (const char*)g.Bt + (size_t)u.pn * 256 * g.ldb * 2; }
};
struct S5Order {
    int G, c;
    __device__ void init(int shift, int bid_l) { G = gridDim.x; c = (bid_l + shift) % gridDim.x; }
    __device__ bool next(int i, Unit& u) const { const int L = i * G + c; if (L >= 160) return false; u.g = L / 5; u.pm = L % 5; u.pn = 0; return true; }
    __device__ const char* aptr(const GemmArgs& g, const Unit& u) const { return (const char*)g.A + (size_t)(u.g * 1040 + u.pm * 256) * g.lda * 2; }
    __device__ const char* bptr(const GemmArgs& g, const Unit& u) const { return (const char*)g.Bt + (size_t)u.g * 256 * g.ldb * 2; }
};
struct TripleOrder {
    int nM, G, c;
    __device__ void init(int M, int bid_l) { nM = M / BM; G = gridDim.x; c = bid_l; }
    __device__ bool next(int i, Unit& u) const { const int L = (i / 3) * G + c; if (L >= nM * 4) return false; u.pm = L >> 2; u.pn = L & 3; u.g = i % 3; return true; }
    __device__ const char* aptr(const GemmArgs& g, const Unit& u) const { return (const char*)g.A + (size_t)u.g * SZ_TB512 + (size_t)u.pm * 256 * 512 * 2; }
    __device__ const char* bptr(const GemmArgs& g, const Unit& u) const { return (const char*)g.Bt + (size_t)(u.g * 1024 + u.pn * 256) * 512 * 2; }
};

template <class Epi, class Ord>
__device__ __forceinline__ void gemm_phase(LAS unsigned char* lds, const GemmArgs g, const Ord& S, const Epi& E, int tid_l) {
    const int tid = tid_l, wid = __builtin_amdgcn_readfirstlane(tid >> 6), lane = tid & 63, wr = wid >> 2, wc = wid & 3, fr = lane & 15, fq = lane >> 4;
    const int K = g.K, nt = K / BK;
    unsigned voffA, voffB;
    { int R, C; stage_rc(tid * 16, R, C); voffA = (unsigned)(R * g.lda + C) * 2u; voffB = (unsigned)(R * g.ldb + C) * 2u; }
    const size_t p64A = (size_t)64 * g.lda * 2, p64B = (size_t)64 * g.ldb * 2;
    const size_t kstep = (size_t)(BK * 2);
    const size_t hstepA = (size_t)HALF * g.lda * 2, hstepB = (size_t)HALF * g.ldb * 2;
    const unsigned ldsw = (unsigned)wid * 1024u;
    const int aoff = lds_byte(wr * 64 + fr, fq * 8), boff = lds_byte(wc * 32 + fr, fq * 8);
#define PG8_SA(b, h) (((b) * 2 + (h)) * HTB)
#define PG8_SB(b, h) ((4 + (b) * 2 + (h)) * HTB)
#define PG8_STAGE(bufoff, gbase, voff) do { _Pragma("unroll") for (int _i = 0; _i < 2; ++_i) \
        __builtin_amdgcn_global_load_lds((const unsigned*)((const char*)(gbase) + _i * p64_##voff + v_##voff), (LAS unsigned*)(lds + (bufoff) + ldsw + _i * 8192), 16, 0, 0); } while (0)
#define PG8_LDA(dst, b, h) do { _Pragma("unroll") for (int m = 0; m < 4; ++m) _Pragma("unroll") for (int k = 0; k < 2; ++k) dst[m][k] = *(const LAS bf16x8*)(lds + PG8_SA(b, h) + aoff + m * 2048 + k * 1024); } while (0)
#define PG8_LDB(dst, b, h) do { _Pragma("unroll") for (int n = 0; n < 2; ++n) _Pragma("unroll") for (int k = 0; k < 2; ++k) dst[n][k] = *(const LAS bf16x8*)(lds + PG8_SB(b, h) + boff + n * 2048 + k * 1024); } while (0)
#define PG8_MMA(ai, bj, At, Bt) do { __builtin_amdgcn_s_setprio(1); _Pragma("unroll") for (int m = 0; m < 4; ++m) _Pragma("unroll") for (int n = 0; n < 2; ++n) _Pragma("unroll") for (int k = 0; k < 2; ++k) \
        acc[ai][bj][m][n] = __builtin_amdgcn_mfma_f32_16x16x32_bf16(Bt[n][k], At[m][k], acc[ai][bj][m][n], 0, 0, 0); __builtin_amdgcn_s_setprio(0); } while (0)
#define p64_offA p64A
#define p64_offB p64B
#define v_offA voffA
#define v_offB voffB
#define PG8_WAIT_V(n) asm volatile("s_waitcnt vmcnt(" #n ")" ::: "memory")
#define PG8_WAIT_L(n) asm volatile("s_waitcnt lgkmcnt(" #n ")" ::: "memory")
#define PG8_BAR __builtin_amdgcn_s_barrier()
#define PG8_SCHED __builtin_amdgcn_sched_barrier(0)
    Unit cur, nxt; int ui = 0;
    if (!S.next(0, cur)) return;
    f32x4 acc[2][2][4][2];
#pragma unroll
    for (int a = 0; a < 2; ++a)
#pragma unroll
        for (int b = 0; b < 2; ++b)
#pragma unroll
            for (int m = 0; m < 4; ++m)
#pragma unroll
                for (int n = 0; n < 2; ++n) acc[a][b][m][n] = (f32x4){0.f, 0.f, 0.f, 0.f};
    bf16x8 At[4][2], B0[2][2], B1[2][2];
    const char* cA = S.aptr(g, cur); const char* cB = S.bptr(g, cur);
    PG8_STAGE(PG8_SB(0, 0), cB, offB); PG8_STAGE(PG8_SA(0, 0), cA, offA); PG8_STAGE(PG8_SB(0, 1), cB + hstepB, offB); PG8_STAGE(PG8_SA(0, 1), cA + hstepA, offA);
    if (wr == 1) PG8_BAR;
    PG8_WAIT_V(4); PG8_BAR;
    PG8_STAGE(PG8_SB(1, 0), cB + kstep, offB); PG8_STAGE(PG8_SA(1, 0), cA + kstep, offA); PG8_STAGE(PG8_SB(1, 1), cB + hstepB + kstep, offB);
    PG8_WAIT_V(6); PG8_BAR;
    for (;;) {
        const bool has_next = S.next(ui + 1, nxt);
        const char* nA = has_next ? S.aptr(g, nxt) : cA; const char* nB = has_next ? S.bptr(g, nxt) : cB;
        for (int t = 0; t < nt; t += 2) {
            const bool last = (t == nt - 2);
            const char* a1 = cA + (size_t)(t + 1) * kstep;
            const char* a2 = last ? nA : cA + (size_t)(t + 2) * kstep; const char* b2 = last ? nB : cB + (size_t)(t + 2) * kstep;
            const char* a3 = a2 + kstep; const char* b3 = b2 + kstep;
            PG8_LDB(B0, 0, 0); PG8_SCHED; PG8_LDA(At, 0, 0); PG8_STAGE(PG8_SA(1, 1), a1 + hstepA, offA);
            PG8_WAIT_L(8); PG8_BAR; PG8_WAIT_L(0); PG8_MMA(0, 0, At, B0); PG8_BAR; PG8_SCHED;
            PG8_LDB(B1, 0, 1); PG8_STAGE(PG8_SB(0, 0), b2, offB);
            PG8_BAR; PG8_WAIT_L(0); PG8_MMA(0, 1, At, B1); PG8_BAR;
            PG8_LDA(At, 0, 1); PG8_STAGE(PG8_SA(0, 0), a2, offA);
            PG8_BAR; PG8_WAIT_L(0); PG8_MMA(1, 0, At, B0); PG8_BAR; PG8_SCHED;
            PG8_STAGE(PG8_SB(0, 1), b2 + hstepB, offB);
            PG8_WAIT_V(6); PG8_BAR; PG8_MMA(1, 1, At, B1); PG8_BAR;
            PG8_LDB(B0, 1, 0); PG8_SCHED; PG8_LDA(At, 1, 0); PG8_STAGE(PG8_SA(0, 1), a2 + hstepA, offA);
            PG8_WAIT_L(8); PG8_BAR; PG8_WAIT_L(0); PG8_MMA(0, 0, At, B0); PG8_BAR; PG8_SCHED;
            PG8_LDB(B1, 1, 1); PG8_STAGE(PG8_SB(1, 0), b3, offB);
            PG8_BAR; PG8_WAIT_L(0); PG8_MMA(0, 1, At, B1); PG8_BAR;
            PG8_LDA(At, 1, 1); PG8_STAGE(PG8_SA(1, 0), a3, offA);
            PG8_BAR; PG8_WAIT_L(0); PG8_MMA(1, 0, At, B0); PG8_BAR; PG8_SCHED;
            PG8_STAGE(PG8_SB(1, 1), b3 + hstepB, offB);
            PG8_WAIT_V(6); PG8_BAR; PG8_MMA(1, 1, At, B1); PG8_BAR;
        }
        E(acc, cur, wr, wc, fr, fq);
        if (!has_next) break;
#pragma unroll
        for (int a = 0; a < 2; ++a)
#pragma unroll
            for (int b = 0; b < 2; ++b)
#pragma unroll
                for (int m = 0; m < 4; ++m)
#pragma unroll
                    for (int n = 0; n < 2; ++n) acc[a][b][m][n] = (f32x4){0.f, 0.f, 0.f, 0.f};
        cur = nxt; cA = nA; cB = nB; ++ui;
    }
    PG8_WAIT_V(0);
    if (wr == 0) PG8_BAR;
    PG8_BAR;
#undef p64_offA
#undef p64_offB
#undef v_offA
#undef v_offB
#undef PG8_SA
#undef PG8_SB
#undef PG8_STAGE
#undef PG8_LDA
#undef PG8_LDB
#undef PG8_MMA
#undef PG8_WAIT_V
#undef PG8_WAIT_L
#undef PG8_BAR
#undef PG8_SCHED
}

typedef f32x4 AccT[2][2][4][2];
#define EPI_ROWS _Pragma("unroll") for (int ai = 0; ai < 2; ++ai) _Pragma("unroll") for (int m = 0; m < 4; ++m)
#define EPI_BN _Pragma("unroll") for (int bj = 0; bj < 2; ++bj) _Pragma("unroll") for (int n = 0; n < 2; ++n)
#define EPI_B _Pragma("unroll") for (int bj = 0; bj < 2; ++bj)

#define EPI_ROW (__builtin_amdgcn_sched_barrier(0), u.pm * 256 + ai * 128 + wr * 64 + m * 16 + fr)
#define EPI_COL(bj, n) (u.pn * 256 + (bj) * 128 + wc * 32 + (n) * 16 + 4 * fq)

struct EpiZ {
    bf16_t* ZA; bf16_t* ZB;
    __device__ __forceinline__ void operator()(const AccT& acc, const Unit& u, int wr, int wc, int fr, int fq) const {
        EPI_ROWS { const int row = EPI_ROW;
            EPI_BN { const int col = EPI_COL(bj, n); const f32x4 v = acc[ai][bj][m][n];
                bf16_t* dst = col < 1536 ? ZA + (size_t)row * 1536 + col : ZB + (size_t)row * 2048 + (col - 1536);
                st4bf(dst, v[0], v[1], v[2], v[3]); } }
    }
};
struct EpiLruGate {
    const bf16_t* XC; bf16_t* LA; bf16_t* LU; const float* ba; const float* bx; const float* lam;
    __device__ __forceinline__ void operator()(const AccT& acc, const Unit& u, int wr, int wc, int fr, int fq) const {
        EPI_B { __builtin_amdgcn_sched_barrier(0);
            const int g32 = (u.pn * 256 + bj * 128 + wc * 32) >> 5, dir = g32 >> 5, ch = (g32 & 31) * 16 + 4 * fq;
            float pba[4], pbx[4], psp[4];
            UNR for (int j = 0; j < 4; ++j) { const int c = dir * 512 + ch + j; pba[j] = ba[c]; pbx[j] = bx[c]; psp[j] = -8.0f * softplusf(-lam[c]); }
            EPI_ROWS { const int row = EPI_ROW;
                const f32x4 va = acc[ai][bj][m][0], vx = acc[ai][bj][m][1];
                float xc[4]; ld4bf(XC + (size_t)row * 512 + ch, xc);
                float la[4], uu[4];
                UNR for (int j = 0; j < 4; ++j) {
                    const float gr = sigm(va[j] + pba[j]), gi = sigm(vx[j] + pbx[j]);
                    la[j] = gr * psp[j];
                    uu[j] = __fsqrt_rn(fmaxf(1.0f - __expf(2.0f * la[j]), 0.f)) * gi * xc[j]; }
                const size_t o = ((size_t)dir * TOK + row) * 512 + ch;
                st4bf(LA + o, la[0], la[1], la[2], la[3]); st4bf(LU + o, uu[0], uu[1], uu[2], uu[3]); } }
    }
};
struct EpiS5E {
    float* E;
    __device__ __forceinline__ void operator()(const AccT& acc, const Unit& u, int wr, int wc, int fr, int fq) const {
        EPI_ROWS { const int row = EPI_ROW; if (row < 1040) {
            EPI_BN { const int col = EPI_COL(bj, n);
                *(f32x4*)(E + ((size_t)u.g * 1040 + row) * 256 + col) = acc[ai][bj][m][n]; } } }
    }
};
struct EpiS5Y {
    const bf16_t* ZA; bf16_t* YG; const float* dsk;
    __device__ __forceinline__ void operator()(const AccT& acc, const Unit& u, int wr, int wc, int fr, int fq) const {
        EPI_ROWS { const int row = EPI_ROW; if (row < 1040) {
            EPI_BN { const int col = EPI_COL(bj, n); const f32x4 v = acc[ai][bj][m][n];
                const int t = col >> 4, cp = col & 15, tk = s5_tok(row * 16 + t), ch = u.g * 16 + cp;
                float uv[4]; ld4bf(ZA + (size_t)tk * 1536 + 1024 + ch, uv);
                float y[4]; UNR for (int j = 0; j < 4; ++j) y[j] = gelu_t(v[j] + dsk[ch + j] * uv[j]);
                st4bf(YG + (size_t)tk * 512 + ch, y[0], y[1], y[2], y[3]); } } }
    }
};
struct EpiGlu {
    const bf16_t* YG; bf16_t* YC; const float* bg;
    __device__ __forceinline__ void operator()(const AccT& acc, const Unit& u, int wr, int wc, int fr, int fq) const {
        EPI_ROWS { const int row = EPI_ROW;
            EPI_BN { const int col = EPI_COL(bj, n); const f32x4 v = acc[ai][bj][m][n];
                float y[4]; ld4bf(YG + (size_t)row * 512 + col, y);
                UNR for (int j = 0; j < 4; ++j) y[j] *= sigm(v[j] + bg[col + j]);
                st4bf(YC + (size_t)row * 512 + col, y[0], y[1], y[2], y[3]); } }
    }
};
struct EpiLora {
    bf16_t* LW; bf16_t* IC; bf16_t* G; const float* w0; const float* a0;
    __device__ __forceinline__ void operator()(const AccT& acc, const Unit& u, int wr, int wc, int fr, int fq) const {
        const int blk = u.pn >> 1;
        if (blk < 2) {
            EPI_BN { __builtin_amdgcn_sched_barrier(0); const int col = EPI_COL(bj, n); float b[4];
                UNR for (int j = 0; j < 4; ++j) b[j] = w0[col + j];
                EPI_ROWS { const int row = EPI_ROW; const f32x4 v = acc[ai][bj][m][n]; float o[4];
                    UNR for (int j = 0; j < 4; ++j) { const float wl = -softplusf(-(b[j] + v[j])) - 0.5f; o[j] = -__expf(wl); }
                    st4bf(LW + ((size_t)blk * TOK + row) * 512 + (col & 511), o[0], o[1], o[2], o[3]); } }
        } else if (blk < 4) {
            EPI_BN { __builtin_amdgcn_sched_barrier(0); const int col = EPI_COL(bj, n) - 1024; float b[4];
                UNR for (int j = 0; j < 4; ++j) b[j] = a0[col + j];
                EPI_ROWS { const int row = EPI_ROW; const f32x4 v = acc[ai][bj][m][n]; float o[4];
                    UNR for (int j = 0; j < 4; ++j) o[j] = sigm(b[j] + v[j]);
                    st4bf(IC + ((size_t)(blk - 2) * TOK + row) * 512 + (col & 511), o[0], o[1], o[2], o[3]); } }
        } else {
            EPI_ROWS { const int row = EPI_ROW;
                EPI_BN { const int col = EPI_COL(bj, n) - 2048; const f32x4 v = acc[ai][bj][m][n];
                    st4bf(G + (size_t)row * 512 + col, v[0], v[1], v[2], v[3]); } }
        }
    }
};
struct EpiZg {
    bf16_t* ZG; int row0;
    __device__ __forceinline__ void operator()(const AccT& acc, const Unit& u, int wr, int wc, int fr, int fq) const {
        EPI_ROWS { const int row = row0 + EPI_ROW;
            EPI_BN { const int col = EPI_COL(bj, n); const f32x4 v = acc[ai][bj][m][n];
                st4bf(ZG + (size_t)row * 3072 + col, sigm(v[0]), sigm(v[1]), sigm(v[2]), sigm(v[3])); } }
    }
};
struct EpiMerge1 {
    const bf16_t* ZG; bf16_t* M; int row0;
    __device__ __forceinline__ void operator()(const AccT& acc, const Unit& u, int wr, int wc, int fr, int fq) const {
        EPI_ROWS { const int row = row0 + EPI_ROW;
            EPI_BN { const int col = EPI_COL(bj, n); const f32x4 v = acc[ai][bj][m][n];
                float gt[4]; ld4bf(ZG + (size_t)row * 3072 + u.g * 1024 + col, gt);
                float mv[4] = {0.f, 0.f, 0.f, 0.f}; if (u.g) ld4bf(M + (size_t)row * 1024 + col, mv);
                st4bf(M + (size_t)row * 1024 + col, mv[0] + gt[0] * v[0], mv[1] + gt[1] * v[1], mv[2] + gt[2] * v[2], mv[3] + gt[3] * v[3]); } }
    }
};
struct EpiRes {
    float* H; const float* gl; const float* gc; int row0;
    __device__ __forceinline__ void operator()(const AccT& acc, const Unit& u, int wr, int wc, int fr, int fq) const {
        EPI_ROWS { const int row = row0 + EPI_ROW; const float* gv = row < 256 ? gc : gl;
            EPI_BN { const int col = EPI_COL(bj, n); const f32x4 v = acc[ai][bj][m][n];
                float* hp = H + (size_t)row * 1024 + col; f32x4 hv = *(f32x4*)hp; const f32x4 gg = *(const f32x4*)(gv + col);
                hv += gg * v; *(f32x4*)hp = hv; } }
    }
};
struct EpiFfn {
    bf16_t* ACT; int row0;
    __device__ __forceinline__ void operator()(const AccT& acc, const Unit& u, int wr, int wc, int fr, int fq) const {
        EPI_ROWS { const int row = row0 + EPI_ROW;
            EPI_B { const int g32 = (u.pn * 256 + bj * 128 + wc * 32) >> 5, oc = g32 * 16 + 4 * fq;
                const f32x4 g = acc[ai][bj][m][0], up = acc[ai][bj][m][1];
                st4bf(ACT + (size_t)row * 2816 + oc, silu(g[0]) * up[0], silu(g[1]) * up[1], silu(g[2]) * up[2], silu(g[3]) * up[3]); } }
    }
};

template <class Map>
__device__ __forceinline__ void conv_T(const float* src, int src_ld, bf16_t* dst, int Nd, int K, Map map, float* sm, int shift, int tid_l, int bid_l) {
    const int tk = K / 64, ntile = (Nd / 64) * tk;
    for (int t = (bid_l + shift) % gridDim.x; t < ntile; t += gridDim.x) {
        const int n0 = (t / tk) * 64, k0 = (t % tk) * 64;
        { const int n = tid_l & 63, kq = tid_l >> 6; const int col = map(n0 + n);
            for (int e = 0; e < 8; ++e) { const int k = e * 8 + kq; sm[k * 65 + n] = col >= 0 ? src[(size_t)(k0 + k) * src_ld + col] : 0.f; } }
        __syncthreads();
        { const int k = tid_l & 63, nq = tid_l >> 6;
            for (int e = 0; e < 8; ++e) { const int n2 = e * 8 + nq; dst[(size_t)(n0 + n2) * K + k0 + k] = f2bf(sm[k * 65 + n2]); } }
        __syncthreads();
    }
}
struct MapIna { __device__ int operator()(int n) const { return n < 1024 ? n : (n < 1536 ? 2944 + (n - 1024) : (n < 3456 ? 1024 + (n - 1536) : -1)); } };
struct MapOff { int off; __device__ int operator()(int n) const { return off + n; } };
struct MapFfn { __device__ int operator()(int n) const { const int g32 = n >> 5, w = n & 31; return w < 16 ? g32 * 16 + w : 2816 + g32 * 16 + (w - 16); } };

__device__ __forceinline__ void norm_rows(const float* H, const float* nw, const float* modl, const float* modc, int shoff, int scoff, bf16_t* HN, int row_begin, int tid_l, int bid_l) {
    const int wid = tid_l >> 6, lane = tid_l & 63;
    for (int row = row_begin + bid_l * 8 + wid; row < TOK; row += gridDim.x * 8) {
        const float* hp = H + (size_t)row * 1024; const float* mv = row < 256 ? modc : modl;
        f32x4 x[4]; float ss = 0.f;
        UNR for (int e = 0; e < 4; ++e) { x[e] = *(const f32x4*)(hp + e * 256 + lane * 4); ss += x[e][0] * x[e][0] + x[e][1] * x[e][1] + x[e][2] * x[e][2] + x[e][3] * x[e][3]; }
        ss = wave_sum(ss, lane); const float sc = rsqrtf(ss * (1.0f / 1024.0f) + 1e-6f);
        UNR for (int e = 0; e < 4; ++e) { const int c = e * 256 + lane * 4; float y[4];
            UNR for (int j = 0; j < 4; ++j) y[j] = x[e][j] * sc * nw[c + j] * (1.0f + mv[scoff + c + j]) + mv[shoff + c + j];
            st4bf(HN + (size_t)row * 1024 + c, y[0], y[1], y[2], y[3]); }
    }
}

template <int NCH, bool WITH_Y>
__device__ __forceinline__ void wkv_steps(float (&s)[NCH], const float* sw, const float* skk, const float* sb, const float* skd, const float* sr, const float* sv, float* sy,
                                          int nst, int vrow, bool hasv, int sub, int lane) {
    for (int jj = 0; jj < nst; ++jj) {
        const int o = jj * 64 + sub * NCH;
        float sa = 0.f;
#pragma unroll
        for (int i = 0; i < NCH; ++i) sa += s[i] * skk[o + i];
#pragma unroll
        for (int x = 1; x < 64 / NCH; x <<= 1) sa += shx(sa, x, lane);
        const float vv = hasv ? sv[jj * 64 + vrow] : 0.f;
#pragma unroll
        for (int i = 0; i < NCH; ++i) s[i] = s[i] * sw[o + i] + (vv * skd[o + i] - sa * sb[o + i]);
        if (WITH_Y) {
            float y = 0.f;
#pragma unroll
            for (int i = 0; i < NCH; ++i) y += s[i] * sr[o + i];
#pragma unroll
            for (int x = 1; x < 64 / NCH; x <<= 1) y += shx(y, x, lane);
            if (sub == 0) sy[jj * 64 + vrow] = y;
        }
    }
}
constexpr int WCH = 208, WNC = 80, WSC = 26;
__device__ __forceinline__ void wkv_stage(float* sm, const bf16_t* ZB, const bf16_t* LW, const bf16_t* IC, const float* mu, const float* kkw, const float* kaw,
                                          int dir, int head, int p0, int tid_l) {
    const int wid = tid_l >> 6, lane = tid_l & 63, col = head * 64 + lane;
    for (int jj = wid; jj < WSC; jj += 8) {
        const int tk = tok_of(dir, p0 + jj);
        const float r = zshift(ZB, tk, col, mu[col]), k = zshift(ZB, tk, 512 + col, mu[512 + col]), v = zshift(ZB, tk, 1024 + col, mu[1024 + col]);
        const float kx = k * kkw[col]; const float ssq = wave_sum(kx * kx, lane); const float kk = kx * rsqrtf(ssq + 1e-12f);
        const size_t o = ((size_t)dir * TOK + tk) * 512 + col;
        const float w = __expf(bf2f(LW[o])), ic = bf2f(IC[o]);
        const int q = jj * 64 + lane;
        sm[q] = w; sm[1664 + q] = kk; sm[2 * 1664 + q] = kk * ic; sm[3 * 1664 + q] = k * (1.0f + (ic - 1.0f) * kaw[col]); sm[4 * 1664 + q] = r; sm[5 * 1664 + q] = v;
    }
}

__device__ __forceinline__ int launder_s(int i) { asm volatile("" : "+s"(i)); return i; }
#define IN(i) (p.in[launder_s(i)])
constexpr int PH_PER_LAYER = 19;
constexpr int NPHASE = 1 + NLAYER * PH_PER_LAYER + 1;

#define ZA ((bf16_t*)(ws + X_ZA))
#define ZB ((bf16_t*)(ws + OFF_ZB))
#define XC ((bf16_t*)(ws + X_XC))
#define LA ((bf16_t*)(ws + X_LA))
#define LU ((bf16_t*)(ws + X_LU))
#define A5 ((bf16_t*)(ws + X_A5))
#define YS ((bf16_t*)(ws + OFF_YS))
#define YA YS
#define YB (YS + (size_t)TOK * 512)
#define YC (YS + (size_t)2 * TOK * 512)
#define S5E ((float*)(ws + OFF_HN))
#define CA ((float*)(ws + M_CA))
#define CB ((float*)(ws + M_CB))
#define HIN ((float*)(ws + M_HIN))
#define LW ((bf16_t*)(ws + X_LW))
#define IC ((bf16_t*)(ws + X_IC))
#define GG ((bf16_t*)(ws + X_G))
#define YD1 ((bf16_t*)(ws + X_YD1))
#define LORAA ((bf16_t*)(ws + X_LORAA))
#define PQ ((float*)(ws + X_PQ))
#define SCS ((float*)(ws + X_SC))
#define ZG ((bf16_t*)(ws + X_ZG))
#define ACT ((bf16_t*)(ws + X_ACT))
#define MM ((bf16_t*)(ws + X_M))
template <int KSEL>
__device__ __forceinline__ void run_phase(const Params& p, int ph, unsigned char* shm, int wv) {
    unsigned char* ws = p.ws;
    float* sm = (float*)shm;
    LAS unsigned char* lds = (LAS unsigned char*)shm;
#ifdef TID_MBCNT
    int tid; asm volatile("v_mbcnt_lo_u32_b32 %0, -1, 0\n\tv_mbcnt_hi_u32_b32 %0, -1, %0" : "=v"(tid)); tid += wv * 64;
#else
    int tid = threadIdx.x; asm volatile("" : "+v"(tid)); (void)wv;
#endif
    int bid = blockIdx.x; asm volatile("" : "+s"(bid));
#define wid (tid >> 6)
#define lane (tid & 63)
#define gtid ((size_t)bid * NTHR + tid)
#define gthreads ((size_t)gridDim.x * NTHR)
    float* H = (float*)(ws + OFF_H);
    bf16_t* HN = (bf16_t*)(ws + OFF_HN);
    float* MODV = (float*)(ws + M_MODV);
    float* PW = (float*)(ws + M_PW);
    float* BBT = (float*)(ws + M_BB);

    if (KSEL == 100 && ph != 0) return;
    if (KSEL == 101 && ph != NPHASE - 1) return;
    if (KSEL >= 0 && KSEL < 100 && (ph == 0 || ph == NPHASE - 1)) return;
    if (ph == 0) {
        for (int vb = bid; vb < 48 + 32 + 512; vb += gridDim.x) {
            if (vb < 48) {
                __syncthreads();
                for (int k = tid; k < 1024; k += NTHR) { sm[k] = silu(IN(I_C)[k]); sm[1024 + k] = silu(IN(I_CCTX)[k]); }
                __syncthreads();
                const int idx = vb * NTHR + tid, layer = idx / 6144, n = idx % 6144;
                const float* w = IN(I_WMOD) + (size_t)layer * 1024 * 6144 + n;
                float al = 0.f, ac = 0.f;
                for (int k = 0; k < 1024; ++k) { const float wv = w[(size_t)k * 6144]; al += sm[k] * wv; ac += sm[1024 + k] * wv; }
                const float b = IN(I_BMOD)[layer * 6144 + n];
                MODV[(layer * 2 + 0) * 6144 + n] = al + b; MODV[(layer * 2 + 1) * 6144 + n] = ac + b;
            } else if (vb < 80) {
                const int idx = (vb - 48) * NTHR + tid;
                const int pp = idx & 63, g = (idx >> 6) & 31, ld = idx >> 11;
                const float lre = IN(I_S5LRE)[idx], lim = IN(I_S5LIM)[idx], step = __expf(IN(I_S5STEP)[ld * 32 + g]);
                const float xr = lre * step, ang = lim * step;
                for (int t = 0; t <= 16; ++t) { const float mg = expf(xr * t); PW[((size_t)idx * 17 + t) * 2] = mg * cosf(ang * t); PW[((size_t)idx * 17 + t) * 2 + 1] = mg * sinf(ang * t); }
                const float mg = expf(xr), lbim = mg * sinf(ang), sh = sinf(0.5f * ang);
                const float nr = expm1f(xr) * cosf(ang) - 2.0f * sh * sh, den = lre * lre + lim * lim;
                const float fre = (nr * lre + lbim * lim) / den, fim = (lbim * lre - nr * lim) / den;
                for (int c = 0; c < 16; ++c) { const float br = IN(I_S5BRE)[(size_t)idx * 16 + c], bi = IN(I_S5BIM)[(size_t)idx * 16 + c];
                    BBT[((size_t)idx * 16 + c) * 2] = fre * br - fim * bi; BBT[((size_t)idx * 16 + c) * 2 + 1] = fre * bi + fim * br; }
                (void)pp;
            } else {
                const int cb = vb - 80;
                for (size_t i = (size_t)cb * NTHR + tid; i < (size_t)TOK * 256; i += (size_t)512 * NTHR) {
                    const f32x4 v = i < (size_t)256 * 256 ? ((const f32x4*)IN(I_CTX))[i] : ((const f32x4*)IN(I_X))[i - (size_t)256 * 256];
                    ((f32x4*)H)[i] = v; }
            }
        }
        return;
    }
    if (ph == NPHASE - 1) {
        const float* nw = IN(I_NORMF);
        for (int row = 256 + bid * 8 + wid; row < TOK; row += gridDim.x * 8) {
            const float* hp = H + (size_t)row * 1024; f32x4 x[4]; float ss = 0.f;
            UNR for (int e = 0; e < 4; ++e) { x[e] = *(const f32x4*)(hp + e * 256 + lane * 4); ss += x[e][0] * x[e][0] + x[e][1] * x[e][1] + x[e][2] * x[e][2] + x[e][3] * x[e][3]; }
            ss = wave_sum(ss, lane); const float sc = rsqrtf(ss * (1.0f / 1024.0f) + 1e-6f);
            UNR for (int e = 0; e < 4; ++e) { const int c = e * 256 + lane * 4; f32x4 y; UNR for (int j = 0; j < 4; ++j) y[j] = x[e][j] * sc * nw[c + j];
                *(f32x4*)(p.out + (size_t)(row - 256) * 1024 + c) = y; }
        }
        return;
    }
    const int L = (ph - 1) / PH_PER_LAYER, k = (ph - 1) % PH_PER_LAYER;
    const bool last = (L == NLAYER - 1);
    const float* modl = MODV + (L * 2 + 0) * 6144; const float* modc = MODV + (L * 2 + 1) * 6144;
    const int row0 = last ? 256 : 0, Mrows = last ? 16384 : TOK;

    if (KSEL >= 0 && k != KSEL) return;
    switch (k) {
    case 0: {
        conv_T(IN(I_WIN) + (size_t)L * 1024 * 6528, 6528, (bf16_t*)(ws + W_INA), 3584, 1024, MapIna(), sm, 0, tid, bid);
        conv_T(IN(I_WGLU) + (size_t)L * 512 * 512, 512, (bf16_t*)(ws + W_GLU), 512, 512, MapOff{0}, sm, 128, tid, bid);
        {
            bf16_t* W = (bf16_t*)(ws + W_LRU); const float* pwa = IN(I_WA); const float* pwx = IN(I_WX);
            for (size_t i = gtid; i < (size_t)2048 * 512; i += gthreads) { const int n = (int)(i >> 9), kk = (int)(i & 511);
                const int g32 = n >> 5, which = (n & 31) >> 4, dir = g32 >> 5, ch = (g32 & 31) * 16 + (n & 15), head = ch >> 6, j = ch & 63;
                float v = 0.f; if ((kk >> 6) == head) v = (which ? pwx : pwa)[((((size_t)L * 2 + dir) * 8 + head) * 64 + (kk & 63)) * 64 + j];
                W[i] = f2bf(v); }
        }
        {
            bf16_t* W = (bf16_t*)(ws + W_LORA);
            for (size_t i = gtid; i < (size_t)2560 * 384; i += gthreads) { const int n = (int)(i / 384), kk = (int)(i % 384);
                const int blk = n >> 9, ch = n & 511; float v = 0.f;
                if (blk < 2) { if ((kk >> 6) == blk) v = IN(I_W2)[(((size_t)L * 2 + blk) * 64 + (kk & 63)) * 512 + ch]; }
                else if (blk < 4) { if ((kk >> 6) == blk) v = IN(I_A2)[(((size_t)L * 2 + (blk - 2)) * 64 + (kk & 63)) * 512 + ch]; }
                else { if (kk >= 256) v = IN(I_G2)[((size_t)L * 128 + (kk - 256)) * 512 + ch]; }
                W[i] = f2bf(v); }
        }
        {
            bf16_t* WY = (bf16_t*)(ws + W_S5Y); bf16_t* WE = (bf16_t*)(ws + W_S5E);
            const float* cre = IN(I_S5CRE) + (size_t)L * 2 * 32 * 16 * 64; const float* cim = IN(I_S5CIM) + (size_t)L * 2 * 32 * 16 * 64;
            const float* pw = PW + (size_t)L * 2 * 32 * 64 * 17 * 2; const float* bb = BBT + (size_t)L * 2 * 32 * 64 * 16 * 2;
            for (size_t i = gtid; i < (size_t)32 * 256 * 512; i += gthreads) {
                const int kk = (int)(i & 511), n = (int)((i >> 9) & 255), g = (int)(i >> 17), t = n >> 4, cp = n & 15; float v = 0.f;
                if (kk < 256) { const int j = kk >> 4, c = kk & 15;
                    for (int d = 0; d < 2; ++d) { const int tau = d == 0 ? t - j : j - t; if (tau < 0) continue;
                        const float* cr = cre + ((size_t)(d * 32 + g) * 16 + cp) * 64; const float* ci = cim + ((size_t)(d * 32 + g) * 16 + cp) * 64;
                        const float* pwd = pw + (size_t)(d * 32 + g) * 64 * 34; const float* bbd = bb + (size_t)(d * 32 + g) * 64 * 32;
                        for (int pp = 0; pp < 64; ++pp) { const float pr = pwd[pp * 34 + tau * 2], pi = pwd[pp * 34 + tau * 2 + 1], br = bbd[pp * 32 + c * 2], bi = bbd[pp * 32 + c * 2 + 1];
                            const float xr = pr * br - pi * bi, xi = pr * bi + pi * br; v += cr[pp] * xr - ci[pp] * xi; } } }
                else { const int d = (kk - 256) >> 7, pp = ((kk - 256) & 127) >> 1, ri = kk & 1; const int e = d == 0 ? t + 1 : 16 - t;
                    const float cr = cre[((size_t)(d * 32 + g) * 16 + cp) * 64 + pp], ci = cim[((size_t)(d * 32 + g) * 16 + cp) * 64 + pp];
                    const float pr = pw[((size_t)(d * 32 + g) * 64 + pp) * 34 + e * 2], pi = pw[((size_t)(d * 32 + g) * 64 + pp) * 34 + e * 2 + 1];
                    v = ri == 0 ? (cr * pr - ci * pi) : -(cr * pi + ci * pr); }
                WY[i] = f2bf(v); }
            for (size_t i = gtid; i < (size_t)32 * 256 * 256; i += gthreads) {
                const int kk = (int)(i & 255), n = (int)((i >> 8) & 255), g = (int)(i >> 16), d = n >> 7, pp = (n & 127) >> 1, ri = n & 1, j = kk >> 4, c = kk & 15;
                const int e = d == 0 ? 15 - j : j;
                const float pr = pw[((size_t)(d * 32 + g) * 64 + pp) * 34 + e * 2], pi = pw[((size_t)(d * 32 + g) * 64 + pp) * 34 + e * 2 + 1];
                const float br = bb[((size_t)(d * 32 + g) * 64 + pp) * 32 + c * 2], bi = bb[((size_t)(d * 32 + g) * 64 + pp) * 32 + c * 2 + 1];
                WE[i] = f2bf(ri == 0 ? pr * br - pi * bi : pr * bi + pi * br); }
        }
        norm_rows(H, IN(I_NORM1) + L * 1024, modl, modc, 0, 1024, HN, 0, tid, bid);
    } break;
    case 1: {
        GemmArgs g{HN, (const bf16_t*)(ws + W_INA), 1024, 1024, 1024}; StaticOrder S; S.init(TOK, 3584, bid);
        gemm_phase(lds, g, S, EpiZ{ZA, ZB}, tid);
    } break;
    case 2: {
        const float* cw = IN(I_CONVW) + L * 2048; const float* cb = IN(I_CONVB) + L * 512;
        for (size_t i = gtid; i < (size_t)TOK * 512; i += gthreads) { const int tk = (int)(i >> 9), ch = (int)(i & 511);
            const int lo = tk < 256 ? 0 : 256, hi = tk < 256 ? 256 : TOK; float a = cb[ch];
            UNR for (int j = 0; j < 4; ++j) { const int t2 = tk + j - 2; if (t2 >= lo && t2 < hi) a += cw[j * 512 + ch] * bf2f(ZA[(size_t)t2 * 1536 + ch]); }
            XC[i] = f2bf(a); }
        for (size_t i = gtid; i < (size_t)32 * 1040 * 16; i += gthreads) { const int j = (int)(i & 15); const int s = (int)((i >> 4) % 1040), g = (int)((i >> 4) / 1040);
            const int tk = s5_tok(s * 16 + j); const u32x4* src = (const u32x4*)(ZA + (size_t)tk * 1536 + 1024 + g * 16); u32x4* dst = (u32x4*)(A5 + ((size_t)g * 1040 + s) * 512 + j * 16);
            dst[0] = src[0]; dst[1] = src[1]; }
    } break;
    case 3: {
        { GemmArgs g{XC, (const bf16_t*)(ws + W_LRU), 512, 512, 512}; StaticOrder S; S.init(TOK, 2048, bid);
          gemm_phase(lds, g, S, EpiLruGate{XC, LA, LU, IN(I_BA) + L * 1024, IN(I_BX) + L * 1024, IN(I_LAM) + L * 1024}, tid); }
        asm volatile("" : "+v"(tid));
        { GemmArgs g{A5, (const bf16_t*)(ws + W_S5E), 512, 256, 256}; S5Order S; S.init(248, bid);
          gemm_phase(lds, g, S, EpiS5E{S5E}, tid); }
    } break;
    case 4: {
        for (int task = bid; task < 520 + 8; task += gridDim.x) {
            if (task < 520) { const int c = task >> 1, dir = task & 1, ch = tid; float As = 0.f, Bs = 0.f;
                for (int j = 0; j < 64; ++j) { const int tk = tok_of(dir, c * 64 + j); const size_t o = ((size_t)dir * TOK + tk) * 512 + ch;
                    const float la = bf2f(LA[o]), uu = bf2f(LU[o]); As += la; Bs = __expf(la) * Bs + uu; }
                CA[(dir * 260 + c) * 512 + ch] = As; CB[(dir * 260 + c) * 512 + ch] = Bs;
            } else { const int idx = (task - 520) * NTHR + tid;
                const int pp = idx & 63, dir = (idx >> 6) & 1, g = idx >> 7;
                const float* pw = PW + ((((size_t)L * 2 + dir) * 32 + g) * 64 + pp) * 34; const float ar = pw[32], ai = pw[33];
                float hr = 0.f, hi = 0.f; const int cb = dir * 128 + pp * 2;
                for (int q0 = 0; q0 < 1040; q0 += 8) { float er[8], ei[8];
                    UNR for (int j = 0; j < 8; ++j) { const int q = q0 + j, s = dir == 0 ? q : (q < 16 ? 15 - q : 1055 - q); const float* ep = S5E + ((size_t)g * 1040 + s) * 256 + cb; er[j] = ep[0]; ei[j] = ep[1]; }
                    UNR for (int j = 0; j < 8; ++j) { const int q = q0 + j, s = dir == 0 ? q : (q < 16 ? 15 - q : 1055 - q);
                        *(unsigned*)(A5 + ((size_t)g * 1040 + s) * 512 + 256 + cb) = pack2(hr, hi);
                        const float nr = ar * hr - ai * hi + er[j], ni = ar * hi + ai * hr + ei[j]; hr = nr; hi = ni; } }
            }
        }
    } break;
    case 5: {
        if (bid < 2) { const int dir = bid, ch = tid; float h = 0.f;
            for (int c0 = 0; c0 < 260; c0 += 4) { float a[4], b[4];
                UNR for (int j = 0; j < 4; ++j) { a[j] = CA[(dir * 260 + c0 + j) * 512 + ch]; b[j] = CB[(dir * 260 + c0 + j) * 512 + ch]; }
                UNR for (int j = 0; j < 4; ++j) { HIN[(dir * 260 + c0 + j) * 512 + ch] = h; h = __expf(a[j]) * h + b[j]; } } }
        __syncthreads(); asm volatile("" : "+v"(tid));
        { GemmArgs g{A5, (const bf16_t*)(ws + W_S5Y), 512, 512, 512}; S5Order S; S.init(254, bid);
          gemm_phase(lds, g, S, EpiS5Y{ZA, XC, IN(I_S5D) + L * 512}, tid); }
    } break;
    case 6: {
        for (int ct = bid; ct < 260; ct += gridDim.x) { const int ch = tid;
            float h = HIN[(0 * 260 + ct) * 512 + ch];
            for (int j = 0; j < 64; ++j) { const int tk = ct * 64 + j; const size_t o = (size_t)tk * 512 + ch; h = __expf(bf2f(LA[o])) * h + bf2f(LU[o]); YA[o] = f2bf(h); }
            const int c1 = ct < 4 ? 3 - ct : 263 - ct; h = HIN[(1 * 260 + c1) * 512 + ch];
            for (int j = 0; j < 64; ++j) { const int tk = ct * 64 + 63 - j; const size_t o = (size_t)tk * 512 + ch, o1 = (size_t)TOK * 512 + o;
                h = __expf(bf2f(LA[o1])) * h + bf2f(LU[o1]); YA[o] = f2bf(gelu_t(bf2f(ZA[(size_t)tk * 1536 + 512 + ch])) * (bf2f(YA[o]) + h)); } }
        __syncthreads(); asm volatile("" : "+v"(tid));
        { GemmArgs g{XC, (const bf16_t*)(ws + W_GLU), 512, 512, 512}; StaticOrder S; S.init(TOK, 512, bid);
          gemm_phase(lds, g, S, EpiGlu{XC, YC, IN(I_BGLU) + L * 512}, tid); }
    } break;
    case 7: {
        const float* mu = IN(I_MU) + L * 1920;
        for (size_t i = gtid; i < (size_t)TOK * 384; i += gthreads) { const int tk = (int)(i / 384), q = (int)(i % 384);
            const float z = zshift(ZB, tk, 1536 + q, mu[1536 + q]);
            LORAA[i] = f2bf(q < 128 ? tanhf(z) : (q < 256 ? z : sigm(z))); }
    } break;
    case 8: {
        GemmArgs g{LORAA, (const bf16_t*)(ws + W_LORA), 384, 384, 384}; StaticOrder S; S.init(TOK, 2560, bid);
        gemm_phase(lds, g, S, EpiLora{LW, IC, GG, IN(I_W0) + L * 1024, IN(I_A0) + L * 1024}, tid);
    } break;
    case 9: {
        const float* mu = IN(I_MU) + L * 1920; const float* kkw = IN(I_KK) + L * 512; const float* kaw = IN(I_KA) + L * 512;
        for (int task = bid; task < 16 * WNC; task += gridDim.x) { const int hd = task / WNC, c = task % WNC, dir = hd >> 3, head = hd & 7;
            const int row = tid >> 2, sub = tid & 3; float s[16];
            UNR for (int i = 0; i < 16; ++i) s[i] = (row >= 64 && (row - 64) == sub * 16 + i) ? 1.f : 0.f;
            for (int sc = 0; sc < WCH / WSC; ++sc) {
                __syncthreads();
                wkv_stage(sm, ZB, LW, IC, mu, kkw, kaw, dir, head, c * WCH + sc * WSC, tid);
                __syncthreads();
                wkv_steps<16, false>(s, sm, sm + 1664, sm + 2 * 1664, sm + 3 * 1664, sm + 4 * 1664, sm + 5 * 1664, nullptr, WSC, row & 63, row < 64, sub, lane);
            }
            float* dst = PQ + ((size_t)hd * WNC + c) * 8192 + (row < 64 ? 0 : 4096) + (row & 63) * 64 + sub * 16;
            UNR for (int i = 0; i < 16; i += 4) *(f32x4*)(dst + i) = (f32x4){s[i], s[i + 1], s[i + 2], s[i + 3]};
        }
    } break;
    case 10: {
        for (int task = bid; task < 128; task += gridDim.x) { const int hd = task >> 3, rg = task & 7, r = tid >> 6, i = tid & 63, vrow = rg * 8 + r;
            float sv = 0.f; float* Ps = sm + 512;
            const float* P0 = PQ + ((size_t)hd * WNC) * 8192;
            f32x4 pa = *(const f32x4*)(P0 + 4096 + tid * 8), pb = *(const f32x4*)(P0 + 4096 + tid * 8 + 4); float qc = P0[vrow * 64 + i];
            for (int c = 0; c < WNC; ++c) {
                __syncthreads();
                *(f32x4*)(Ps + tid * 8) = pa; *(f32x4*)(Ps + tid * 8 + 4) = pb; sm[r * 64 + i] = sv;
                SCS[((size_t)hd * WNC + c) * 4096 + vrow * 64 + i] = sv;
                float a2 = qc;
                if (c + 1 < WNC) { const float* P1 = PQ + ((size_t)hd * WNC + c + 1) * 8192; pa = *(const f32x4*)(P1 + 4096 + tid * 8); pb = *(const f32x4*)(P1 + 4096 + tid * 8 + 4); qc = P1[vrow * 64 + i]; }
                __syncthreads();
#pragma unroll 16
                for (int a = 0; a < 64; ++a) a2 += sm[r * 64 + a] * Ps[a * 64 + i];
                sv = a2;
            }
            __syncthreads();
        }
    } break;
    case 11: {
        const float* mu = IN(I_MU) + L * 1920; const float* kkw = IN(I_KK) + L * 512; const float* kaw = IN(I_KA) + L * 512;
        for (int task = bid; task < 16 * WNC; task += gridDim.x) { const int hd = task / WNC, c = task % WNC, dir = hd >> 3, head = hd & 7;
            const int row = tid >> 3, sub = tid & 7; float s[8];
            { const float* src = SCS + ((size_t)hd * WNC + c) * 4096 + row * 64 + sub * 8; UNR for (int i = 0; i < 8; ++i) s[i] = src[i]; }
            bf16_t* YD = dir == 0 ? YB : YD1; float* sy = sm + 6 * 1664;
            for (int sc = 0; sc < WCH / WSC; ++sc) { const int p0 = c * WCH + sc * WSC;
                __syncthreads();
                wkv_stage(sm, ZB, LW, IC, mu, kkw, kaw, dir, head, p0, tid);
                __syncthreads();
                wkv_steps<8, true>(s, sm, sm + 1664, sm + 2 * 1664, sm + 3 * 1664, sm + 4 * 1664, sm + 5 * 1664, sy, WSC, row, true, sub, lane);
                __syncthreads();
                for (int e = tid; e < WSC * 64; e += NTHR) { const int jj = e >> 6, vch = e & 63; YD[(size_t)tok_of(dir, p0 + jj) * 512 + head * 64 + vch] = f2bf(sy[e]); }
            }
        }
    } break;
    case 12: {
        const float* mu = IN(I_MU) + L * 1920; const float* kaw = IN(I_KA) + L * 512; const float* rk = IN(I_RK) + L * 512;
        const float* lnw = IN(I_LNW) + L * 512; const float* lnb = IN(I_LNB) + L * 512;
        for (int wt = bid * 8 + wid; wt < TOK * 8; wt += gridDim.x * 8) { const int tk = wt >> 3, head = wt & 7, col = head * 64 + lane; const size_t o = (size_t)tk * 512 + col;
            const float y = bf2f(YB[o]) + bf2f(YD1[o]);
            const float mean = wave_sum(y, lane) * (1.0f / 64.0f); const float dv = y - mean; const float var = wave_sum(dv * dv, lane) * (1.0f / 64.0f);
            float yn = dv * rsqrtf(var + 64e-5f) * lnw[col] + lnb[col];
            const float r = zshift(ZB, tk, col, mu[col]), kx = zshift(ZB, tk, 512 + col, mu[512 + col]), v = zshift(ZB, tk, 1024 + col, mu[1024 + col]);
            const float ic0 = bf2f(IC[o]), ic1 = bf2f(IC[(size_t)TOK * 512 + o]);
            const float kd0 = kx * (1.0f + (ic0 - 1.0f) * kaw[col]), kd1 = kx * (1.0f + (ic1 - 1.0f) * kaw[col]);
            const float bon = wave_sum(r * (kd0 + kd1) * rk[col], lane);
            yn += bon * v;
            YB[o] = f2bf(yn * bf2f(GG[o])); }
        __syncthreads();
        conv_T(IN(I_WIN) + (size_t)L * 1024 * 6528, 6528, (bf16_t*)(ws + W_INZG), 3072, 1024, MapOff{3456}, sm, 0, tid, bid);
        for (int kb = 0; kb < 3; ++kb) conv_T(IN(I_WBR) + ((size_t)L * 3 + kb) * 512 * 1024, 1024, (bf16_t*)(ws + W_BR) + (size_t)kb * 1024 * 512, 1024, 512, MapOff{0}, sm, kb * 64, tid, bid);
        conv_T(IN(I_WOUT) + (size_t)L * 1024 * 1024, 1024, (bf16_t*)(ws + W_OUT), 1024, 1024, MapOff{0}, sm, 192, tid, bid);
        conv_T(IN(I_WFIN) + (size_t)L * 1024 * 5632, 5632, (bf16_t*)(ws + W_FIN), 5632, 1024, MapFfn(), sm, 0, tid, bid);
        conv_T(IN(I_WFOUT) + (size_t)L * 2816 * 1024, 1024, (bf16_t*)(ws + W_FOUT), 1024, 2816, MapOff{0}, sm, 128, tid, bid);
        norm_rows(H, IN(I_NORM1) + L * 1024, modl, modc, 0, 1024, HN, row0, tid, bid);
    } break;
    case 13: {
        GemmArgs g{HN + (size_t)row0 * 1024, (const bf16_t*)(ws + W_INZG), 1024, 1024, 1024}; StaticOrder S; S.init(Mrows, 3072, bid);
        gemm_phase(lds, g, S, EpiZg{ZG, row0}, tid);
    } break;
    case 14: {
        GemmArgs g{YS + (size_t)row0 * 512, (const bf16_t*)(ws + W_BR), 512, 512, 512}; TripleOrder S; S.init(Mrows, bid);
        gemm_phase(lds, g, S, EpiMerge1{ZG, MM, row0}, tid);
    } break;
    case 15: {
        GemmArgs g{MM + (size_t)row0 * 1024, (const bf16_t*)(ws + W_OUT), 1024, 1024, 1024}; StaticOrder S; S.init(Mrows, 1024, bid);
        gemm_phase(lds, g, S, EpiRes{H, modl + 2048, modc + 2048, row0}, tid);
    } break;
    case 16: {
        norm_rows(H, IN(I_NORM2) + L * 1024, modl, modc, 3072, 4096, HN, row0, tid, bid);
    } break;
    case 17: {
        GemmArgs g{HN + (size_t)row0 * 1024, (const bf16_t*)(ws + W_FIN), 1024, 1024, 1024}; StaticOrder S; S.init(Mrows, 5632, bid);
        gemm_phase(lds, g, S, EpiFfn{ACT, row0}, tid);
    } break;
    case 18: {
        GemmArgs g{ACT + (size_t)row0 * 2816, (const bf16_t*)(ws + W_FOUT), 2816, 2816, 2816}; StaticOrder S; S.init(Mrows, 1024, bid);
        gemm_phase(lds, g, S, EpiRes{H, modl + 5120, modc + 5120, row0}, tid);
    } break;
    }
}

#undef wid
#undef lane
#undef gtid
#undef gthreads
__device__ __forceinline__ void grid_bar(unsigned* ctr, unsigned target) {
    asm volatile("s_waitcnt vmcnt(0) lgkmcnt(0)" ::: "memory");
    __syncthreads();
    if (threadIdx.x == 0) {
        __builtin_amdgcn_fence(__ATOMIC_RELEASE, "agent");
        asm volatile("s_waitcnt vmcnt(0)" ::: "memory");
        __hip_atomic_fetch_add(ctr, 1u, __ATOMIC_RELAXED, __HIP_MEMORY_SCOPE_AGENT);
        while (__hip_atomic_load(ctr, __ATOMIC_RELAXED, __HIP_MEMORY_SCOPE_AGENT) < target) __builtin_amdgcn_s_sleep(1);
    }
    __syncthreads();
    __builtin_amdgcn_fence(__ATOMIC_ACQUIRE, "agent");
    asm volatile("s_waitcnt vmcnt(0)" ::: "memory");
}
#if SINGLE_LAUNCH
__global__ void __launch_bounds__(NTHR, 2) fwd_megakernel(Params p, int ph_lo, int ph_hi) {
    extern __shared__ __attribute__((aligned(16))) unsigned char shm[];
    if (blockIdx.x == 0 && threadIdx.x == 0) __hip_atomic_store((unsigned*)(p.ws + M_BAR), 0u, __ATOMIC_RELAXED, __HIP_MEMORY_SCOPE_AGENT);
    { cg::grid_group grid = cg::this_grid(); grid.sync(); }
    const int wv = __builtin_amdgcn_readfirstlane(threadIdx.x >> 6);
    unsigned nbar = 0;
#ifdef USE_CG_SYNC
#define MK_SYNC do { asm volatile("s_waitcnt vmcnt(0) lgkmcnt(0)" ::: "memory"); __syncthreads(); cg::this_grid().sync(); } while (0)
#else
#define MK_SYNC do { nbar += gridDim.x; grid_bar((unsigned*)(p.ws + M_BAR), nbar); } while (0)
#endif
#ifdef MK_SWITCH
    for (int ph = 0; ph < NPHASE; ++ph) { run_phase<-1>(p, ph, shm, wv); if (ph + 1 < NPHASE) MK_SYNC; }
}
#else
    run_phase<100>(p, 0, shm, wv); MK_SYNC;
#define MK_LAYER(LL) do { const int base = 1 + (LL) * PH_PER_LAYER; \
        run_phase<0>(p, base + 0, shm, wv); MK_SYNC;   run_phase<1>(p, base + 1, shm, wv); MK_SYNC;   run_phase<2>(p, base + 2, shm, wv); MK_SYNC; \
        run_phase<3>(p, base + 3, shm, wv); MK_SYNC;   run_phase<4>(p, base + 4, shm, wv); MK_SYNC;   run_phase<5>(p, base + 5, shm, wv); MK_SYNC; \
        run_phase<6>(p, base + 6, shm, wv); MK_SYNC;   run_phase<7>(p, base + 7, shm, wv); MK_SYNC;   run_phase<8>(p, base + 8, shm, wv); MK_SYNC; \
        run_phase<9>(p, base + 9, shm, wv); MK_SYNC;   run_phase<10>(p, base + 10, shm, wv); MK_SYNC; run_phase<11>(p, base + 11, shm, wv); MK_SYNC; \
        run_phase<12>(p, base + 12, shm, wv); MK_SYNC; run_phase<13>(p, base + 13, shm, wv); MK_SYNC; run_phase<14>(p, base + 14, shm, wv); MK_SYNC; \
        run_phase<15>(p, base + 15, shm, wv); MK_SYNC; run_phase<16>(p, base + 16, shm, wv); MK_SYNC; run_phase<17>(p, base + 17, shm, wv); MK_SYNC; \
        run_phase<18>(p, base + 18, shm, wv); MK_SYNC; } while (0)
    MK_LAYER(0); MK_LAYER(1); MK_LAYER(2); MK_LAYER(3);
    run_phase<101>(p, NPHASE - 1, shm, wv);
}
#endif
#endif
template <int KSEL>
__global__ void __launch_bounds__(NTHR, 2) phase_kernel(Params p, int ph) {
    extern __shared__ __attribute__((aligned(16))) unsigned char shm[];
    run_phase<KSEL>(p, ph, shm, __builtin_amdgcn_readfirstlane(threadIdx.x >> 6));
}
template <int KSEL> static void launch_phase(const Params& p, int ph, int grid, hipStream_t stream) {
    static bool attr = false;
    if (!attr) { (void)hipFuncSetAttribute((const void*)phase_kernel<KSEL>, hipFuncAttributeMaxDynamicSharedMemorySize, LDS_BYTES); attr = true; }
    phase_kernel<KSEL><<<grid, NTHR, LDS_BYTES, stream>>>(p, ph);
}

extern "C" void kernel_launch(void* const* d_in, const int* in_sizes, int n_in, void* d_out, int out_size, void* d_ws, size_t ws_size, hipStream_t stream) {
    static int grid = 0;
    if (grid == 0) {
        if (n_in != 42 || ws_size < WS_END) { fprintf(stderr, "kernel_launch: unexpected n_in %d or ws %zu < %zu\n", n_in, ws_size, (size_t)WS_END); grid = -1; return; }
        int dev = 0, cus = 0;
        (void)hipGetDevice(&dev); (void)hipDeviceGetAttribute(&cus, hipDeviceAttributeMultiprocessorCount, dev);
#if SINGLE_LAUNCH
        if (hipFuncSetAttribute((const void*)fwd_megakernel, hipFuncAttributeMaxDynamicSharedMemorySize, LDS_BYTES) != hipSuccess) { fprintf(stderr, "hipFuncSetAttribute failed\n"); grid = -1; return; }
#endif
        (void)hipGetLastError();
        grid = cus;
    }
    if (grid < 0) return;
    Params p{};
    for (int i = 0; i < 42; ++i) p.in[i] = (const float*)d_in[i];
    p.out = (float*)d_out; p.ws = (unsigned char*)d_ws;
#if SINGLE_LAUNCH
    (void)hipMemsetAsync((unsigned char*)d_ws + M_BAR, 0, 256, stream);
    int lo = 0, hi = NPHASE;
    void* args[] = {&p, &lo, &hi};
    hipError_t e = hipLaunchCooperativeKernel((const void*)fwd_megakernel, dim3(grid), dim3(NTHR), args, LDS_BYTES, stream);
    if (e != hipSuccess) fprintf(stderr, "cooperative launch failed: %s (grid %d)\n", hipGetErrorString(e), grid);
#else
    for (int ph = 0; ph < NPHASE; ++ph) {
        if (ph == 0) { launch_phase<100>(p, ph, grid, stream); continue; }
        if (ph == NPHASE - 1) { launch_phase<101>(p, ph, grid, stream); continue; }
        switch ((ph - 1) % PH_PER_LAYER) {
        case 0: launch_phase<0>(p, ph, grid, stream); break;   case 1: launch_phase<1>(p, ph, grid, stream); break;
        case 2: launch_phase<2>(p, ph, grid, stream); break;   case 3: launch_phase<3>(p, ph, grid, stream); break;
        case 4: launch_phase<4>(p, ph, grid, stream); break;   case 5: launch_phase<5>(p, ph, grid, stream); break;
        case 6: launch_phase<6>(p, ph, grid, stream); break;   case 7: launch_phase<7>(p, ph, grid, stream); break;
        case 8: launch_phase<8>(p, ph, grid, stream); break;   case 9: launch_phase<9>(p, ph, grid, stream); break;
        case 10: launch_phase<10>(p, ph, grid, stream); break; case 11: launch_phase<11>(p, ph, grid, stream); break;
        case 12: launch_phase<12>(p, ph, grid, stream); break; case 13: launch_phase<13>(p, ph, grid, stream); break;
        case 14: launch_phase<14>(p, ph, grid, stream); break; case 15: launch_phase<15>(p, ph, grid, stream); break;
        case 16: launch_phase<16>(p, ph, grid, stream); break; case 17: launch_phase<17>(p, ph, grid, stream); break;
        case 18: launch_phase<18>(p, ph, grid, stream); break;
        }
    }
#endif
}
```

```cpp
#define TID_MBCNT 1
#include <hip/hip_runtime.h>
#include <hip/hip_cooperative_groups.h>
#include <cstdio>
namespace cg = cooperative_groups;

#define LAS __attribute__((address_space(3)))
#define UNR _Pragma("unroll")
typedef unsigned short bf16_t;
typedef short bf16x8 __attribute__((ext_vector_type(8)));
typedef float f32x4 __attribute__((ext_vector_type(4)));
typedef unsigned u32x2 __attribute__((ext_vector_type(2)));
typedef unsigned u32x4 __attribute__((ext_vector_type(4)));

constexpr int TOK = 16640, NLAYER = 4;
#ifndef SINGLE_LAUNCH
#define SINGLE_LAUNCH 1
#endif
constexpr int NTHR = 512;
constexpr int LDS_BYTES = 131072;

constexpr size_t SZ_TB512 = (size_t)TOK * 512 * 2;
constexpr size_t OFF_H = 0;
constexpr size_t OFF_HN = OFF_H + (size_t)TOK * 1024 * 4;
constexpr size_t OFF_W1 = OFF_HN + (size_t)TOK * 1024 * 2;
constexpr size_t W_INA = OFF_W1;
constexpr size_t W_LRU = W_INA + (size_t)3584 * 1024 * 2;
constexpr size_t W_LORA = W_LRU + (size_t)2048 * 512 * 2;
constexpr size_t W_S5Y = W_LORA + (size_t)2560 * 384 * 2;
constexpr size_t W_S5E = W_S5Y + (size_t)32 * 256 * 512 * 2;
constexpr size_t W_GLU = W_S5E + (size_t)32 * 256 * 256 * 2;
constexpr size_t OFF_YS = W_GLU + (size_t)512 * 512 * 2;
constexpr size_t OFF_ZB = OFF_YS + 3 * SZ_TB512;
constexpr size_t OFF_MISC = OFF_ZB + (size_t)TOK * 2048 * 2;
constexpr size_t M_MODV = OFF_MISC;
constexpr size_t M_PW = M_MODV + (size_t)4 * 2 * 6144 * 4;
constexpr size_t M_BB = M_PW + (size_t)4 * 2 * 32 * 64 * 17 * 2 * 4;
constexpr size_t M_CA = M_BB + (size_t)4 * 2 * 32 * 64 * 16 * 2 * 4;
constexpr size_t M_CB = M_CA + (size_t)2 * 260 * 512 * 4;
constexpr size_t M_HIN = M_CB + (size_t)2 * 260 * 512 * 4;
constexpr size_t M_KT = M_HIN + (size_t)2 * 260 * 512 * 4;
constexpr size_t M_BAR = OFF_MISC + 16777216 - 4096;
constexpr size_t OFF_X = OFF_MISC + 16777216;
constexpr size_t X_ZA = OFF_X;
constexpr size_t X_XC = X_ZA + (size_t)TOK * 1536 * 2;
constexpr size_t X_LA = X_XC + SZ_TB512;
constexpr size_t X_LU = X_LA + 2 * SZ_TB512;
constexpr size_t X_A5 = X_LU + 2 * SZ_TB512;
constexpr size_t X_LW = OFF_X;
constexpr size_t X_IC = X_LW + 2 * SZ_TB512;
constexpr size_t X_G = X_IC + 2 * SZ_TB512;
constexpr size_t X_YD1 = X_G + SZ_TB512;
constexpr size_t X_LORAA = X_YD1 + SZ_TB512;
constexpr size_t X_PQ = X_LORAA + (size_t)TOK * 384 * 2;
constexpr size_t X_SC = X_PQ + (size_t)16 * 80 * 8192 * 4;
constexpr size_t X_ZG = OFF_X;
constexpr size_t X_ACT = OFF_X;
constexpr size_t W_INZG = X_PQ;
constexpr size_t W_BR = W_INZG + (size_t)3072 * 1024 * 2;
constexpr size_t W_OUT = W_BR + (size_t)3 * 1024 * 512 * 2;
constexpr size_t W_FIN = W_OUT + (size_t)1024 * 1024 * 2;
constexpr size_t W_FOUT = W_FIN + (size_t)5632 * 1024 * 2;
constexpr size_t X_M = W_FOUT + (size_t)1024 * 2816 * 2;
constexpr size_t WS_END = X_M + (size_t)TOK * 1024 * 2 + 1048576;

struct Params { const float* in[42]; float* out; unsigned char* ws; };

enum { I_X = 0, I_C, I_CTX, I_CCTX, I_WMOD, I_BMOD, I_NORM1, I_NORM2, I_NORMF, I_WIN, I_CONVW, I_CONVB, I_WA, I_BA, I_WX, I_BX, I_LAM,
       I_MU, I_W0, I_W2, I_A0, I_A2, I_G2, I_KK, I_KA, I_RK, I_LNW, I_LNB, I_S5LRE, I_S5LIM, I_S5STEP, I_S5BRE, I_S5BIM, I_S5CRE, I_S5CIM,
       I_S5D, I_WGLU, I_BGLU, I_WBR, I_WOUT, I_WFIN, I_WFOUT };

__device__ __forceinline__ bf16_t f2bf(float f) { unsigned u = __float_as_uint(f); u += 0x7FFFu + ((u >> 16) & 1u); return (bf16_t)(u >> 16); }
__device__ __forceinline__ float bf2f(bf16_t b) { return __uint_as_float(((unsigned)b) << 16); }
typedef __bf16 bf16x2_t __attribute__((ext_vector_type(2)));
typedef float f32x2_t __attribute__((ext_vector_type(2)));
__device__ __forceinline__ unsigned pack2(float a, float b) { f32x2_t v = {a, b}; bf16x2_t r = __builtin_convertvector(v, bf16x2_t); return __builtin_bit_cast(unsigned, r); }
__device__ __forceinline__ void st4bf(bf16_t* p, float a, float b, float c, float d) { u32x2 w; w.x = pack2(a, b); w.y = pack2(c, d); *(u32x2*)p = w; }
__device__ __forceinline__ void ld4bf(const bf16_t* p, float (&o)[4]) { u32x2 w = *(const u32x2*)p; o[0] = __uint_as_float(w.x << 16); o[1] = __uint_as_float(w.x & 0xFFFF0000u); o[2] = __uint_as_float(w.y << 16); o[3] = __uint_as_float(w.y & 0xFFFF0000u); }
#ifdef OLD_SIGM
__device__ __forceinline__ float sigm(float x) { return 1.0f / (1.0f + __expf(-x)); }
#else
__device__ __forceinline__ float sigm(float x) { return __builtin_amdgcn_rcpf(1.0f + __expf(-x)); }
#endif
__device__ __forceinline__ float softplusf(float x) { return x > 15.f ? x : __logf(1.0f + __expf(x)); }
__device__ __forceinline__ float gelu_t(float x) { float t = tanhf(0.7978845608028654f * (x + 0.044715f * x * x * x)); return 0.5f * x * (1.0f + t); }
__device__ __forceinline__ float silu(float x) { return x * sigm(x); }
__device__ __forceinline__ int tok_of(int dir, int p) { return dir == 0 ? p : (p < 256 ? 255 - p : 16895 - p); }
__device__ __forceinline__ int s5_tok(int p) { if (p < 256) return p; int q = p - 256; return 256 + (q & 255) * 64 + (q >> 8); }
__device__ __forceinline__ float shx(float v, int o, int lane) { return __int_as_float(__builtin_amdgcn_ds_bpermute((lane ^ o) << 2, __float_as_int(v))); }
__device__ __forceinline__ float wave_sum(float v, int lane) {
#pragma unroll
    for (int o = 32; o >= 1; o >>= 1) v += shx(v, o, lane);
    return v;
}
__device__ __forceinline__ float zshift(const bf16_t* ZB, int tk, int col, float mu) {
    const int lo = tk < 256 ? 0 : 256, hi = tk < 256 ? 256 : TOK;
    const float z = bf2f(ZB[(size_t)tk * 2048 + col]);
    const float zp = (tk - 1 >= lo) ? bf2f(ZB[(size_t)(tk - 1) * 2048 + col]) : 0.f;
    const float zn = (tk + 1 < hi) ? bf2f(ZB[(size_t)(tk + 1) * 2048 + col]) : 0.f;
    return z + mu * (0.5f * (zp + zn) - z);
}

constexpr int BM = 256, BK = 64, HALF = 128, HTB = HALF * BK * 2, NXCD = 8, WGM = 8;
__device__ __forceinline__ int lds_byte(int r, int c) { const int st = (r >> 4) * 2 + (c >> 5), rr = r & 15, cc = c & 31, ob = rr * 64 + cc * 2; return st * 1024 + (ob ^ (((ob >> 9) & 1) << 5)); }
__device__ __forceinline__ void stage_rc(int b, int& R, int& C) { const int st = b / 1024, sb = b % 1024, swz = sb ^ (((sb >> 9) & 1) << 5); R = (st >> 1) * 16 + swz / 64; C = (st & 1) * 32 + (swz % 64) / 2; }

struct Unit { int pm, pn, g; };
struct GemmArgs { const bf16_t* A; const bf16_t* Bt; int lda, ldb, K; };

struct StaticOrder {
    int nM, nN, nwg, G, c;
    __device__ void init(int M, int N, int bid_l) { nM = M / BM; nN = N / BM; nwg = nM * nN; G = gridDim.x; c = bid_l; }
    __device__ bool next(int i, Unit& u) const {
        const long L = (long)i * G + c; if (L >= nwg) return false;
        int wgid = (int)L; { const int q = nwg / NXCD, r = nwg % NXCD, xcd = wgid % NXCD, off = wgid / NXCD; wgid = (xcd < r ? xcd * (q + 1) : r * (q + 1) + (xcd - r) * q) + off; }
        const int nig = WGM * nN, gid = wgid / nig, fm = gid * WGM, gsz = (nM - fm) < WGM ? (nM - fm) : WGM;
        u.pm = fm + ((wgid % nig) % gsz); u.pn = (wgid % nig) / gsz; u.g = 0; return true;
    }
    __device__ const char* aptr(const GemmArgs& g, const Unit& u) const { return (const char*)g.A + (size_t)u.pm * 256 * g.lda * 2; }
    __device__ const char* bptr(const GemmArgs& g, const Unit& u) const { return (const char*)g.Bt + (size_t)u.pn * 256 * g.ldb * 2; }
};
struct S5Order {
    int G, c;
    __device__ void init(int shift, int bid_l) { G = gridDim.x; c = (bid_l + shift) % gridDim.x; }
    __device__ bool next(int i, Unit& u) const { const int L = i * G + c; if (L >= 160) return false; u.g = L / 5; u.pm = L % 5; u.pn = 0; return true; }
    __device__ const char* aptr(const GemmArgs& g, const Unit& u) const { return (const char*)g.A + (size_t)(u.g * 1040 + u.pm * 256) * g.lda * 2; }
    __device__ const char* bptr(const GemmArgs& g, const Unit& u) const { return (const char*)g.Bt + (size_t)u.g * 256 * g.ldb * 2; }
};
struct TripleOrder {
    int nM, G, c;
    __device__ void init(int M, int bid_l) { nM = M / BM; G = gridDim.x; c = bid_l; }
    __device__ bool next(int i, Unit& u) const { const int L = (i / 3) * G + c; if (L >= nM * 4) return false; u.pm = L >> 2; u.pn = L & 3; u.g = i % 3; return true; }
    __device__ const char* aptr(const GemmArgs& g, const Unit& u) const { return (const char*)g.A + (size_t)u.g * SZ_TB512 + (size_t)u.pm * 256 * 512 * 2; }
    __device__ const char* bptr(const GemmArgs& g, const Unit& u) const { return (const char*)g.Bt + (size_t)(u.g * 1024 + u.pn * 256) * 512 * 2; }
};

template <class Epi, class Ord>
__device__ __forceinline__ void gemm_phase(LAS unsigned char* lds, const GemmArgs g, const Ord& S, const Epi& E, int tid_l) {
    const int tid = tid_l, wid = __builtin_amdgcn_readfirstlane(tid >> 6), lane = tid & 63, wr = wid >> 2, wc = wid & 3, fr = lane & 15, fq = lane >> 4;
    const int K = g.K, nt = K / BK;
    unsigned voffA, voffB;
    { int R, C; stage_rc(tid * 16, R, C); voffA = (unsigned)(R * g.lda + C) * 2u; voffB = (unsigned)(R * g.ldb + C) * 2u; }
    const size_t p64A = (size_t)64 * g.lda * 2, p64B = (size_t)64 * g.ldb * 2;
    const size_t kstep = (size_t)(BK * 2);
    const size_t hstepA = (size_t)HALF * g.lda * 2, hstepB = (size_t)HALF * g.ldb * 2;
    const unsigned ldsw = (unsigned)wid * 1024u;
    const int aoff = lds_byte(wr * 64 + fr, fq * 8), boff = lds_byte(wc * 32 + fr, fq * 8);
#define PG8_SA(b, h) (((b) * 2 + (h)) * HTB)
#define PG8_SB(b, h) ((4 + (b) * 2 + (h)) * HTB)
#define PG8_STAGE(bufoff, gbase, voff) do { _Pragma("unroll") for (int _i = 0; _i < 2; ++_i) \
        __builtin_amdgcn_global_load_lds((const unsigned*)((const char*)(gbase) + _i * p64_##voff + v_##voff), (LAS unsigned*)(lds + (bufoff) + ldsw + _i * 8192), 16, 0, 0); } while (0)
#define PG8_LDA(dst, b, h) do { _Pragma("unroll") for (int m = 0; m < 4; ++m) _Pragma("unroll") for (int k = 0; k < 2; ++k) dst[m][k] = *(const LAS bf16x8*)(lds + PG8_SA(b, h) + aoff + m * 2048 + k * 1024); } while (0)
#define PG8_LDB(dst, b, h) do { _Pragma("unroll") for (int n = 0; n < 2; ++n) _Pragma("unroll") for (int k = 0; k < 2; ++k) dst[n][k] = *(const LAS bf16x8*)(lds + PG8_SB(b, h) + boff + n * 2048 + k * 1024); } while (0)
#define PG8_MMA(ai, bj, At, Bt) do { __builtin_amdgcn_s_setprio(1); _Pragma("unroll") for (int m = 0; m < 4; ++m) _Pragma("unroll") for (int n = 0; n < 2; ++n) _Pragma("unroll") for (int k = 0; k < 2; ++k) \
        acc[ai][bj][m][n] = __builtin_amdgcn_mfma_f32_16x16x32_bf16(Bt[n][k], At[m][k], acc[ai][bj][m][n], 0, 0, 0); __builtin_amdgcn_s_setprio(0); } while (0)
#define p64_offA p64A
#define p64_offB p64B
#define v_offA voffA
#define v_offB voffB
#define PG8_WAIT_V(n) asm volatile("s_waitcnt vmcnt(" #n ")" ::: "memory")
#define PG8_WAIT_L(n) asm volatile("s_waitcnt lgkmcnt(" #n ")" ::: "memory")
#define PG8_BAR __builtin_amdgcn_s_barrier()
#define PG8_SCHED __builtin_amdgcn_sched_barrier(0)
    Unit cur, nxt; int ui = 0;
    if (!S.next(0, cur)) return;
    f32x4 acc[2][2][4][2];
#pragma unroll
    for (int a = 0; a < 2; ++a)
#pragma unroll
        for (int b = 0; b < 2; ++b)
#pragma unroll
            for (int m = 0; m < 4; ++m)
#pragma unroll
                for (int n = 0; n < 2; ++n) acc[a][b][m][n] = (f32x4){0.f, 0.f, 0.f, 0.f};
    bf16x8 At[4][2], B0[2][2], B1[2][2];
    const char* cA = S.aptr(g, cur); const char* cB = S.bptr(g, cur);
    PG8_STAGE(PG8_SB(0, 0), cB, offB); PG8_STAGE(PG8_SA(0, 0), cA, offA); PG8_STAGE(PG8_SB(0, 1), cB + hstepB, offB); PG8_STAGE(PG8_SA(0, 1), cA + hstepA, offA);
    if (wr == 1) PG8_BAR;
    PG8_WAIT_V(4); PG8_BAR;
    PG8_STAGE(PG8_SB(1, 0), cB + kstep, offB); PG8_STAGE(PG8_SA(1, 0), cA + kstep, offA); PG8_STAGE(PG8_SB(1, 1), cB + hstepB + kstep, offB);
    PG8_WAIT_V(6); PG8_BAR;
    for (;;) {
        const bool has_next = S.next(ui + 1, nxt);
        const char* nA = has_next ? S.aptr(g, nxt) : cA; const char* nB = has_next ? S.bptr(g, nxt) : cB;
        for (int t = 0; t < nt; t += 2) {
            const bool last = (t == nt - 2);
            const char* a1 = cA + (size_t)(t + 1) * kstep;
            const char* a2 = last ? nA : cA + (size_t)(t + 2) * kstep; const char* b2 = last ? nB : cB + (size_t)(t + 2) * kstep;
            const char* a3 = a2 + kstep; const char* b3 = b2 + kstep;
            PG8_LDB(B0, 0, 0); PG8_SCHED; PG8_LDA(At, 0, 0); PG8_STAGE(PG8_SA(1, 1), a1 + hstepA, offA);
            PG8_WAIT_L(8); PG8_BAR; PG8_WAIT_L(0); PG8_MMA(0, 0, At, B0); PG8_BAR; PG8_SCHED;
            PG8_LDB(B1, 0, 1); PG8_STAGE(PG8_SB(0, 0), b2, offB);
            PG8_BAR; PG8_WAIT_L(0); PG8_MMA(0, 1, At, B1); PG8_BAR;
            PG8_LDA(At, 0, 1); PG8_STAGE(PG8_SA(0, 0), a2, offA);
            PG8_BAR; PG8_WAIT_L(0); PG8_MMA(1, 0, At, B0); PG8_BAR; PG8_SCHED;
            PG8_STAGE(PG8_SB(0, 1), b2 + hstepB, offB);
            PG8_WAIT_V(6); PG8_BAR; PG8_MMA(1, 1, At, B1); PG8_BAR;
            PG8_LDB(B0, 1, 0); PG8_SCHED; PG8_LDA(At, 1, 0); PG8_STAGE(PG8_SA(0, 1), a2 + hstepA, offA);
            PG8_WAIT_L(8); PG8_BAR; PG8_WAIT_L(0); PG8_MMA(0, 0, At, B0); PG8_BAR; PG8_SCHED;
            PG8_LDB(B1, 1, 1); PG8_STAGE(PG8_SB(1, 0), b3, offB);
            PG8_BAR; PG8_WAIT_L(0); PG8_MMA(0, 1, At, B1); PG8_BAR;
            PG8_LDA(At, 1, 1); PG8_STAGE(PG8_SA(1, 0), a3, offA);
            PG8_BAR; PG8_WAIT_L(0); PG8_MMA(1, 0, At, B0); PG8_BAR; PG8_SCHED;
            PG8_STAGE(PG8_SB(1, 1), b3 + hstepB, offB);
            PG8_WAIT_V(6); PG8_BAR; PG8_MMA(1, 1, At, B1); PG8_BAR;
        }
        E(acc, cur, wr, wc, fr, fq);
        if (!has_next) break;
#pragma unroll
        for (int a = 0; a < 2; ++a)
#pragma unroll
            for (int b = 0; b < 2; ++b)
#pragma unroll
                for (int m = 0; m < 4; ++m)
#pragma unroll
                    for (int n = 0; n < 2; ++n) acc[a][b][m][n] = (f32x4){0.f, 0.f, 0.f, 0.f};
        cur = nxt; cA = nA; cB = nB; ++ui;
    }
    PG8_WAIT_V(0);
    if (wr == 0) PG8_BAR;
    PG8_BAR;
#undef p64_offA
#undef p64_offB
#undef v_offA
#undef v_offB
#undef PG8_SA
#undef PG8_SB
#undef PG8_STAGE
#undef PG8_LDA
#undef PG8_LDB
#undef PG8_MMA
#undef PG8_WAIT_V
#undef PG8_WAIT_L
#undef PG8_BAR
#undef PG8_SCHED
}

typedef f32x4 AccT[2][2][4][2];
#define EPI_ROWS _Pragma("unroll") for (int ai = 0; ai < 2; ++ai) _Pragma("unroll") for (int m = 0; m < 4; ++m)
#define EPI_BN _Pragma("unroll") for (int bj = 0; bj < 2; ++bj) _Pragma("unroll") for (int n = 0; n < 2; ++n)
#define EPI_B _Pragma("unroll") for (int bj = 0; bj < 2; ++bj)

#define EPI_ROW (__builtin_amdgcn_sched_barrier(0), u.pm * 256 + ai * 128 + wr * 64 + m * 16 + fr)
#define EPI_COL(bj, n) (u.pn * 256 + (bj) * 128 + wc * 32 + (n) * 16 + 4 * fq)

struct EpiZ {
    bf16_t* ZA; bf16_t* ZB;
    __device__ __forceinline__ void operator()(const AccT& acc, const Unit& u, int wr, int wc, int fr, int fq) const {
        EPI_ROWS { const int row = EPI_ROW;
            EPI_BN { const int col = EPI_COL(bj, n); const f32x4 v = acc[ai][bj][m][n];
                bf16_t* dst = col < 1536 ? ZA + (size_t)row * 1536 + col : ZB + (size_t)row * 2048 + (col - 1536);
                st4bf(dst, v[0], v[1], v[2], v[3]); } }
    }
};
struct EpiLruGate {
    const bf16_t* XC; bf16_t* LA; bf16_t* LU; const float* ba; const float* bx; const float* lam;
    __device__ __forceinline__ void operator()(const AccT& acc, const Unit& u, int wr, int wc, int fr, int fq) const {
        EPI_B { __builtin_amdgcn_sched_barrier(0);
            const int g32 = (u.pn * 256 + bj * 128 + wc * 32) >> 5, dir = g32 >> 5, ch = (g32 & 31) * 16 + 4 * fq;
            float pba[4], pbx[4], psp[4];
            UNR for (int j = 0; j < 4; ++j) { const int c = dir * 512 + ch + j; pba[j] = ba[c]; pbx[j] = bx[c]; psp[j] = -8.0f * softplusf(-lam[c]); }
            EPI_ROWS { const int row = EPI_ROW;
                const f32x4 va = acc[ai][bj][m][0], vx = acc[ai][bj][m][1];
                float xc[4]; ld4bf(XC + (size_t)row * 512 + ch, xc);
                float la[4], uu[4];
                UNR for (int j = 0; j < 4; ++j) {
                    const float gr = sigm(va[j] + pba[j]), gi = sigm(vx[j] + pbx[j]);
                    la[j] = gr * psp[j];
                    uu[j] = __fsqrt_rn(fmaxf(1.0f - __expf(2.0f * la[j]), 0.f)) * gi * xc[j]; }
                const size_t o = ((size_t)dir * TOK + row) * 512 + ch;
                st4bf(LA + o, la[0], la[1], la[2], la[3]); st4bf(LU + o, uu[0], uu[1], uu[2], uu[3]); } }
    }
};
struct EpiS5E {
    float* E;
    __device__ __forceinline__ void operator()(const AccT& acc, const Unit& u, int wr, int wc, int fr, int fq) const {
        EPI_ROWS { const int row = EPI_ROW; if (row < 1040) {
            EPI_BN { const int col = EPI_COL(bj, n);
                *(f32x4*)(E + ((size_t)u.g * 1040 + row) * 256 + col) = acc[ai][bj][m][n]; } } }
    }
};
struct EpiS5Y {
    const bf16_t* ZA; bf16_t* YG; const float* dsk;
    __device__ __forceinline__ void operator()(const AccT& acc, const Unit& u, int wr, int wc, int fr, int fq) const {
        EPI_ROWS { const int row = EPI_ROW; if (row < 1040) {
            EPI_BN { const int col = EPI_COL(bj, n); const f32x4 v = acc[ai][bj][m][n];
                const int t = col >> 4, cp = col & 15, tk = s5_tok(row * 16 + t), ch = u.g * 16 + cp;
                float uv[4]; ld4bf(ZA + (size_t)tk * 1536 + 1024 + ch, uv);
                float y[4]; UNR for (int j = 0; j < 4; ++j) y[j] = gelu_t(v[j] + dsk[ch + j] * uv[j]);
                st4bf(YG + (size_t)tk * 512 + ch, y[0], y[1], y[2], y[3]); } } }
    }
};
struct EpiGlu {
    const bf16_t* YG; bf16_t* YC; const float* bg;
    __device__ __forceinline__ void operator()(const AccT& acc, const Unit& u, int wr, int wc, int fr, int fq) const {
        EPI_ROWS { const int row = EPI_ROW;
            EPI_BN { const int col = EPI_COL(bj, n); const f32x4 v = acc[ai][bj][m][n];
                float y[4]; ld4bf(YG + (size_t)row * 512 + col, y);
                UNR for (int j = 0; j < 4; ++j) y[j] *= sigm(v[j] + bg[col + j]);
                st4bf(YC + (size_t)row * 512 + col, y[0], y[1], y[2], y[3]); } }
    }
};
struct EpiLora {
    bf16_t* LW; bf16_t* IC; bf16_t* G; const float* w0; const float* a0;
    __device__ __forceinline__ void operator()(const AccT& acc, const Unit& u, int wr, int wc, int fr, int fq) const {
        const int blk = u.pn >> 1;
        if (blk < 2) {
            EPI_BN { __builtin_amdgcn_sched_barrier(0); const int col = EPI_COL(bj, n); float b[4];
                UNR for (int j = 0; j < 4; ++j) b[j] = w0[col + j];
                EPI_ROWS { const int row = EPI_ROW; const f32x4 v = acc[ai][bj][m][n]; float o[4];
                    UNR for (int j = 0; j < 4; ++j) { const float wl = -softplusf(-(b[j] + v[j])) - 0.5f; o[j] = -__expf(wl); }
                    st4bf(LW + ((size_t)blk * TOK + row) * 512 + (col & 511), o[0], o[1], o[2], o[3]); } }
        } else if (blk < 4) {
            EPI_BN { __builtin_amdgcn_sched_barrier(0); const int col = EPI_COL(bj, n) - 1024; float b[4];
                UNR for (int j = 0; j < 4; ++j) b[j] = a0[col + j];
                EPI_ROWS { const int row = EPI_ROW; const f32x4 v = acc[ai][bj][m][n]; float o[4];
                    UNR for (int j = 0; j < 4; ++j) o[j] = sigm(b[j] + v[j]);
                    st4bf(IC + ((size_t)(blk - 2) * TOK + row) * 512 + (col & 511), o[0], o[1], o[2], o[3]); } }
        } else {
            EPI_ROWS { const int row = EPI_ROW;
                EPI_BN { const int col = EPI_COL(bj, n) - 2048; const f32x4 v = acc[ai][bj][m][n];
                    st4bf(G + (size_t)row * 512 + col, v[0], v[1], v[2], v[3]); } }
        }
    }
};
struct EpiZg {
    bf16_t* ZG; int row0;
    __device__ __forceinline__ void operator()(const AccT& acc, const Unit& u, int wr, int wc, int fr, int fq) const {
        EPI_ROWS { const int row = row0 + EPI_ROW;
            EPI_BN { const int col = EPI_COL(bj, n); const f32x4 v = acc[ai][bj][m][n];
                st4bf(ZG + (size_t)row * 3072 + col, sigm(v[0]), sigm(v[1]), sigm(v[2]), sigm(v[3])); } }
    }
};
struct EpiMerge1 {
    const bf16_t* ZG; bf16_t* M; int row0;
    __device__ __forceinline__ void operator()(const AccT& acc, const Unit& u, int wr, int wc, int fr, int fq) const {
        EPI_ROWS { const int row = row0 + EPI_ROW;
            EPI_BN { const int col = EPI_COL(bj, n); const f32x4 v = acc[ai][bj][m][n];
                float gt[4]; ld4bf(ZG + (size_t)row * 3072 + u.g * 1024 + col, gt);
                float mv[4] = {0.f, 0.f, 0.f, 0.f}; if (u.g) ld4bf(M + (size_t)row * 1024 + col, mv);
                st4bf(M + (size_t)row * 1024 + col, mv[0] + gt[0] * v[0], mv[1] + gt[1] * v[1], mv[2] + gt[2] * v[2], mv[3] + gt[3] * v[3]); } }
    }
};
struct EpiRes {
    float* H; const float* gl; const float* gc; int row0;
    __device__ __forceinline__ void operator()(const AccT& acc, const Unit& u, int wr, int wc, int fr, int fq) const {
        EPI_ROWS { const int row = row0 + EPI_ROW; const float* gv = row < 256 ? gc : gl;
            EPI_BN { const int col = EPI_COL(bj, n); const f32x4 v = acc[ai][bj][m][n];
                float* hp = H + (size_t)row * 1024 + col; f32x4 hv = *(f32x4*)hp; const f32x4 gg = *(const f32x4*)(gv + col);
                hv += gg * v; *(f32x4*)hp = hv; } }
    }
};
struct EpiFfn {
    bf16_t* ACT; int row0;
    __device__ __forceinline__ void operator()(const AccT& acc, const Unit& u, int wr, int wc, int fr, int fq) const {
        EPI_ROWS { const int row = row0 + EPI_ROW;
            EPI_B { const int g32 = (u.pn * 256 + bj * 128 + wc * 32) >> 5, oc = g32 * 16 + 4 * fq;
                const f32x4 g = acc[ai][bj][m][0], up = acc[ai][bj][m][1];
                st4bf(ACT + (size_t)row * 2816 + oc, silu(g[0]) * up[0], silu(g[1]) * up[1], silu(g[2]) * up[2], silu(g[3]) * up[3]); } }
    }
};

template <class Map>
__device__ __forceinline__ void conv_T(const float* src, int src_ld, bf16_t* dst, int Nd, int K, Map map, float* sm, int shift, int tid_l, int bid_l) {
    const int tk = K / 64, ntile = (Nd / 64) * tk;
    for (int t = (bid_l + shift) % gridDim.x; t < ntile; t += gridDim.x) {
        const int n0 = (t / tk) * 64, k0 = (t % tk) * 64;
        { const int n = tid_l & 63, kq = tid_l >> 6; const int col = map(n0 + n);
            for (int e = 0; e < 8; ++e) { const int k = e * 8 + kq; sm[k * 65 + n] = col >= 0 ? src[(size_t)(k0 + k) * src_ld + col] : 0.f; } }
        __syncthreads();
        { const int k = tid_l & 63, nq = tid_l >> 6;
            for (int e = 0; e < 8; ++e) { const int n2 = e * 8 + nq; dst[(size_t)(n0 + n2) * K + k0 + k] = f2bf(sm[k * 65 + n2]); } }
        __syncthreads();
    }
}
struct MapIna { __device__ int operator()(int n) const { return n < 1024 ? n : (n < 1536 ? 2944 + (n - 1024) : (n < 3456 ? 1024 + (n - 1536) : -1)); } };
struct MapOff { int off; __device__ int operator()(int n) const { return off + n; } };
struct MapFfn { __device__ int operator()(int n) const { const int g32 = n >> 5, w = n & 31; return w < 16 ? g32 * 16 + w : 2816 + g32 * 16 + (w - 16); } };

__device__ __forceinline__ void norm_rows(const float* H, const float* nw, const float* modl, const float* modc, int shoff, int scoff, bf16_t* HN, int row_begin, int tid_l, int bid_l) {
    const int wid = tid_l >> 6, lane = tid_l & 63;
    for (int row = row_begin + bid_l * 8 + wid; row < TOK; row += gridDim.x * 8) {
        const float* hp = H + (size_t)row * 1024; const float* mv = row < 256 ? modc : modl;
        f32x4 x[4]; float ss = 0.f;
        UNR for (int e = 0; e < 4; ++e) { x[e] = *(const f32x4*)(hp + e * 256 + lane * 4); ss += x[e][0] * x[e][0] + x[e][1] * x[e][1] + x[e][2] * x[e][2] + x[e][3] * x[e][3]; }
        ss = wave_sum(ss, lane); const float sc = rsqrtf(ss * (1.0f / 1024.0f) + 1e-6f);
        UNR for (int e = 0; e < 4; ++e) { const int c = e * 256 + lane * 4; float y[4];
            UNR for (int j = 0; j < 4; ++j) y[j] = x[e][j] * sc * nw[c + j] * (1.0f + mv[scoff + c + j]) + mv[shoff + c + j];
            st4bf(HN + (size_t)row * 1024 + c, y[0], y[1], y[2], y[3]); }
    }
}

template <int NCH, bool WITH_Y>
__device__ __forceinline__ void wkv_steps(float (&s)[NCH], const float* sw, const float* skk, const float* sb, const float* skd, const float* sr, const float* sv, float* sy,
                                          int nst, int vrow, bool hasv, int sub, int lane) {
    for (int jj = 0; jj < nst; ++jj) {
        const int o = jj * 64 + sub * NCH;
        float sa = 0.f;
#pragma unroll
        for (int i = 0; i < NCH; ++i) sa += s[i] * skk[o + i];
#pragma unroll
        for (int x = 1; x < 64 / NCH; x <<= 1) sa += shx(sa, x, lane);
        const float vv = hasv ? sv[jj * 64 + vrow] : 0.f;
#pragma unroll
        for (int i = 0; i < NCH; ++i) s[i] = s[i] * sw[o + i] + (vv * skd[o + i] - sa * sb[o + i]);
        if (WITH_Y) {
            float y = 0.f;
#pragma unroll
            for (int i = 0; i < NCH; ++i) y += s[i] * sr[o + i];
#pragma unroll
            for (int x = 1; x < 64 / NCH; x <<= 1) y += shx(y, x, lane);
            if (sub == 0) sy[jj * 64 + vrow] = y;
        }
    }
}
constexpr int WCH = 208, WNC = 80, WSC = 26;
__device__ __forceinline__ void wkv_stage(float* sm, const bf16_t* ZB, const bf16_t* LW, const bf16_t* IC, const float* mu, const float* kkw, const float* kaw,
                                          int dir, int head, int p0, int tid_l) {
    const int wid = tid_l >> 6, lane = tid_l & 63, col = head * 64 + lane;
    for (int jj = wid; jj < WSC; jj += 8) {
        const int tk = tok_of(dir, p0 + jj);
        const float r = zshift(ZB, tk, col, mu[col]), k = zshift(ZB, tk, 512 + col, mu[512 + col]), v = zshift(ZB, tk, 1024 + col, mu[1024 + col]);
        const float kx = k * kkw[col]; const float ssq = wave_sum(kx * kx, lane); const float kk = kx * rsqrtf(ssq + 1e-12f);
        const size_t o = ((size_t)dir * TOK + tk) * 512 + col;
        const float w = __expf(bf2f(LW[o])), ic = bf2f(IC[o]);
        const int q = jj * 64 + lane;
        sm[q] = w; sm[1664 + q] = kk; sm[2 * 1664 + q] = kk * ic; sm[3 * 1664 + q] = k * (1.0f + (ic - 1.0f) * kaw[col]); sm[4 * 1664 + q] = r; sm[5 * 1664 + q] = v;
    }
}

__device__ __forceinline__ int launder_s(int i) { asm volatile("" : "+s"(i)); return i; }
#define IN(i) (p.in[launder_s(i)])
constexpr int PH_PER_LAYER = 19;
constexpr int NPHASE = 1 + NLAYER * PH_PER_LAYER + 1;

#define ZA ((bf16_t*)(ws + X_ZA))
#define ZB ((bf16_t*)(ws + OFF_ZB))
#define XC ((bf16_t*)(ws + X_XC))
#define LA ((bf16_t*)(ws + X_LA))
#define LU ((bf16_t*)(ws + X_LU))
#define A5 ((bf16_t*)(ws + X_A5))
#define YS ((bf16_t*)(ws + OFF_YS))
#define YA YS
#define YB (YS + (size_t)TOK * 512)
#define YC (YS + (size_t)2 * TOK * 512)
#define S5E ((float*)(ws + OFF_HN))
#define CA ((float*)(ws + M_CA))
#define CB ((float*)(ws + M_CB))
#define HIN ((float*)(ws + M_HIN))
#define LW ((bf16_t*)(ws + X_LW))
#define IC ((bf16_t*)(ws + X_IC))
#define GG ((bf16_t*)(ws + X_G))
#define YD1 ((bf16_t*)(ws + X_YD1))
#define LORAA ((bf16_t*)(ws + X_LORAA))
#define PQ ((float*)(ws + X_PQ))
#define SCS ((float*)(ws + X_SC))
#define ZG ((bf16_t*)(ws + X_ZG))
#define ACT ((bf16_t*)(ws + X_ACT))
#define MM ((bf16_t*)(ws + X_M))
template <int KSEL>
__device__ __forceinline__ void run_phase(const Params& p, int ph, unsigned char* shm, int wv) {
    unsigned char* ws = p.ws;
    float* sm = (float*)shm;
    LAS unsigned char* lds = (LAS unsigned char*)shm;
#ifdef TID_MBCNT
    int tid; asm volatile("v_mbcnt_lo_u32_b32 %0, -1, 0\n\tv_mbcnt_hi_u32_b32 %0, -1, %0" : "=v"(tid)); tid += wv * 64;
#else
    int tid = threadIdx.x; asm volatile("" : "+v"(tid)); (void)wv;
#endif
    int bid = blockIdx.x; asm volatile("" : "+s"(bid));
#define wid (tid >> 6)
#define lane (tid & 63)
#define gtid ((size_t)bid * NTHR + tid)
#define gthreads ((size_t)gridDim.x * NTHR)
    float* H = (float*)(ws + OFF_H);
    bf16_t* HN = (bf16_t*)(ws + OFF_HN);
    float* MODV = (float*)(ws + M_MODV);
    float* PW = (float*)(ws + M_PW);
    float* BBT = (float*)(ws + M_BB);

    if (KSEL == 100 && ph != 0) return;
    if (KSEL == 101 && ph != NPHASE - 1) return;
    if (KSEL >= 0 && KSEL < 100 && (ph == 0 || ph == NPHASE - 1)) return;
    if (ph == 0) {
        for (int vb = bid; vb < 48 + 32 + 512; vb += gridDim.x) {
            if (vb < 48) {
                __syncthreads();
                for (int k = tid; k < 1024; k += NTHR) { sm[k] = silu(IN(I_C)[k]); sm[1024 + k] = silu(IN(I_CCTX)[k]); }
                __syncthreads();
                const int idx = vb * NTHR + tid, layer = idx / 6144, n = idx % 6144;
                const float* w = IN(I_WMOD) + (size_t)layer * 1024 * 6144 + n;
                float al = 0.f, ac = 0.f;
                for (int k = 0; k < 1024; ++k) { const float wv = w[(size_t)k * 6144]; al += sm[k] * wv; ac += sm[1024 + k] * wv; }
                const float b = IN(I_BMOD)[layer * 6144 + n];
                MODV[(layer * 2 + 0) * 6144 + n] = al + b; MODV[(layer * 2 + 1) * 6144 + n] = ac + b;
            } else if (vb < 80) {
                const int idx = (vb - 48) * NTHR + tid;
                const int pp = idx & 63, g = (idx >> 6) & 31, ld = idx >> 11;
                const float lre = IN(I_S5LRE)[idx], lim = IN(I_S5LIM)[idx], step = __expf(IN(I_S5STEP)[ld * 32 + g]);
                const float xr = lre * step, ang = lim * step;
                for (int t = 0; t <= 16; ++t) { const float mg = expf(xr * t); PW[((size_t)idx * 17 + t) * 2] = mg * cosf(ang * t); PW[((size_t)idx * 17 + t) * 2 + 1] = mg * sinf(ang * t); }
                const float mg = expf(xr), lbim = mg * sinf(ang), sh = sinf(0.5f * ang);
                const float nr = expm1f(xr) * cosf(ang) - 2.0f * sh * sh, den = lre * lre + lim * lim;
                const float fre = (nr * lre + lbim * lim) / den, fim = (lbim * lre - nr * lim) / den;
                for (int c = 0; c < 16; ++c) { const float br = IN(I_S5BRE)[(size_t)idx * 16 + c], bi = IN(I_S5BIM)[(size_t)idx * 16 + c];
                    BBT[((size_t)idx * 16 + c) * 2] = fre * br - fim * bi; BBT[((size_t)idx * 16 + c) * 2 + 1] = fre * bi + fim * br; }
                (void)pp;
            } else {
                const int cb = vb - 80;
                for (size_t i = (size_t)cb * NTHR + tid; i < (size_t)TOK * 256; i += (size_t)512 * NTHR) {
                    const f32x4 v = i < (size_t)256 * 256 ? ((const f32x4*)IN(I_CTX))[i] : ((const f32x4*)IN(I_X))[i - (size_t)256 * 256];
                    ((f32x4*)H)[i] = v; }
            }
        }
        return;
    }
    if (ph == NPHASE - 1) {
        const float* nw = IN(I_NORMF);
        for (int row = 256 + bid * 8 + wid; row < TOK; row += gridDim.x * 8) {
            const float* hp = H + (size_t)row * 1024; f32x4 x[4]; float ss = 0.f;
            UNR for (int e = 0; e < 4; ++e) { x[e] = *(const f32x4*)(hp + e * 256 + lane * 4); ss += x[e][0] * x[e][0] + x[e][1] * x[e][1] + x[e][2] * x[e][2] + x[e][3] * x[e][3]; }
            ss = wave_sum(ss, lane); const float sc = rsqrtf(ss * (1.0f / 1024.0f) + 1e-6f);
            UNR for (int e = 0; e < 4; ++e) { const int c = e * 256 + lane * 4; f32x4 y; UNR for (int j = 0; j < 4; ++j) y[j] = x[e][j] * sc * nw[c + j];
                *(f32x4*)(p.out + (size_t)(row - 256) * 1024 + c) = y; }
        }
        return;
    }
    const int L = (ph - 1) / PH_PER_LAYER, k = (ph - 1) % PH_PER_LAYER;
    const bool last = (L == NLAYER - 1);
    const float* modl = MODV + (L * 2 + 0) * 6144; const float* modc = MODV + (L * 2 + 1) * 6144;
    const int row0 = last ? 256 : 0, Mrows = last ? 16384 : TOK;

    if (KSEL >= 0 && k != KSEL) return;
    switch (k) {
    case 0: {
        conv_T(IN(I_WIN) + (size_t)L * 1024 * 6528, 6528, (bf16_t*)(ws + W_INA), 3584, 1024, MapIna(), sm, 0, tid, bid);
        conv_T(IN(I_WGLU) + (size_t)L * 512 * 512, 512, (bf16_t*)(ws + W_GLU), 512, 512, MapOff{0}, sm, 128, tid, bid);
        {
            bf16_t* W = (bf16_t*)(ws + W_LRU); const float* pwa = IN(I_WA); const float* pwx = IN(I_WX);
            for (size_t i = gtid; i < (size_t)2048 * 512; i += gthreads) { const int n = (int)(i >> 9), kk = (int)(i & 511);
                const int g32 = n >> 5, which = (n & 31) >> 4, dir = g32 >> 5, ch = (g32 & 31) * 16 + (n & 15), head = ch >> 6, j = ch & 63;
                float v = 0.f; if ((kk >> 6) == head) v = (which ? pwx : pwa)[((((size_t)L * 2 + dir) * 8 + head) * 64 + (kk & 63)) * 64 + j];
                W[i] = f2bf(v); }
        }
        {
            bf16_t* W = (bf16_t*)(ws + W_LORA);
            for (size_t i = gtid; i < (size_t)2560 * 384; i += gthreads) { const int n = (int)(i / 384), kk = (int)(i % 384);
                const int blk = n >> 9, ch = n & 511; float v = 0.f;
                if (blk < 2) { if ((kk >> 6) == blk) v = IN(I_W2)[(((size_t)L * 2 + blk) * 64 + (kk & 63)) * 512 + ch]; }
                else if (blk < 4) { if ((kk >> 6) == blk) v = IN(I_A2)[(((size_t)L * 2 + (blk - 2)) * 64 + (kk & 63)) * 512 + ch]; }
                else { if (kk >= 256) v = IN(I_G2)[((size_t)L * 128 + (kk - 256)) * 512 + ch]; }
                W[i] = f2bf(v); }
        }
        {
            float* KT = (float*)(ws + M_KT);
            const float* cre = IN(I_S5CRE) + (size_t)L * 2 * 32 * 16 * 64; const float* cim = IN(I_S5CIM) + (size_t)L * 2 * 32 * 16 * 64;
            const float* pw = PW + (size_t)L * 2 * 32 * 64 * 17 * 2; const float* bb = BBT + (size_t)L * 2 * 32 * 64 * 16 * 2;
            for (size_t i = gtid; i < (size_t)2 * 32 * 16 * 256; i += gthreads) {
                const int c = (int)(i & 15), cp = (int)((i >> 4) & 15), tau = (int)((i >> 8) & 15), dg = (int)(i >> 12);
                const float* cr = cre + ((size_t)dg * 16 + cp) * 64; const float* ci = cim + ((size_t)dg * 16 + cp) * 64;
                const float* pwd = pw + (size_t)dg * 64 * 34 + tau * 2; const float* bbd = bb + (size_t)dg * 64 * 32 + c * 2;
                float v = 0.f;
#pragma unroll 8
                for (int pp = 0; pp < 64; ++pp) { const float pr = pwd[pp * 34], pi = pwd[pp * 34 + 1], br = bbd[pp * 32], bi = bbd[pp * 32 + 1];
                    v += cr[pp] * (pr * br - pi * bi) - ci[pp] * (pr * bi + pi * br); }
                KT[i] = v; }
        }
        norm_rows(H, IN(I_NORM1) + L * 1024, modl, modc, 0, 1024, HN, 0, tid, bid);
    } break;
    case 1: {
        GemmArgs g{HN, (const bf16_t*)(ws + W_INA), 1024, 1024, 1024}; StaticOrder S; S.init(TOK, 3584, bid);
        gemm_phase(lds, g, S, EpiZ{ZA, ZB}, tid);
    } break;
    case 2: {
        const float* cw = IN(I_CONVW) + L * 2048; const float* cb = IN(I_CONVB) + L * 512;
        for (size_t i = gtid; i < (size_t)TOK * 512; i += gthreads) { const int tk = (int)(i >> 9), ch = (int)(i & 511);
            const int lo = tk < 256 ? 0 : 256, hi = tk < 256 ? 256 : TOK; float a = cb[ch];
            UNR for (int j = 0; j < 4; ++j) { const int t2 = tk + j - 2; if (t2 >= lo && t2 < hi) a += cw[j * 512 + ch] * bf2f(ZA[(size_t)t2 * 1536 + ch]); }
            XC[i] = f2bf(a); }
        for (size_t i = gtid; i < (size_t)32 * 1040 * 16; i += gthreads) { const int j = (int)(i & 15); const int s = (int)((i >> 4) % 1040), g = (int)((i >> 4) / 1040);
            const int tk = s5_tok(s * 16 + j); const u32x4* src = (const u32x4*)(ZA + (size_t)tk * 1536 + 1024 + g * 16); u32x4* dst = (u32x4*)(A5 + ((size_t)g * 1040 + s) * 512 + j * 16);
            dst[0] = src[0]; dst[1] = src[1]; }
        {
            bf16_t* WY = (bf16_t*)(ws + W_S5Y); bf16_t* WE = (bf16_t*)(ws + W_S5E); const float* KT = (const float*)(ws + M_KT);
            const float* cre = IN(I_S5CRE) + (size_t)L * 2 * 32 * 16 * 64; const float* cim = IN(I_S5CIM) + (size_t)L * 2 * 32 * 16 * 64;
            const float* pw = PW + (size_t)L * 2 * 32 * 64 * 17 * 2; const float* bb = BBT + (size_t)L * 2 * 32 * 64 * 16 * 2;
            for (size_t i = gtid; i < (size_t)32 * 256 * 512; i += gthreads) {
                const int kk = (int)(i & 511), n = (int)((i >> 9) & 255), g = (int)(i >> 17), t = n >> 4, cp = n & 15; float v = 0.f;
                if (kk < 256) { const int j = kk >> 4, c = kk & 15;
                    if (t >= j) v += KT[((((size_t)0 * 32 + g) * 16 + (t - j)) * 16 + cp) * 16 + c];
                    if (j >= t) v += KT[((((size_t)1 * 32 + g) * 16 + (j - t)) * 16 + cp) * 16 + c]; }
                else { const int d = (kk - 256) >> 7, pp = ((kk - 256) & 127) >> 1, ri = kk & 1; const int e = d == 0 ? t + 1 : 16 - t;
                    const float cr = cre[((size_t)(d * 32 + g) * 16 + cp) * 64 + pp], ci = cim[((size_t)(d * 32 + g) * 16 + cp) * 64 + pp];
                    const float pr = pw[((size_t)(d * 32 + g) * 64 + pp) * 34 + e * 2], pi = pw[((size_t)(d * 32 + g) * 64 + pp) * 34 + e * 2 + 1];
                    v = ri == 0 ? (cr * pr - ci * pi) : -(cr * pi + ci * pr); }
                WY[i] = f2bf(v); }
            for (size_t i = gtid; i < (size_t)32 * 256 * 256; i += gthreads) {
                const int kk = (int)(i & 255), n = (int)((i >> 8) & 255), g = (int)(i >> 16), d = n >> 7, pp = (n & 127) >> 1, ri = n & 1, j = kk >> 4, c = kk & 15;
                const int e = d == 0 ? 15 - j : j;
                const float pr = pw[((size_t)(d * 32 + g) * 64 + pp) * 34 + e * 2], pi = pw[((size_t)(d * 32 + g) * 64 + pp) * 34 + e * 2 + 1];
                const float br = bb[((size_t)(d * 32 + g) * 64 + pp) * 32 + c * 2], bi = bb[((size_t)(d * 32 + g) * 64 + pp) * 32 + c * 2 + 1];
                WE[i] = f2bf(ri == 0 ? pr * br - pi * bi : pr * bi + pi * br); }
        }
    } break;
    case 3: {
        { GemmArgs g{XC, (const bf16_t*)(ws + W_LRU), 512, 512, 512}; StaticOrder S; S.init(TOK, 2048, bid);
          gemm_phase(lds, g, S, EpiLruGate{XC, LA, LU, IN(I_BA) + L * 1024, IN(I_BX) + L * 1024, IN(I_LAM) + L * 1024}, tid); }
        asm volatile("" : "+v"(tid));
        { GemmArgs g{A5, (const bf16_t*)(ws + W_S5E), 512, 256, 256}; S5Order S; S.init(248, bid);
          gemm_phase(lds, g, S, EpiS5E{S5E}, tid); }
    } break;
    case 4: {
        for (int task = bid; task < 520 + 8; task += gridDim.x) {
            if (task < 520) { const int c = task >> 1, dir = task & 1, ch = tid; float As = 0.f, Bs = 0.f;
                for (int j0 = 0; j0 < 64; j0 += 16) { float la[16], uu[16];
                    UNR for (int j = 0; j < 16; ++j) { const int tk = tok_of(dir, c * 64 + j0 + j); const size_t o = ((size_t)dir * TOK + tk) * 512 + ch; la[j] = bf2f(LA[o]); uu[j] = bf2f(LU[o]); }
                    UNR for (int j = 0; j < 16; ++j) { As += la[j]; Bs = __expf(la[j]) * Bs + uu[j]; } }
                CA[(dir * 260 + c) * 512 + ch] = As; CB[(dir * 260 + c) * 512 + ch] = Bs;
            } else { const int idx = (task - 520) * NTHR + tid;
                const int pp = idx & 63, dir = (idx >> 6) & 1, g = idx >> 7;
                const float* pw = PW + ((((size_t)L * 2 + dir) * 32 + g) * 64 + pp) * 34; const float ar = pw[32], ai = pw[33];
                float hr = 0.f, hi = 0.f; const int cb = dir * 128 + pp * 2;
                for (int q0 = 0; q0 < 1040; q0 += 16) { float er[16], ei[16];
                    UNR for (int j = 0; j < 16; ++j) { const int q = q0 + j, s = dir == 0 ? q : (q < 16 ? 15 - q : 1055 - q); const float* ep = S5E + ((size_t)g * 1040 + s) * 256 + cb; er[j] = ep[0]; ei[j] = ep[1]; }
                    UNR for (int j = 0; j < 16; ++j) { const int q = q0 + j, s = dir == 0 ? q : (q < 16 ? 15 - q : 1055 - q);
                        *(unsigned*)(A5 + ((size_t)g * 1040 + s) * 512 + 256 + cb) = pack2(hr, hi);
                        const float nr = ar * hr - ai * hi + er[j], ni = ar * hi + ai * hr + ei[j]; hr = nr; hi = ni; } }
            }
        }
    } break;
    case 5: {
        if (bid < 2) { const int dir = bid, ch = tid; float h = 0.f;
            for (int c0 = 0; c0 < 260; c0 += 13) { float a[13], b[13];
                UNR for (int j = 0; j < 13; ++j) { a[j] = CA[(dir * 260 + c0 + j) * 512 + ch]; b[j] = CB[(dir * 260 + c0 + j) * 512 + ch]; }
                UNR for (int j = 0; j < 13; ++j) { HIN[(dir * 260 + c0 + j) * 512 + ch] = h; h = __expf(a[j]) * h + b[j]; } } }
        __syncthreads(); asm volatile("" : "+v"(tid));
        { GemmArgs g{A5, (const bf16_t*)(ws + W_S5Y), 512, 512, 512}; S5Order S; S.init(254, bid);
          gemm_phase(lds, g, S, EpiS5Y{ZA, XC, IN(I_S5D) + L * 512}, tid); }
    } break;
    case 6: {
        for (int ct = bid; ct < 260; ct += gridDim.x) { const int ch = tid;
            float h = HIN[(0 * 260 + ct) * 512 + ch];
            for (int j0 = 0; j0 < 64; j0 += 16) { float la[16], uu[16];
                UNR for (int j = 0; j < 16; ++j) { const size_t o = (size_t)(ct * 64 + j0 + j) * 512 + ch; la[j] = bf2f(LA[o]); uu[j] = bf2f(LU[o]); }
                UNR for (int j = 0; j < 16; ++j) { const size_t o = (size_t)(ct * 64 + j0 + j) * 512 + ch; h = __expf(la[j]) * h + uu[j]; YA[o] = f2bf(h); } }
            const int c1 = ct < 4 ? 3 - ct : 263 - ct; h = HIN[(1 * 260 + c1) * 512 + ch];
            for (int j0 = 0; j0 < 64; j0 += 16) { float la[16], uu[16], ga[16], hf[16];
                UNR for (int j = 0; j < 16; ++j) { const int tk = ct * 64 + 63 - j0 - j; const size_t o = (size_t)tk * 512 + ch, o1 = (size_t)TOK * 512 + o;
                    la[j] = bf2f(LA[o1]); uu[j] = bf2f(LU[o1]); ga[j] = bf2f(ZA[(size_t)tk * 1536 + 512 + ch]); hf[j] = bf2f(YA[o]); }
                UNR for (int j = 0; j < 16; ++j) { const int tk = ct * 64 + 63 - j0 - j; const size_t o = (size_t)tk * 512 + ch;
                    h = __expf(la[j]) * h + uu[j]; YA[o] = f2bf(gelu_t(ga[j]) * (hf[j] + h)); } } }
        __syncthreads(); asm volatile("" : "+v"(tid));
        { GemmArgs g{XC, (const bf16_t*)(ws + W_GLU), 512, 512, 512}; StaticOrder S; S.init(TOK, 512, bid);
          gemm_phase(lds, g, S, EpiGlu{XC, YC, IN(I_BGLU) + L * 512}, tid); }
    } break;
    case 7: {
        const float* mu = IN(I_MU) + L * 1920;
        for (size_t i = gtid; i < (size_t)TOK * 384; i += gthreads) { const int tk = (int)(i / 384), q = (int)(i % 384);
            const float z = zshift(ZB, tk, 1536 + q, mu[1536 + q]);
            LORAA[i] = f2bf(q < 128 ? tanhf(z) : (q < 256 ? z : sigm(z))); }
    } break;
    case 8: {
        GemmArgs g{LORAA, (const bf16_t*)(ws + W_LORA), 384, 384, 384}; StaticOrder S; S.init(TOK, 2560, bid);
        gemm_phase(lds, g, S, EpiLora{LW, IC, GG, IN(I_W0) + L * 1024, IN(I_A0) + L * 1024}, tid);
    } break;
    case 9: {
        const float* mu = IN(I_MU) + L * 1920; const float* kkw = IN(I_KK) + L * 512; const float* kaw = IN(I_KA) + L * 512;
        for (int task = bid; task < 16 * WNC; task += gridDim.x) { const int hd = task / WNC, c = task % WNC, dir = hd >> 3, head = hd & 7;
            const int row = tid >> 2, sub = tid & 3; float s[16];
            UNR for (int i = 0; i < 16; ++i) s[i] = (row >= 64 && (row - 64) == sub * 16 + i) ? 1.f : 0.f;
            for (int sc = 0; sc < WCH / WSC; ++sc) {
                __syncthreads();
                wkv_stage(sm, ZB, LW, IC, mu, kkw, kaw, dir, head, c * WCH + sc * WSC, tid);
                __syncthreads();
                wkv_steps<16, false>(s, sm, sm + 1664, sm + 2 * 1664, sm + 3 * 1664, sm + 4 * 1664, sm + 5 * 1664, nullptr, WSC, row & 63, row < 64, sub, lane);
            }
            float* dst = PQ + ((size_t)hd * WNC + c) * 8192 + (row < 64 ? 0 : 4096) + (row & 63) * 64 + sub * 16;
            UNR for (int i = 0; i < 16; i += 4) *(f32x4*)(dst + i) = (f32x4){s[i], s[i + 1], s[i + 2], s[i + 3]};
        }
    } break;
    case 10: {
        for (int task = bid; task < 128; task += gridDim.x) { const int hd = task >> 3, rg = task & 7, r = tid >> 6, i = tid & 63, vrow = rg * 8 + r;
            float sv = 0.f; float* Ps = sm + 512;
            const float* P0 = PQ + ((size_t)hd * WNC) * 8192;
            f32x4 pa = *(const f32x4*)(P0 + 4096 + tid * 8), pb = *(const f32x4*)(P0 + 4096 + tid * 8 + 4); float qc = P0[vrow * 64 + i];
            for (int c = 0; c < WNC; ++c) {
                __syncthreads();
                *(f32x4*)(Ps + tid * 8) = pa; *(f32x4*)(Ps + tid * 8 + 4) = pb; sm[r * 64 + i] = sv;
                SCS[((size_t)hd * WNC + c) * 4096 + vrow * 64 + i] = sv;
                float a2 = qc;
                if (c + 1 < WNC) { const float* P1 = PQ + ((size_t)hd * WNC + c + 1) * 8192; pa = *(const f32x4*)(P1 + 4096 + tid * 8); pb = *(const f32x4*)(P1 + 4096 + tid * 8 + 4); qc = P1[vrow * 64 + i]; }
                __syncthreads();
#pragma unroll 16
                for (int a = 0; a < 64; ++a) a2 += sm[r * 64 + a] * Ps[a * 64 + i];
                sv = a2;
            }
            __syncthreads();
        }
    } break;
    case 11: {
        const float* mu = IN(I_MU) + L * 1920; const float* kkw = IN(I_KK) + L * 512; const float* kaw = IN(I_KA) + L * 512;
        for (int task = bid; task < 16 * WNC; task += gridDim.x) { const int hd = task / WNC, c = task % WNC, dir = hd >> 3, head = hd & 7;
            const int row = tid >> 3, sub = tid & 7; float s[8];
            { const float* src = SCS + ((size_t)hd * WNC + c) * 4096 + row * 64 + sub * 8; UNR for (int i = 0; i < 8; ++i) s[i] = src[i]; }
            bf16_t* YD = dir == 0 ? YB : YD1; float* sy = sm + 6 * 1664;
            for (int sc = 0; sc < WCH / WSC; ++sc) { const int p0 = c * WCH + sc * WSC;
                __syncthreads();
                wkv_stage(sm, ZB, LW, IC, mu, kkw, kaw, dir, head, p0, tid);
                __syncthreads();
                wkv_steps<8, true>(s, sm, sm + 1664, sm + 2 * 1664, sm + 3 * 1664, sm + 4 * 1664, sm + 5 * 1664, sy, WSC, row, true, sub, lane);
                __syncthreads();
                for (int e = tid; e < WSC * 64; e += NTHR) { const int jj = e >> 6, vch = e & 63; YD[(size_t)tok_of(dir, p0 + jj) * 512 + head * 64 + vch] = f2bf(sy[e]); }
            }
        }
    } break;
    case 12: {
        const float* mu = IN(I_MU) + L * 1920; const float* kaw = IN(I_KA) + L * 512; const float* rk = IN(I_RK) + L * 512;
        const float* lnw = IN(I_LNW) + L * 512; const float* lnb = IN(I_LNB) + L * 512;
        for (int wt = bid * 8 + wid; wt < TOK * 8; wt += gridDim.x * 8) { const int tk = wt >> 3, head = wt & 7, col = head * 64 + lane; const size_t o = (size_t)tk * 512 + col;
            const float y = bf2f(YB[o]) + bf2f(YD1[o]);
            const float mean = wave_sum(y, lane) * (1.0f / 64.0f); const float dv = y - mean; const float var = wave_sum(dv * dv, lane) * (1.0f / 64.0f);
            float yn = dv * rsqrtf(var + 64e-5f) * lnw[col] + lnb[col];
            const float r = zshift(ZB, tk, col, mu[col]), kx = zshift(ZB, tk, 512 + col, mu[512 + col]), v = zshift(ZB, tk, 1024 + col, mu[1024 + col]);
            const float ic0 = bf2f(IC[o]), ic1 = bf2f(IC[(size_t)TOK * 512 + o]);
            const float kd0 = kx * (1.0f + (ic0 - 1.0f) * kaw[col]), kd1 = kx * (1.0f + (ic1 - 1.0f) * kaw[col]);
            const float bon = wave_sum(r * (kd0 + kd1) * rk[col], lane);
            yn += bon * v;
            YB[o] = f2bf(yn * bf2f(GG[o])); }
        __syncthreads();
        conv_T(IN(I_WIN) + (size_t)L * 1024 * 6528, 6528, (bf16_t*)(ws + W_INZG), 3072, 1024, MapOff{3456}, sm, 0, tid, bid);
        for (int kb = 0; kb < 3; ++kb) conv_T(IN(I_WBR) + ((size_t)L * 3 + kb) * 512 * 1024, 1024, (bf16_t*)(ws + W_BR) + (size_t)kb * 1024 * 512, 1024, 512, MapOff{0}, sm, kb * 64, tid, bid);
        conv_T(IN(I_WOUT) + (size_t)L * 1024 * 1024, 1024, (bf16_t*)(ws + W_OUT), 1024, 1024, MapOff{0}, sm, 192, tid, bid);
        conv_T(IN(I_WFIN) + (size_t)L * 1024 * 5632, 5632, (bf16_t*)(ws + W_FIN), 5632, 1024, MapFfn(), sm, 0, tid, bid);
        conv_T(IN(I_WFOUT) + (size_t)L * 2816 * 1024, 1024, (bf16_t*)(ws + W_FOUT), 1024, 2816, MapOff{0}, sm, 128, tid, bid);
        norm_rows(H, IN(I_NORM1) + L * 1024, modl, modc, 0, 1024, HN, row0, tid, bid);
    } break;
    case 13: {
        GemmArgs g{HN + (size_t)row0 * 1024, (const bf16_t*)(ws + W_INZG), 1024, 1024, 1024}; StaticOrder S; S.init(Mrows, 3072, bid);
        gemm_phase(lds, g, S, EpiZg{ZG, row0}, tid);
    } break;
    case 14: {
        GemmArgs g{YS + (size_t)row0 * 512, (const bf16_t*)(ws + W_BR), 512, 512, 512}; TripleOrder S; S.init(Mrows, bid);
        gemm_phase(lds, g, S, EpiMerge1{ZG, MM, row0}, tid);
    } break;
    case 15: {
        GemmArgs g{MM + (size_t)row0 * 1024, (const bf16_t*)(ws + W_OUT), 1024, 1024, 1024}; StaticOrder S; S.init(Mrows, 1024, bid);
        gemm_phase(lds, g, S, EpiRes{H, modl + 2048, modc + 2048, row0}, tid);
    } break;
    case 16: {
        norm_rows(H, IN(I_NORM2) + L * 1024, modl, modc, 3072, 4096, HN, row0, tid, bid);
    } break;
    case 17: {
        GemmArgs g{HN + (size_t)row0 * 1024, (const bf16_t*)(ws + W_FIN), 1024, 1024, 1024}; StaticOrder S; S.init(Mrows, 5632, bid);
        gemm_phase(lds, g, S, EpiFfn{ACT, row0}, tid);
    } break;
    case 18: {
        GemmArgs g{ACT + (size_t)row0 * 2816, (const bf16_t*)(ws + W_FOUT), 2816, 2816, 2816}; StaticOrder S; S.init(Mrows, 1024, bid);
        gemm_phase(lds, g, S, EpiRes{H, modl + 5120, modc + 5120, row0}, tid);
    } break;
    }
}

#undef wid
#undef lane
#undef gtid
#undef gthreads
__device__ __forceinline__ void grid_bar(unsigned* ctr, unsigned target) {
    asm volatile("s_waitcnt vmcnt(0) lgkmcnt(0)" ::: "memory");
    __syncthreads();
    if (threadIdx.x == 0) {
        __builtin_amdgcn_fence(__ATOMIC_RELEASE, "agent");
        asm volatile("s_waitcnt vmcnt(0)" ::: "memory");
        __hip_atomic_fetch_add(ctr, 1u, __ATOMIC_RELAXED, __HIP_MEMORY_SCOPE_AGENT);
        while (__hip_atomic_load(ctr, __ATOMIC_RELAXED, __HIP_MEMORY_SCOPE_AGENT) < target) __builtin_amdgcn_s_sleep(1);
    }
    __syncthreads();
    __builtin_amdgcn_fence(__ATOMIC_ACQUIRE, "agent");
    asm volatile("s_waitcnt vmcnt(0)" ::: "memory");
}
#if SINGLE_LAUNCH
__global__ void __launch_bounds__(NTHR, 2) fwd_megakernel(Params p, int ph_lo, int ph_hi) {
    extern __shared__ __attribute__((aligned(16))) unsigned char shm[];
    if (blockIdx.x == 0 && threadIdx.x == 0) __hip_atomic_store((unsigned*)(p.ws + M_BAR), 0u, __ATOMIC_RELAXED, __HIP_MEMORY_SCOPE_AGENT);
    { cg::grid_group grid = cg::this_grid(); grid.sync(); }
    const int wv = __builtin_amdgcn_readfirstlane(threadIdx.x >> 6);
    unsigned nbar = 0;
#ifdef USE_CG_SYNC
#define MK_SYNC do { asm volatile("s_waitcnt vmcnt(0) lgkmcnt(0)" ::: "memory"); __syncthreads(); cg::this_grid().sync(); } while (0)
#else
#define MK_SYNC do { nbar += gridDim.x; grid_bar((unsigned*)(p.ws + M_BAR), nbar); } while (0)
#endif
#ifdef MK_SWITCH
    for (int ph = 0; ph < NPHASE; ++ph) { run_phase<-1>(p, ph, shm, wv); if (ph + 1 < NPHASE) MK_SYNC; }
}
#else
    run_phase<100>(p, 0, shm, wv); MK_SYNC;
#define MK_LAYER(LL) do { const int base = 1 + (LL) * PH_PER_LAYER; \
        run_phase<0>(p, base + 0, shm, wv); MK_SYNC;   run_phase<1>(p, base + 1, shm, wv); MK_SYNC;   run_phase<2>(p, base + 2, shm, wv); MK_SYNC; \
        run_phase<3>(p, base + 3, shm, wv); MK_SYNC;   run_phase<4>(p, base + 4, shm, wv); MK_SYNC;   run_phase<5>(p, base + 5, shm, wv); MK_SYNC; \
        run_phase<6>(p, base + 6, shm, wv); MK_SYNC;   run_phase<7>(p, base + 7, shm, wv); MK_SYNC;   run_phase<8>(p, base + 8, shm, wv); MK_SYNC; \
        run_phase<9>(p, base + 9, shm, wv); MK_SYNC;   run_phase<10>(p, base + 10, shm, wv); MK_SYNC; run_phase<11>(p, base + 11, shm, wv); MK_SYNC; \
        run_phase<12>(p, base + 12, shm, wv); MK_SYNC; run_phase<13>(p, base + 13, shm, wv); MK_SYNC; run_phase<14>(p, base + 14, shm, wv); MK_SYNC; \
        run_phase<15>(p, base + 15, shm, wv); MK_SYNC; run_phase<16>(p, base + 16, shm, wv); MK_SYNC; run_phase<17>(p, base + 17, shm, wv); MK_SYNC; \
        run_phase<18>(p, base + 18, shm, wv); MK_SYNC; } while (0)
    MK_LAYER(0); MK_LAYER(1); MK_LAYER(2); MK_LAYER(3);
    run_phase<101>(p, NPHASE - 1, shm, wv);
}
#endif
#endif
template <int KSEL>
__global__ void __launch_bounds__(NTHR, 2) phase_kernel(Params p, int ph) {
    extern __shared__ __attribute__((aligned(16))) unsigned char shm[];
    run_phase<KSEL>(p, ph, shm, __builtin_amdgcn_readfirstlane(threadIdx.x >> 6));
}
template <int KSEL> static void launch_phase(const Params& p, int ph, int grid, hipStream_t stream) {
    static bool attr = false;
    if (!attr) { (void)hipFuncSetAttribute((const void*)phase_kernel<KSEL>, hipFuncAttributeMaxDynamicSharedMemorySize, LDS_BYTES); attr = true; }
    phase_kernel<KSEL><<<grid, NTHR, LDS_BYTES, stream>>>(p, ph);
}

extern "C" void kernel_launch(void* const* d_in, const int* in_sizes, int n_in, void* d_out, int out_size, void* d_ws, size_t ws_size, hipStream_t stream) {
    static int grid = 0;
    if (grid == 0) {
        if (n_in != 42 || ws_size < WS_END) { fprintf(stderr, "kernel_launch: unexpected n_in %d or ws %zu < %zu\n", n_in, ws_size, (size_t)WS_END); grid = -1; return; }
        int dev = 0, cus = 0;
        (void)hipGetDevice(&dev); (void)hipDeviceGetAttribute(&cus, hipDeviceAttributeMultiprocessorCount, dev);
#if SINGLE_LAUNCH
        if (hipFuncSetAttribute((const void*)fwd_megakernel, hipFuncAttributeMaxDynamicSharedMemorySize, LDS_BYTES) != hipSuccess) { fprintf(stderr, "hipFuncSetAttribute failed\n"); grid = -1; return; }
#endif
        (void)hipGetLastError();
        grid = cus;
    }
    if (grid < 0) return;
    Params p{};
    for (int i = 0; i < 42; ++i) p.in[i] = (const float*)d_in[i];
    p.out = (float*)d_out; p.ws = (unsigned char*)d_ws;
#if SINGLE_LAUNCH
    (void)hipMemsetAsync((unsigned char*)d_ws + M_BAR, 0, 256, stream);
    int lo = 0, hi = NPHASE;
    void* args[] = {&p, &lo, &hi};
    hipError_t e = hipLaunchCooperativeKernel((const void*)fwd_megakernel, dim3(grid), dim3(NTHR), args, LDS_BYTES, stream);
    if (e != hipSuccess) fprintf(stderr, "cooperative launch failed: %s (grid %d)\n", hipGetErrorString(e), grid);
#else
    for (int ph = 0; ph < NPHASE; ++ph) {
        if (ph == 0) { launch_phase<100>(p, ph, grid, stream); continue; }
        if (ph == NPHASE - 1) { launch_phase<101>(p, ph, grid, stream); continue; }
        switch ((ph - 1) % PH_PER_LAYER) {
        case 0: launch_phase<0>(p, ph, grid, stream); break;   case 1: launch_phase<1>(p, ph, grid, stream); break;
        case 2: launch_phase<2>(p, ph, grid, stream); break;   case 3: launch_phase<3>(p, ph, grid, stream); break;
        case 4: launch_phase<4>(p, ph, grid, stream); break;   case 5: launch_phase<5>(p, ph, grid, stream); break;
        case 6: launch_phase<6>(p, ph, grid, stream); break;   case 7: launch_phase<7>(p, ph, grid, stream); break;
        case 8: launch_phase<8>(p, ph, grid, stream); break;   case 9: launch_phase<9>(p, ph, grid, stream); break;
        case 10: launch_phase<10>(p, ph, grid, stream); break; case 11: launch_phase<11>(p, ph, grid, stream); break;
        case 12: launch_phase<12>(p, ph, grid, stream); break; case 13: launch_phase<13>(p, ph, grid, stream); break;
        case 14: launch_phase<14>(p, ph, grid, stream); break; case 15: launch_phase<15>(p, ph, grid, stream); break;
        case 16: launch_phase<16>(p, ph, grid, stream); break; case 17: launch_phase<17>(p, ph, grid, stream); break;
        case 18: launch_phase<18>(p, ph, grid, stream); break;
        }
    }
#endif
}
```

```cpp
#define TID_MBCNT 1
#include <hip/hip_runtime.h>
#include <hip/hip_cooperative_groups.h>
#include <cstdio>
namespace cg = cooperative_groups;

#define LAS __attribute__((address_space(3)))
#define UNR _Pragma("unroll")
typedef unsigned short bf16_t;
typedef short bf16x8 __attribute__((ext_vector_type(8)));
typedef float f32x4 __attribute__((ext_vector_type(4)));
typedef unsigned u32x2 __attribute__((ext_vector_type(2)));
typedef unsigned u32x4 __attribute__((ext_vector_type(4)));

constexpr int TOK = 16640, NLAYER = 4;
#ifndef SINGLE_LAUNCH
#define SINGLE_LAUNCH 1
#endif
constexpr int NTHR = 512;
constexpr int LDS_BYTES = 131072;

constexpr size_t SZ_TB512 = (size_t)TOK * 512 * 2;
constexpr size_t OFF_H = 0;
constexpr size_t OFF_HN = OFF_H + (size_t)TOK * 1024 * 4;
constexpr size_t OFF_W1 = OFF_HN + (size_t)TOK * 1024 * 2;
constexpr size_t W_INA = OFF_W1;
constexpr size_t W_LRU = W_INA + (size_t)3584 * 1024 * 2;
constexpr size_t W_LORA = W_LRU + (size_t)2048 * 512 * 2;
constexpr size_t W_S5Y = W_LORA + (size_t)2560 * 384 * 2;
constexpr size_t W_S5E = W_S5Y + (size_t)32 * 256 * 512 * 2;
constexpr size_t W_GLU = W_S5E + (size_t)32 * 256 * 256 * 2;
constexpr size_t OFF_YS = W_GLU + (size_t)512 * 512 * 2;
constexpr size_t OFF_ZB = OFF_YS + 3 * SZ_TB512;
constexpr size_t OFF_MISC = OFF_ZB + (size_t)TOK * 2048 * 2;
constexpr size_t M_MODV = OFF_MISC;
constexpr size_t M_PW = M_MODV + (size_t)4 * 2 * 6144 * 4;
constexpr size_t M_BB = M_PW + (size_t)4 * 2 * 32 * 64 * 17 * 2 * 4;
constexpr size_t M_CA = M_BB + (size_t)4 * 2 * 32 * 64 * 16 * 2 * 4;
constexpr size_t M_CB = M_CA + (size_t)2 * 260 * 512 * 4;
constexpr size_t M_HIN = M_CB + (size_t)2 * 260 * 512 * 4;
constexpr size_t M_KT = M_HIN + (size_t)2 * 260 * 512 * 4;
constexpr size_t M_BAR = OFF_MISC + 16777216 - 4096;
constexpr size_t OFF_X = OFF_MISC + 16777216;
constexpr size_t X_ZA = OFF_X;
constexpr size_t X_XC = X_ZA + (size_t)TOK * 1536 * 2;
constexpr size_t X_LA = X_XC + SZ_TB512;
constexpr size_t X_LU = X_LA + 2 * SZ_TB512;
constexpr size_t X_A5 = X_LU + 2 * SZ_TB512;
constexpr size_t X_LW = OFF_X;
constexpr size_t X_IC = X_LW + 2 * SZ_TB512;
constexpr size_t X_G = X_IC + 2 * SZ_TB512;
constexpr size_t X_YD1 = X_G + SZ_TB512;
constexpr size_t X_LORAA = X_YD1 + SZ_TB512;
constexpr size_t X_PQ = X_LORAA + (size_t)TOK * 384 * 2;
constexpr size_t X_SC = X_PQ + (size_t)16 * 64 * 8192 * 4;
constexpr size_t X_ZG = OFF_X;
constexpr size_t X_ACT = OFF_X;
constexpr size_t W_INZG = X_PQ;
constexpr size_t W_BR = W_INZG + (size_t)3072 * 1024 * 2;
constexpr size_t W_OUT = W_BR + (size_t)3 * 1024 * 512 * 2;
constexpr size_t W_FIN = W_OUT + (size_t)1024 * 1024 * 2;
constexpr size_t W_FOUT = W_FIN + (size_t)5632 * 1024 * 2;
constexpr size_t X_M = W_FOUT + (size_t)1024 * 2816 * 2;
constexpr size_t WS_END = X_M + (size_t)TOK * 1024 * 2 + 1048576;

struct Params { const float* in[42]; float* out; unsigned char* ws; };

enum { I_X = 0, I_C, I_CTX, I_CCTX, I_WMOD, I_BMOD, I_NORM1, I_NORM2, I_NORMF, I_WIN, I_CONVW, I_CONVB, I_WA, I_BA, I_WX, I_BX, I_LAM,
       I_MU, I_W0, I_W2, I_A0, I_A2, I_G2, I_KK, I_KA, I_RK, I_LNW, I_LNB, I_S5LRE, I_S5LIM, I_S5STEP, I_S5BRE, I_S5BIM, I_S5CRE, I_S5CIM,
       I_S5D, I_WGLU, I_BGLU, I_WBR, I_WOUT, I_WFIN, I_WFOUT };

__device__ __forceinline__ bf16_t f2bf(float f) { unsigned u = __float_as_uint(f); u += 0x7FFFu + ((u >> 16) & 1u); return (bf16_t)(u >> 16); }
__device__ __forceinline__ float bf2f(bf16_t b) { return __uint_as_float(((unsigned)b) << 16); }
typedef __bf16 bf16x2_t __attribute__((ext_vector_type(2)));
typedef float f32x2_t __attribute__((ext_vector_type(2)));
__device__ __forceinline__ unsigned pack2(float a, float b) { f32x2_t v = {a, b}; bf16x2_t r = __builtin_convertvector(v, bf16x2_t); return __builtin_bit_cast(unsigned, r); }
__device__ __forceinline__ void st4bf(bf16_t* p, float a, float b, float c, float d) { u32x2 w; w.x = pack2(a, b); w.y = pack2(c, d); *(u32x2*)p = w; }
__device__ __forceinline__ void ld4bf(const bf16_t* p, float (&o)[4]) { u32x2 w = *(const u32x2*)p; o[0] = __uint_as_float(w.x << 16); o[1] = __uint_as_float(w.x & 0xFFFF0000u); o[2] = __uint_as_float(w.y << 16); o[3] = __uint_as_float(w.y & 0xFFFF0000u); }
#ifdef OLD_SIGM
__device__ __forceinline__ float sigm(float x) { return 1.0f / (1.0f + __expf(-x)); }
#else
__device__ __forceinline__ float sigm(float x) { return __builtin_amdgcn_rcpf(1.0f + __expf(-x)); }
#endif
__device__ __forceinline__ float softplusf(float x) { return x > 15.f ? x : __logf(1.0f + __expf(x)); }
__device__ __forceinline__ float gelu_t(float x) { float t = tanhf(0.7978845608028654f * (x + 0.044715f * x * x * x)); return 0.5f * x * (1.0f + t); }
__device__ __forceinline__ float silu(float x) { return x * sigm(x); }
__device__ __forceinline__ int tok_of(int dir, int p) { return dir == 0 ? p : (p < 256 ? 255 - p : 16895 - p); }
__device__ __forceinline__ int s5_tok(int p) { if (p < 256) return p; int q = p - 256; return 256 + (q & 255) * 64 + (q >> 8); }
__device__ __forceinline__ float shx(float v, int o, int lane) { return __int_as_float(__builtin_amdgcn_ds_bpermute((lane ^ o) << 2, __float_as_int(v))); }
__device__ __forceinline__ float wave_sum(float v, int lane) {
#pragma unroll
    for (int o = 32; o >= 1; o >>= 1) v += shx(v, o, lane);
    return v;
}
__device__ __forceinline__ float zshift(const bf16_t* ZB, int tk, int col, float mu) {
    const int lo = tk < 256 ? 0 : 256, hi = tk < 256 ? 256 : TOK;
    const float z = bf2f(ZB[(size_t)tk * 2048 + col]);
    const float zp = (tk - 1 >= lo) ? bf2f(ZB[(size_t)(tk - 1) * 2048 + col]) : 0.f;
    const float zn = (tk + 1 < hi) ? bf2f(ZB[(size_t)(tk + 1) * 2048 + col]) : 0.f;
    return z + mu * (0.5f * (zp + zn) - z);
}

constexpr int BM = 256, BK = 64, HALF = 128, HTB = HALF * BK * 2, NXCD = 8, WGM = 8;
__device__ __forceinline__ int lds_byte(int r, int c) { const int st = (r >> 4) * 2 + (c >> 5), rr = r & 15, cc = c & 31, ob = rr * 64 + cc * 2; return st * 1024 + (ob ^ (((ob >> 9) & 1) << 5)); }
__device__ __forceinline__ void stage_rc(int b, int& R, int& C) { const int st = b / 1024, sb = b % 1024, swz = sb ^ (((sb >> 9) & 1) << 5); R = (st >> 1) * 16 + swz / 64; C = (st & 1) * 32 + (swz % 64) / 2; }

struct Unit { int pm, pn, g; };
struct GemmArgs { const bf16_t* A; const bf16_t* Bt; int lda, ldb, K; };

struct StaticOrder {
    int nM, nN, nwg, G, c;
    __device__ void init(int M, int N, int bid_l) { nM = M / BM; nN = N / BM; nwg = nM * nN; G = gridDim.x; c = bid_l; }
    __device__ bool next(int i, Unit& u) const {
        const long L = (long)i * G + c; if (L >= nwg) return false;
        int wgid = (int)L; { const int q = nwg / NXCD, r = nwg % NXCD, xcd = wgid % NXCD, off = wgid / NXCD; wgid = (xcd < r ? xcd * (q + 1) : r * (q + 1) + (xcd - r) * q) + off; }
        const int nig = WGM * nN, gid = wgid / nig, fm = gid * WGM, gsz = (nM - fm) < WGM ? (nM - fm) : WGM;
        u.pm = fm + ((wgid % nig) % gsz); u.pn = (wgid % nig) / gsz; u.g = 0; return true;
    }
    __device__ const char* aptr(const GemmArgs& g, const Unit& u) const { return (const char*)g.A + (size_t)u.pm * 256 * g.lda * 2; }
    __device__ const char* bptr(const GemmArgs& g, const Unit& u) const { return (const char*)g.Bt + (size_t)u.pn * 256 * g.ldb * 2; }
};
struct S5Order {
    int G, c;
    __device__ void init(int shift, int bid_l) { G = gridDim.x; c = (bid_l + shift) % gridDim.x; }
    __device__ bool next(int i, Unit& u) const { const int L = i * G + c; if (L >= 160) return false; u.g = L / 5; u.pm = L % 5; u.pn = 0; return true; }
    __device__ const char* aptr(const GemmArgs& g, const Unit& u) const { return (const char*)g.A + (size_t)(u.g * 1040 + u.pm * 256) * g.lda * 2; }
    __device__ const char* bptr(const GemmArgs& g, const Unit& u) const { return (const char*)g.Bt + (size_t)u.g * 256 * g.ldb * 2; }
};
struct TripleOrder {
    int nM, G, c;
    __device__ void init(int M, int bid_l) { nM = M / BM; G = gridDim.x; c = bid_l; }
    __device__ bool next(int i, Unit& u) const { const int L = (i / 3) * G + c; if (L >= nM * 4) return false; u.pm = L >> 2; u.pn = L & 3; u.g = i % 3; return true; }
    __device__ const char* aptr(const GemmArgs& g, const Unit& u) const { return (const char*)g.A + (size_t)u.g * SZ_TB512 + (size_t)u.pm * 256 * 512 * 2; }
    __device__ const char* bptr(const GemmArgs& g, const Unit& u) const { return (const char*)g.Bt + (size_t)(u.g * 1024 + u.pn * 256) * 512 * 2; }
};

template <class Epi, class Ord>
__device__ __forceinline__ void gemm_phase(LAS unsigned char* lds, const GemmArgs g, const Ord& S, const Epi& E, int tid_l) {
    const int tid = tid_l, wid = __builtin_amdgcn_readfirstlane(tid >> 6), lane = tid & 63, wr = wid >> 2, wc = wid & 3, fr = lane & 15, fq = lane >> 4;
    const int K = g.K, nt = K / BK;
    unsigned voffA, voffB;
    { int R, C; stage_rc(tid * 16, R, C); voffA = (unsigned)(R * g.lda + C) * 2u; voffB = (unsigned)(R * g.ldb + C) * 2u; }
    const size_t p64A = (size_t)64 * g.lda * 2, p64B = (size_t)64 * g.ldb * 2;
    const size_t kstep = (size_t)(BK * 2);
    const size_t hstepA = (size_t)HALF * g.lda * 2, hstepB = (size_t)HALF * g.ldb * 2;
    const unsigned ldsw = (unsigned)wid * 1024u;
    const int aoff = lds_byte(wr * 64 + fr, fq * 8), boff = lds_byte(wc * 32 + fr, fq * 8);
#define PG8_SA(b, h) (((b) * 2 + (h)) * HTB)
#define PG8_SB(b, h) ((4 + (b) * 2 + (h)) * HTB)
#define PG8_STAGE(bufoff, gbase, voff) do { _Pragma("unroll") for (int _i = 0; _i < 2; ++_i) \
        __builtin_amdgcn_global_load_lds((const unsigned*)((const char*)(gbase) + _i * p64_##voff + v_##voff), (LAS unsigned*)(lds + (bufoff) + ldsw + _i * 8192), 16, 0, 0); } while (0)
#define PG8_LDA(dst, b, h) do { _Pragma("unroll") for (int m = 0; m < 4; ++m) _Pragma("unroll") for (int k = 0; k < 2; ++k) dst[m][k] = *(const LAS bf16x8*)(lds + PG8_SA(b, h) + aoff + m * 2048 + k * 1024); } while (0)
#define PG8_LDB(dst, b, h) do { _Pragma("unroll") for (int n = 0; n < 2; ++n) _Pragma("unroll") for (int k = 0; k < 2; ++k) dst[n][k] = *(const LAS bf16x8*)(lds + PG8_SB(b, h) + boff + n * 2048 + k * 1024); } while (0)
#define PG8_MMA(ai, bj, At, Bt) do { __builtin_amdgcn_s_setprio(1); _Pragma("unroll") for (int m = 0; m < 4; ++m) _Pragma("unroll") for (int n = 0; n < 2; ++n) _Pragma("unroll") for (int k = 0; k < 2; ++k) \
        acc[ai][bj][m][n] = __builtin_amdgcn_mfma_f32_16x16x32_bf16(Bt[n][k], At[m][k], acc[ai][bj][m][n], 0, 0, 0); __builtin_amdgcn_s_setprio(0); } while (0)
#define p64_offA p64A
#define p64_offB p64B
#define v_offA voffA
#define v_offB voffB
#define PG8_WAIT_V(n) asm volatile("s_waitcnt vmcnt(" #n ")" ::: "memory")
#define PG8_WAIT_L(n) asm volatile("s_waitcnt lgkmcnt(" #n ")" ::: "memory")
#define PG8_BAR __builtin_amdgcn_s_barrier()
#define PG8_SCHED __builtin_amdgcn_sched_barrier(0)
    Unit cur, nxt; int ui = 0;
    if (!S.next(0, cur)) return;
    f32x4 acc[2][2][4][2];
#pragma unroll
    for (int a = 0; a < 2; ++a)
#pragma unroll
        for (int b = 0; b < 2; ++b)
#pragma unroll
            for (int m = 0; m < 4; ++m)
#pragma unroll
                for (int n = 0; n < 2; ++n) acc[a][b][m][n] = (f32x4){0.f, 0.f, 0.f, 0.f};
    bf16x8 At[4][2], B0[2][2], B1[2][2];
    const char* cA = S.aptr(g, cur); const char* cB = S.bptr(g, cur);
    PG8_STAGE(PG8_SB(0, 0), cB, offB); PG8_STAGE(PG8_SA(0, 0), cA, offA); PG8_STAGE(PG8_SB(0, 1), cB + hstepB, offB); PG8_STAGE(PG8_SA(0, 1), cA + hstepA, offA);
    if (wr == 1) PG8_BAR;
    PG8_WAIT_V(4); PG8_BAR;
    PG8_STAGE(PG8_SB(1, 0), cB + kstep, offB); PG8_STAGE(PG8_SA(1, 0), cA + kstep, offA); PG8_STAGE(PG8_SB(1, 1), cB + hstepB + kstep, offB);
    PG8_WAIT_V(6); PG8_BAR;
    for (;;) {
        const bool has_next = S.next(ui + 1, nxt);
        const char* nA = has_next ? S.aptr(g, nxt) : cA; const char* nB = has_next ? S.bptr(g, nxt) : cB;
        for (int t = 0; t < nt; t += 2) {
            const bool last = (t == nt - 2);
            const char* a1 = cA + (size_t)(t + 1) * kstep;
            const char* a2 = last ? nA : cA + (size_t)(t + 2) * kstep; const char* b2 = last ? nB : cB + (size_t)(t + 2) * kstep;
            const char* a3 = a2 + kstep; const char* b3 = b2 + kstep;
            PG8_LDB(B0, 0, 0); PG8_SCHED; PG8_LDA(At, 0, 0); PG8_STAGE(PG8_SA(1, 1), a1 + hstepA, offA);
            PG8_WAIT_L(8); PG8_BAR; PG8_WAIT_L(0); PG8_MMA(0, 0, At, B0); PG8_BAR; PG8_SCHED;
            PG8_LDB(B1, 0, 1); PG8_STAGE(PG8_SB(0, 0), b2, offB);
            PG8_BAR; PG8_WAIT_L(0); PG8_MMA(0, 1, At, B1); PG8_BAR;
            PG8_LDA(At, 0, 1); PG8_STAGE(PG8_SA(0, 0), a2, offA);
            PG8_BAR; PG8_WAIT_L(0); PG8_MMA(1, 0, At, B0); PG8_BAR; PG8_SCHED;
            PG8_STAGE(PG8_SB(0, 1), b2 + hstepB, offB);
            PG8_WAIT_V(6); PG8_BAR; PG8_MMA(1, 1, At, B1); PG8_BAR;
            PG8_LDB(B0, 1, 0); PG8_SCHED; PG8_LDA(At, 1, 0); PG8_STAGE(PG8_SA(0, 1), a2 + hstepA, offA);
            PG8_WAIT_L(8); PG8_BAR; PG8_WAIT_L(0); PG8_MMA(0, 0, At, B0); PG8_BAR; PG8_SCHED;
            PG8_LDB(B1, 1, 1); PG8_STAGE(PG8_SB(1, 0), b3, offB);
            PG8_BAR; PG8_WAIT_L(0); PG8_MMA(0, 1, At, B1); PG8_BAR;
            PG8_LDA(At, 1, 1); PG8_STAGE(PG8_SA(1, 0), a3, offA);
            PG8_BAR; PG8_WAIT_L(0); PG8_MMA(1, 0, At, B0); PG8_BAR; PG8_SCHED;
            PG8_STAGE(PG8_SB(1, 1), b3 + hstepB, offB);
            PG8_WAIT_V(6); PG8_BAR; PG8_MMA(1, 1, At, B1); PG8_BAR;
        }
        E(acc, cur, wr, wc, fr, fq);
        if (!has_next) break;
#pragma unroll
        for (int a = 0; a < 2; ++a)
#pragma unroll
            for (int b = 0; b < 2; ++b)
#pragma unroll
                for (int m = 0; m < 4; ++m)
#pragma unroll
                    for (int n = 0; n < 2; ++n) acc[a][b][m][n] = (f32x4){0.f, 0.f, 0.f, 0.f};
        cur = nxt; cA = nA; cB = nB; ++ui;
    }
    PG8_WAIT_V(0);
    if (wr == 0) PG8_BAR;
    PG8_BAR;
#undef p64_offA
#undef p64_offB
#undef v_offA
#undef v_offB
#undef PG8_SA
#undef PG8_SB
#undef PG8_STAGE
#undef PG8_LDA
#undef PG8_LDB
#undef PG8_MMA
#undef PG8_WAIT_V
#undef PG8_WAIT_L
#undef PG8_BAR
#undef PG8_SCHED
}

typedef f32x4 AccT[2][2][4][2];
#define EPI_ROWS _Pragma("unroll") for (int ai = 0; ai < 2; ++ai) _Pragma("unroll") for (int m = 0; m < 4; ++m)
#define EPI_BN _Pragma("unroll") for (int bj = 0; bj < 2; ++bj) _Pragma("unroll") for (int n = 0; n < 2; ++n)
#define EPI_B _Pragma("unroll") for (int bj = 0; bj < 2; ++bj)

#define EPI_ROW (__builtin_amdgcn_sched_barrier(0), u.pm * 256 + ai * 128 + wr * 64 + m * 16 + fr)
#define EPI_COL(bj, n) (u.pn * 256 + (bj) * 128 + wc * 32 + (n) * 16 + 4 * fq)

struct EpiZ {
    bf16_t* ZA; bf16_t* ZB;
    __device__ __forceinline__ void operator()(const AccT& acc, const Unit& u, int wr, int wc, int fr, int fq) const {
        EPI_ROWS { const int row = EPI_ROW;
            EPI_BN { const int col = EPI_COL(bj, n); const f32x4 v = acc[ai][bj][m][n];
                bf16_t* dst = col < 1536 ? ZA + (size_t)row * 1536 + col : ZB + (size_t)row * 2048 + (col - 1536);
                st4bf(dst, v[0], v[1], v[2], v[3]); } }
    }
};
struct EpiLruGate {
    const bf16_t* XC; bf16_t* LA; bf16_t* LU; const float* ba; const float* bx; const float* lam;
    __device__ __forceinline__ void operator()(const AccT& acc, const Unit& u, int wr, int wc, int fr, int fq) const {
        EPI_B { __builtin_amdgcn_sched_barrier(0);
            const int g32 = (u.pn * 256 + bj * 128 + wc * 32) >> 5, dir = g32 >> 5, ch = (g32 & 31) * 16 + 4 * fq;
            float pba[4], pbx[4], psp[4];
            UNR for (int j = 0; j < 4; ++j) { const int c = dir * 512 + ch + j; pba[j] = ba[c]; pbx[j] = bx[c]; psp[j] = -8.0f * softplusf(-lam[c]); }
            EPI_ROWS { const int row = EPI_ROW;
                const f32x4 va = acc[ai][bj][m][0], vx = acc[ai][bj][m][1];
                float xc[4]; ld4bf(XC + (size_t)row * 512 + ch, xc);
                float la[4], uu[4];
                UNR for (int j = 0; j < 4; ++j) {
                    const float gr = sigm(va[j] + pba[j]), gi = sigm(vx[j] + pbx[j]);
                    la[j] = gr * psp[j];
                    uu[j] = __fsqrt_rn(fmaxf(1.0f - __expf(2.0f * la[j]), 0.f)) * gi * xc[j]; }
                const size_t o = ((size_t)dir * TOK + row) * 512 + ch;
                st4bf(LA + o, la[0], la[1], la[2], la[3]); st4bf(LU + o, uu[0], uu[1], uu[2], uu[3]); } }
    }
};
struct EpiS5E {
    float* E;
    __device__ __forceinline__ void operator()(const AccT& acc, const Unit& u, int wr, int wc, int fr, int fq) const {
        EPI_ROWS { const int row = EPI_ROW; if (row < 1040) {
            EPI_BN { const int col = EPI_COL(bj, n);
                *(f32x4*)(E + ((size_t)u.g * 1040 + row) * 256 + col) = acc[ai][bj][m][n]; } } }
    }
};
struct EpiS5Y {
    const bf16_t* ZA; bf16_t* YG; const float* dsk;
    __device__ __forceinline__ void operator()(const AccT& acc, const Unit& u, int wr, int wc, int fr, int fq) const {
        EPI_ROWS { const int row = EPI_ROW; if (row < 1040) {
            EPI_BN { const int col = EPI_COL(bj, n); const f32x4 v = acc[ai][bj][m][n];
                const int t = col >> 4, cp = col & 15, tk = s5_tok(row * 16 + t), ch = u.g * 16 + cp;
                float uv[4]; ld4bf(ZA + (size_t)tk * 1536 + 1024 + ch, uv);
                float y[4]; UNR for (int j = 0; j < 4; ++j) y[j] = gelu_t(v[j] + dsk[ch + j] * uv[j]);
                st4bf(YG + (size_t)tk * 512 + ch, y[0], y[1], y[2], y[3]); } } }
    }
};
struct EpiGlu {
    const bf16_t* YG; bf16_t* YC; const float* bg;
    __device__ __forceinline__ void operator()(const AccT& acc, const Unit& u, int wr, int wc, int fr, int fq) const {
        EPI_ROWS { const int row = EPI_ROW;
            EPI_BN { const int col = EPI_COL(bj, n); const f32x4 v = acc[ai][bj][m][n];
                float y[4]; ld4bf(YG + (size_t)row * 512 + col, y);
                UNR for (int j = 0; j < 4; ++j) y[j] *= sigm(v[j] + bg[col + j]);
                st4bf(YC + (size_t)row * 512 + col, y[0], y[1], y[2], y[3]); } }
    }
};
struct EpiLora {
    bf16_t* LW; bf16_t* IC; bf16_t* G; const float* w0; const float* a0;
    __device__ __forceinline__ void operator()(const AccT& acc, const Unit& u, int wr, int wc, int fr, int fq) const {
        const int blk = u.pn >> 1;
        if (blk < 2) {
            EPI_BN { __builtin_amdgcn_sched_barrier(0); const int col = EPI_COL(bj, n); float b[4];
                UNR for (int j = 0; j < 4; ++j) b[j] = w0[col + j];
                EPI_ROWS { const int row = EPI_ROW; const f32x4 v = acc[ai][bj][m][n]; float o[4];
                    UNR for (int j = 0; j < 4; ++j) { const float wl = -softplusf(-(b[j] + v[j])) - 0.5f; o[j] = -__expf(wl); }
                    st4bf(LW + ((size_t)blk * TOK + row) * 512 + (col & 511), o[0], o[1], o[2], o[3]); } }
        } else if (blk < 4) {
            EPI_BN { __builtin_amdgcn_sched_barrier(0); const int col = EPI_COL(bj, n) - 1024; float b[4];
                UNR for (int j = 0; j < 4; ++j) b[j] = a0[col + j];
                EPI_ROWS { const int row = EPI_ROW; const f32x4 v = acc[ai][bj][m][n]; float o[4];
                    UNR for (int j = 0; j < 4; ++j) o[j] = sigm(b[j] + v[j]);
                    st4bf(IC + ((size_t)(blk - 2) * TOK + row) * 512 + (col & 511), o[0], o[1], o[2], o[3]); } }
        } else {
            EPI_ROWS { const int row = EPI_ROW;
                EPI_BN { const int col = EPI_COL(bj, n) - 2048; const f32x4 v = acc[ai][bj][m][n];
                    st4bf(G + (size_t)row * 512 + col, v[0], v[1], v[2], v[3]); } }
        }
    }
};
struct EpiZg {
    bf16_t* ZG; int row0;
    __device__ __forceinline__ void operator()(const AccT& acc, const Unit& u, int wr, int wc, int fr, int fq) const {
        EPI_ROWS { const int row = row0 + EPI_ROW;
            EPI_BN { const int col = EPI_COL(bj, n); const f32x4 v = acc[ai][bj][m][n];
                st4bf(ZG + (size_t)row * 3072 + col, sigm(v[0]), sigm(v[1]), sigm(v[2]), sigm(v[3])); } }
    }
};
struct EpiMerge1 {
    const bf16_t* ZG; bf16_t* M; int row0;
    __device__ __forceinline__ void operator()(const AccT& acc, const Unit& u, int wr, int wc, int fr, int fq) const {
        EPI_ROWS { const int row = row0 + EPI_ROW;
            EPI_BN { const int col = EPI_COL(bj, n); const f32x4 v = acc[ai][bj][m][n];
                float gt[4]; ld4bf(ZG + (size_t)row * 3072 + u.g * 1024 + col, gt);
                float mv[4] = {0.f, 0.f, 0.f, 0.f}; if (u.g) ld4bf(M + (size_t)row * 1024 + col, mv);
                st4bf(M + (size_t)row * 1024 + col, mv[0] + gt[0] * v[0], mv[1] + gt[1] * v[1], mv[2] + gt[2] * v[2], mv[3] + gt[3] * v[3]); } }
    }
};
struct EpiRes {
    float* H; const float* gl; const float* gc; int row0;
    __device__ __forceinline__ void operator()(const AccT& acc, const Unit& u, int wr, int wc, int fr, int fq) const {
        EPI_ROWS { const int row = row0 + EPI_ROW; const float* gv = row < 256 ? gc : gl;
            EPI_BN { const int col = EPI_COL(bj, n); const f32x4 v = acc[ai][bj][m][n];
                float* hp = H + (size_t)row * 1024 + col; f32x4 hv = *(f32x4*)hp; const f32x4 gg = *(const f32x4*)(gv + col);
                hv += gg * v; *(f32x4*)hp = hv; } }
    }
};
struct EpiFfn {
    bf16_t* ACT; int row0;
    __device__ __forceinline__ void operator()(const AccT& acc, const Unit& u, int wr, int wc, int fr, int fq) const {
        EPI_ROWS { const int row = row0 + EPI_ROW;
            EPI_B { const int g32 = (u.pn * 256 + bj * 128 + wc * 32) >> 5, oc = g32 * 16 + 4 * fq;
                const f32x4 g = acc[ai][bj][m][0], up = acc[ai][bj][m][1];
                st4bf(ACT + (size_t)row * 2816 + oc, silu(g[0]) * up[0], silu(g[1]) * up[1], silu(g[2]) * up[2], silu(g[3]) * up[3]); } }
    }
};

template <class Map>
__device__ __forceinline__ void conv_T(const float* src, int src_ld, bf16_t* dst, int Nd, int K, Map map, float* sm, int shift, int tid_l, int bid_l) {
    const int tk = K / 64, ntile = (Nd / 64) * tk;
    for (int t = (bid_l + shift) % gridDim.x; t < ntile; t += gridDim.x) {
        const int n0 = (t / tk) * 64, k0 = (t % tk) * 64;
        { const int n = tid_l & 63, kq = tid_l >> 6; const int col = map(n0 + n);
            for (int e = 0; e < 8; ++e) { const int k = e * 8 + kq; sm[k * 65 + n] = col >= 0 ? src[(size_t)(k0 + k) * src_ld + col] : 0.f; } }
        __syncthreads();
        { const int k = tid_l & 63, nq = tid_l >> 6;
            for (int e = 0; e < 8; ++e) { const int n2 = e * 8 + nq; dst[(size_t)(n0 + n2) * K + k0 + k] = f2bf(sm[k * 65 + n2]); } }
        __syncthreads();
    }
}
struct MapIna { __device__ int operator()(int n) const { return n < 1024 ? n : (n < 1536 ? 2944 + (n - 1024) : (n < 3456 ? 1024 + (n - 1536) : -1)); } };
struct MapOff { int off; __device__ int operator()(int n) const { return off + n; } };
struct MapFfn { __device__ int operator()(int n) const { const int g32 = n >> 5, w = n & 31; return w < 16 ? g32 * 16 + w : 2816 + g32 * 16 + (w - 16); } };

__device__ __forceinline__ void norm_rows(const float* H, const float* nw, const float* modl, const float* modc, int shoff, int scoff, bf16_t* HN, int row_begin, int tid_l, int bid_l) {
    const int wid = tid_l >> 6, lane = tid_l & 63;
    for (int row = row_begin + bid_l * 8 + wid; row < TOK; row += gridDim.x * 8) {
        const float* hp = H + (size_t)row * 1024; const float* mv = row < 256 ? modc : modl;
        f32x4 x[4]; float ss = 0.f;
        UNR for (int e = 0; e < 4; ++e) { x[e] = *(const f32x4*)(hp + e * 256 + lane * 4); ss += x[e][0] * x[e][0] + x[e][1] * x[e][1] + x[e][2] * x[e][2] + x[e][3] * x[e][3]; }
        ss = wave_sum(ss, lane); const float sc = rsqrtf(ss * (1.0f / 1024.0f) + 1e-6f);
        UNR for (int e = 0; e < 4; ++e) { const int c = e * 256 + lane * 4; float y[4];
            UNR for (int j = 0; j < 4; ++j) y[j] = x[e][j] * sc * nw[c + j] * (1.0f + mv[scoff + c + j]) + mv[shoff + c + j];
            st4bf(HN + (size_t)row * 1024 + c, y[0], y[1], y[2], y[3]); }
    }
}

typedef float f32x2 __attribute__((ext_vector_type(2)));
__device__ __forceinline__ float quad_sum(float v) {
    v += __int_as_float(__builtin_amdgcn_mov_dpp(__float_as_int(v), 0xB1, 0xF, 0xF, true));
    v += __int_as_float(__builtin_amdgcn_mov_dpp(__float_as_int(v), 0x4E, 0xF, 0xF, true));
    return v;
}
constexpr int WCH = 260, WNC = 64, WSC = 13, WVEC = 6 * 64;
template <int R, bool WITH_Y>
__device__ __forceinline__ void wkv_steps(f32x2 (&s)[R][8], const float* stg, float* sy, int nst, int row0, bool hasv, int sub) {
    for (int jj = 0; jj < nst; ++jj) {
        const float* base = stg + jj * WVEC + sub * 16;
        f32x2 kk[8];
#pragma unroll
        for (int i = 0; i < 4; ++i) { const f32x4 t = *(const f32x4*)(base + 64 + i * 4); kk[2 * i] = (f32x2){t[0], t[1]}; kk[2 * i + 1] = (f32x2){t[2], t[3]}; }
        float nsa[R], vv[R];
#pragma unroll
        for (int r = 0; r < R; ++r) { f32x2 a = s[r][0] * kk[0];
#pragma unroll
            for (int i = 1; i < 8; ++i) a = __builtin_elementwise_fma(s[r][i], kk[i], a);
            nsa[r] = -quad_sum(a[0] + a[1]); vv[r] = hasv ? stg[jj * WVEC + 320 + row0 + r] : 0.f; }
        f32x2 w[8], bb[8], kd[8];
#pragma unroll
        for (int i = 0; i < 4; ++i) { const f32x4 t0 = *(const f32x4*)(base + i * 4), t1 = *(const f32x4*)(base + 128 + i * 4), t2 = *(const f32x4*)(base + 192 + i * 4);
            w[2 * i] = (f32x2){t0[0], t0[1]}; w[2 * i + 1] = (f32x2){t0[2], t0[3]}; bb[2 * i] = (f32x2){t1[0], t1[1]}; bb[2 * i + 1] = (f32x2){t1[2], t1[3]};
            kd[2 * i] = (f32x2){t2[0], t2[1]}; kd[2 * i + 1] = (f32x2){t2[2], t2[3]}; }
#pragma unroll
        for (int r = 0; r < R; ++r) { const f32x2 v2 = (f32x2){vv[r], vv[r]}, n2 = (f32x2){nsa[r], nsa[r]};
#pragma unroll
            for (int i = 0; i < 8; ++i) { const f32x2 t = __builtin_elementwise_fma(n2, bb[i], v2 * kd[i]); s[r][i] = __builtin_elementwise_fma(s[r][i], w[i], t); } }
        if (WITH_Y) {
            f32x2 rr[8];
#pragma unroll
            for (int i = 0; i < 4; ++i) { const f32x4 t = *(const f32x4*)(base + 256 + i * 4); rr[2 * i] = (f32x2){t[0], t[1]}; rr[2 * i + 1] = (f32x2){t[2], t[3]}; }
#pragma unroll
            for (int r = 0; r < R; ++r) { f32x2 a = s[r][0] * rr[0];
#pragma unroll
                for (int i = 1; i < 8; ++i) a = __builtin_elementwise_fma(s[r][i], rr[i], a);
                const float y = quad_sum(a[0] + a[1]); if (sub == 0) sy[jj * 64 + row0 + r] = y; }
        }
    }
}
__device__ __forceinline__ void wkv_stage1(float* dst, const bf16_t* ZBp, const bf16_t* LWp, const bf16_t* ICp, const float* mu, const float* kkw, const float* kaw,
                                           int dir, int head, int pos, int ln) {
    const int col = head * 64 + ln, tk = tok_of(dir, pos);
    const float r = zshift(ZBp, tk, col, mu[col]), k = zshift(ZBp, tk, 512 + col, mu[512 + col]), v = zshift(ZBp, tk, 1024 + col, mu[1024 + col]);
    const float kx = k * kkw[col]; const float ssq = wave_sum(kx * kx, ln); const float kk = kx * rsqrtf(ssq + 1e-12f);
    const size_t o = ((size_t)dir * TOK + tk) * 512 + col;
    const float w = __expf(bf2f(LWp[o])), ic = bf2f(ICp[o]);
    dst[ln] = w; dst[64 + ln] = kk; dst[128 + ln] = kk * ic; dst[192 + ln] = k * (1.0f + (ic - 1.0f) * kaw[col]); dst[256 + ln] = r; dst[320 + ln] = v;
}

__device__ __forceinline__ int launder_s(int i) { asm volatile("" : "+s"(i)); return i; }
#define IN(i) (p.in[launder_s(i)])
constexpr int PH_PER_LAYER = 19;
constexpr int NPHASE = 1 + NLAYER * PH_PER_LAYER + 1;

#define ZA ((bf16_t*)(ws + X_ZA))
#define ZB ((bf16_t*)(ws + OFF_ZB))
#define XC ((bf16_t*)(ws + X_XC))
#define LA ((bf16_t*)(ws + X_LA))
#define LU ((bf16_t*)(ws + X_LU))
#define A5 ((bf16_t*)(ws + X_A5))
#define YS ((bf16_t*)(ws + OFF_YS))
#define YA YS
#define YB (YS + (size_t)TOK * 512)
#define YC (YS + (size_t)2 * TOK * 512)
#define S5E ((float*)(ws + OFF_HN))
#define CA ((float*)(ws + M_CA))
#define CB ((float*)(ws + M_CB))
#define HIN ((float*)(ws + M_HIN))
#define LW ((bf16_t*)(ws + X_LW))
#define IC ((bf16_t*)(ws + X_IC))
#define GG ((bf16_t*)(ws + X_G))
#define YD1 ((bf16_t*)(ws + X_YD1))
#define LORAA ((bf16_t*)(ws + X_LORAA))
#define PQ ((float*)(ws + X_PQ))
#define SCS ((float*)(ws + X_SC))
#define ZG ((bf16_t*)(ws + X_ZG))
#define ACT ((bf16_t*)(ws + X_ACT))
#define MM ((bf16_t*)(ws + X_M))
template <int KSEL>
__device__ __forceinline__ void run_phase(const Params& p, int ph, unsigned char* shm, int wv) {
    unsigned char* ws = p.ws;
    float* sm = (float*)shm;
    LAS unsigned char* lds = (LAS unsigned char*)shm;
#ifdef TID_MBCNT
    int tid; asm volatile("v_mbcnt_lo_u32_b32 %0, -1, 0\n\tv_mbcnt_hi_u32_b32 %0, -1, %0" : "=v"(tid)); tid += wv * 64;
#else
    int tid = threadIdx.x; asm volatile("" : "+v"(tid)); (void)wv;
#endif
    int bid = blockIdx.x; asm volatile("" : "+s"(bid));
#define wid (tid >> 6)
#define lane (tid & 63)
#define gtid ((size_t)bid * NTHR + tid)
#define gthreads ((size_t)gridDim.x * NTHR)
    float* H = (float*)(ws + OFF_H);
    bf16_t* HN = (bf16_t*)(ws + OFF_HN);
    float* MODV = (float*)(ws + M_MODV);
    float* PW = (float*)(ws + M_PW);
    float* BBT = (float*)(ws + M_BB);

    if (KSEL == 100 && ph != 0) return;
    if (KSEL == 101 && ph != NPHASE - 1) return;
    if (KSEL >= 0 && KSEL < 100 && (ph == 0 || ph == NPHASE - 1)) return;
    if (ph == 0) {
        for (int vb = bid; vb < 48 + 32 + 512; vb += gridDim.x) {
            if (vb < 48) {
                __syncthreads();
                for (int k = tid; k < 1024; k += NTHR) { sm[k] = silu(IN(I_C)[k]); sm[1024 + k] = silu(IN(I_CCTX)[k]); }
                __syncthreads();
                const int idx = vb * NTHR + tid, layer = idx / 6144, n = idx % 6144;
                const float* w = IN(I_WMOD) + (size_t)layer * 1024 * 6144 + n;
                float al = 0.f, ac = 0.f;
                for (int k = 0; k < 1024; ++k) { const float wv = w[(size_t)k * 6144]; al += sm[k] * wv; ac += sm[1024 + k] * wv; }
                const float b = IN(I_BMOD)[layer * 6144 + n];
                MODV[(layer * 2 + 0) * 6144 + n] = al + b; MODV[(layer * 2 + 1) * 6144 + n] = ac + b;
            } else if (vb < 80) {
                const int idx = (vb - 48) * NTHR + tid;
                const int pp = idx & 63, g = (idx >> 6) & 31, ld = idx >> 11;
                const float lre = IN(I_S5LRE)[idx], lim = IN(I_S5LIM)[idx], step = __expf(IN(I_S5STEP)[ld * 32 + g]);
                const float xr = lre * step, ang = lim * step;
                for (int t = 0; t <= 16; ++t) { const float mg = expf(xr * t); PW[((size_t)idx * 17 + t) * 2] = mg * cosf(ang * t); PW[((size_t)idx * 17 + t) * 2 + 1] = mg * sinf(ang * t); }
                const float mg = expf(xr), lbim = mg * sinf(ang), sh = sinf(0.5f * ang);
                const float nr = expm1f(xr) * cosf(ang) - 2.0f * sh * sh, den = lre * lre + lim * lim;
                const float fre = (nr * lre + lbim * lim) / den, fim = (lbim * lre - nr * lim) / den;
                for (int c = 0; c < 16; ++c) { const float br = IN(I_S5BRE)[(size_t)idx * 16 + c], bi = IN(I_S5BIM)[(size_t)idx * 16 + c];
                    BBT[((size_t)idx * 16 + c) * 2] = fre * br - fim * bi; BBT[((size_t)idx * 16 + c) * 2 + 1] = fre * bi + fim * br; }
                (void)pp;
            } else {
                const int cb = vb - 80;
                for (size_t i = (size_t)cb * NTHR + tid; i < (size_t)TOK * 256; i += (size_t)512 * NTHR) {
                    const f32x4 v = i < (size_t)256 * 256 ? ((const f32x4*)IN(I_CTX))[i] : ((const f32x4*)IN(I_X))[i - (size_t)256 * 256];
                    ((f32x4*)H)[i] = v; }
            }
        }
        return;
    }
    if (ph == NPHASE - 1) {
        const float* nw = IN(I_NORMF);
        for (int row = 256 + bid * 8 + wid; row < TOK; row += gridDim.x * 8) {
            const float* hp = H + (size_t)row * 1024; f32x4 x[4]; float ss = 0.f;
            UNR for (int e = 0; e < 4; ++e) { x[e] = *(const f32x4*)(hp + e * 256 + lane * 4); ss += x[e][0] * x[e][0] + x[e][1] * x[e][1] + x[e][2] * x[e][2] + x[e][3] * x[e][3]; }
            ss = wave_sum(ss, lane); const float sc = rsqrtf(ss * (1.0f / 1024.0f) + 1e-6f);
            UNR for (int e = 0; e < 4; ++e) { const int c = e * 256 + lane * 4; f32x4 y; UNR for (int j = 0; j < 4; ++j) y[j] = x[e][j] * sc * nw[c + j];
                *(f32x4*)(p.out + (size_t)(row - 256) * 1024 + c) = y; }
        }
        return;
    }
    const int L = (ph - 1) / PH_PER_LAYER, k = (ph - 1) % PH_PER_LAYER;
    const bool last = (L == NLAYER - 1);
    const float* modl = MODV + (L * 2 + 0) * 6144; const float* modc = MODV + (L * 2 + 1) * 6144;
    const int row0 = last ? 256 : 0, Mrows = last ? 16384 : TOK;

    if (KSEL >= 0 && k != KSEL) return;
    switch (k) {
    case 0: {
        conv_T(IN(I_WIN) + (size_t)L * 1024 * 6528, 6528, (bf16_t*)(ws + W_INA), 3584, 1024, MapIna(), sm, 0, tid, bid);
        conv_T(IN(I_WGLU) + (size_t)L * 512 * 512, 512, (bf16_t*)(ws + W_GLU), 512, 512, MapOff{0}, sm, 128, tid, bid);
        {
            bf16_t* W = (bf16_t*)(ws + W_LRU); const float* pwa = IN(I_WA); const float* pwx = IN(I_WX);
            for (size_t i = gtid; i < (size_t)2048 * 512; i += gthreads) { const int n = (int)(i >> 9), kk = (int)(i & 511);
                const int g32 = n >> 5, which = (n & 31) >> 4, dir = g32 >> 5, ch = (g32 & 31) * 16 + (n & 15), head = ch >> 6, j = ch & 63;
                float v = 0.f; if ((kk >> 6) == head) v = (which ? pwx : pwa)[((((size_t)L * 2 + dir) * 8 + head) * 64 + (kk & 63)) * 64 + j];
                W[i] = f2bf(v); }
        }
        {
            bf16_t* W = (bf16_t*)(ws + W_LORA);
            for (size_t i = gtid; i < (size_t)2560 * 384; i += gthreads) { const int n = (int)(i / 384), kk = (int)(i % 384);
                const int blk = n >> 9, ch = n & 511; float v = 0.f;
                if (blk < 2) { if ((kk >> 6) == blk) v = IN(I_W2)[(((size_t)L * 2 + blk) * 64 + (kk & 63)) * 512 + ch]; }
                else if (blk < 4) { if ((kk >> 6) == blk) v = IN(I_A2)[(((size_t)L * 2 + (blk - 2)) * 64 + (kk & 63)) * 512 + ch]; }
                else { if (kk >= 256) v = IN(I_G2)[((size_t)L * 128 + (kk - 256)) * 512 + ch]; }
                W[i] = f2bf(v); }
        }
        {
            float* KT = (float*)(ws + M_KT);
            const float* cre = IN(I_S5CRE) + (size_t)L * 2 * 32 * 16 * 64; const float* cim = IN(I_S5CIM) + (size_t)L * 2 * 32 * 16 * 64;
            const float* pw = PW + (size_t)L * 2 * 32 * 64 * 17 * 2; const float* bb = BBT + (size_t)L * 2 * 32 * 64 * 16 * 2;
            for (size_t i = gtid; i < (size_t)2 * 32 * 16 * 256; i += gthreads) {
                const int c = (int)(i & 15), cp = (int)((i >> 4) & 15), tau = (int)((i >> 8) & 15), dg = (int)(i >> 12);
                const float* cr = cre + ((size_t)dg * 16 + cp) * 64; const float* ci = cim + ((size_t)dg * 16 + cp) * 64;
                const float* pwd = pw + (size_t)dg * 64 * 34 + tau * 2; const float* bbd = bb + (size_t)dg * 64 * 32 + c * 2;
                float v = 0.f;
#pragma unroll 8
                for (int pp = 0; pp < 64; ++pp) { const float pr = pwd[pp * 34], pi = pwd[pp * 34 + 1], br = bbd[pp * 32], bi = bbd[pp * 32 + 1];
                    v += cr[pp] * (pr * br - pi * bi) - ci[pp] * (pr * bi + pi * br); }
                KT[i] = v; }
        }
        norm_rows(H, IN(I_NORM1) + L * 1024, modl, modc, 0, 1024, HN, 0, tid, bid);
    } break;
    case 1: {
        GemmArgs g{HN, (const bf16_t*)(ws + W_INA), 1024, 1024, 1024}; StaticOrder S; S.init(TOK, 3584, bid);
        gemm_phase(lds, g, S, EpiZ{ZA, ZB}, tid);
    } break;
    case 2: {
        const float* cw = IN(I_CONVW) + L * 2048; const float* cb = IN(I_CONVB) + L * 512;
        for (size_t i = gtid; i < (size_t)TOK * 512; i += gthreads) { const int tk = (int)(i >> 9), ch = (int)(i & 511);
            const int lo = tk < 256 ? 0 : 256, hi = tk < 256 ? 256 : TOK; float a = cb[ch];
            UNR for (int j = 0; j < 4; ++j) { const int t2 = tk + j - 2; if (t2 >= lo && t2 < hi) a += cw[j * 512 + ch] * bf2f(ZA[(size_t)t2 * 1536 + ch]); }
            XC[i] = f2bf(a); }
        for (size_t i = gtid; i < (size_t)32 * 1040 * 16; i += gthreads) { const int j = (int)(i & 15); const int s = (int)((i >> 4) % 1040), g = (int)((i >> 4) / 1040);
            const int tk = s5_tok(s * 16 + j); const u32x4* src = (const u32x4*)(ZA + (size_t)tk * 1536 + 1024 + g * 16); u32x4* dst = (u32x4*)(A5 + ((size_t)g * 1040 + s) * 512 + j * 16);
            dst[0] = src[0]; dst[1] = src[1]; }
        {
            bf16_t* WY = (bf16_t*)(ws + W_S5Y); bf16_t* WE = (bf16_t*)(ws + W_S5E); const float* KT = (const float*)(ws + M_KT);
            const float* cre = IN(I_S5CRE) + (size_t)L * 2 * 32 * 16 * 64; const float* cim = IN(I_S5CIM) + (size_t)L * 2 * 32 * 16 * 64;
            const float* pw = PW + (size_t)L * 2 * 32 * 64 * 17 * 2; const float* bb = BBT + (size_t)L * 2 * 32 * 64 * 16 * 2;
            for (size_t i = gtid; i < (size_t)32 * 256 * 512; i += gthreads) {
                const int kk = (int)(i & 511), n = (int)((i >> 9) & 255), g = (int)(i >> 17), t = n >> 4, cp = n & 15; float v = 0.f;
                if (kk < 256) { const int j = kk >> 4, c = kk & 15;
                    if (t >= j) v += KT[((((size_t)0 * 32 + g) * 16 + (t - j)) * 16 + cp) * 16 + c];
                    if (j >= t) v += KT[((((size_t)1 * 32 + g) * 16 + (j - t)) * 16 + cp) * 16 + c]; }
                else { const int d = (kk - 256) >> 7, pp = ((kk - 256) & 127) >> 1, ri = kk & 1; const int e = d == 0 ? t + 1 : 16 - t;
                    const float cr = cre[((size_t)(d * 32 + g) * 16 + cp) * 64 + pp], ci = cim[((size_t)(d * 32 + g) * 16 + cp) * 64 + pp];
                    const float pr = pw[((size_t)(d * 32 + g) * 64 + pp) * 34 + e * 2], pi = pw[((size_t)(d * 32 + g) * 64 + pp) * 34 + e * 2 + 1];
                    v = ri == 0 ? (cr * pr - ci * pi) : -(cr * pi + ci * pr); }
                WY[i] = f2bf(v); }
            for (size_t i = gtid; i < (size_t)32 * 256 * 256; i += gthreads) {
                const int kk = (int)(i & 255), n = (int)((i >> 8) & 255), g = (int)(i >> 16), d = n >> 7, pp = (n & 127) >> 1, ri = n & 1, j = kk >> 4, c = kk & 15;
                const int e = d == 0 ? 15 - j : j;
                const float pr = pw[((size_t)(d * 32 + g) * 64 + pp) * 34 + e * 2], pi = pw[((size_t)(d * 32 + g) * 64 + pp) * 34 + e * 2 + 1];
                const float br = bb[((size_t)(d * 32 + g) * 64 + pp) * 32 + c * 2], bi = bb[((size_t)(d * 32 + g) * 64 + pp) * 32 + c * 2 + 1];
                WE[i] = f2bf(ri == 0 ? pr * br - pi * bi : pr * bi + pi * br); }
        }
    } break;
    case 3: {
        { GemmArgs g{XC, (const bf16_t*)(ws + W_LRU), 512, 512, 512}; StaticOrder S; S.init(TOK, 2048, bid);
          gemm_phase(lds, g, S, EpiLruGate{XC, LA, LU, IN(I_BA) + L * 1024, IN(I_BX) + L * 1024, IN(I_LAM) + L * 1024}, tid); }
        asm volatile("" : "+v"(tid));
        { GemmArgs g{A5, (const bf16_t*)(ws + W_S5E), 512, 256, 256}; S5Order S; S.init(248, bid);
          gemm_phase(lds, g, S, EpiS5E{S5E}, tid); }
    } break;
    case 4: {
        for (int task = bid; task < 520 + 8; task += gridDim.x) {
            if (task < 520) { const int c = task >> 1, dir = task & 1, ch = tid; float As = 0.f, Bs = 0.f;
                for (int j0 = 0; j0 < 64; j0 += 16) { float la[16], uu[16];
                    UNR for (int j = 0; j < 16; ++j) { const int tk = tok_of(dir, c * 64 + j0 + j); const size_t o = ((size_t)dir * TOK + tk) * 512 + ch; la[j] = bf2f(LA[o]); uu[j] = bf2f(LU[o]); }
                    UNR for (int j = 0; j < 16; ++j) { As += la[j]; Bs = __expf(la[j]) * Bs + uu[j]; } }
                CA[(dir * 260 + c) * 512 + ch] = As; CB[(dir * 260 + c) * 512 + ch] = Bs;
            } else { const int idx = (task - 520) * NTHR + tid;
                const int pp = idx & 63, dir = (idx >> 6) & 1, g = idx >> 7;
                const float* pw = PW + ((((size_t)L * 2 + dir) * 32 + g) * 64 + pp) * 34; const float ar = pw[32], ai = pw[33];
                float hr = 0.f, hi = 0.f; const int cb = dir * 128 + pp * 2;
                for (int q0 = 0; q0 < 1040; q0 += 16) { float er[16], ei[16];
                    UNR for (int j = 0; j < 16; ++j) { const int q = q0 + j, s = dir == 0 ? q : (q < 16 ? 15 - q : 1055 - q); const float* ep = S5E + ((size_t)g * 1040 + s) * 256 + cb; er[j] = ep[0]; ei[j] = ep[1]; }
                    UNR for (int j = 0; j < 16; ++j) { const int q = q0 + j, s = dir == 0 ? q : (q < 16 ? 15 - q : 1055 - q);
                        *(unsigned*)(A5 + ((size_t)g * 1040 + s) * 512 + 256 + cb) = pack2(hr, hi);
                        const float nr = ar * hr - ai * hi + er[j], ni = ar * hi + ai * hr + ei[j]; hr = nr; hi = ni; } }
            }
        }
    } break;
    case 5: {
        if (bid < 2) { const int dir = bid, ch = tid; float h = 0.f;
            for (int c0 = 0; c0 < 260; c0 += 13) { float a[13], b[13];
                UNR for (int j = 0; j < 13; ++j) { a[j] = CA[(dir * 260 + c0 + j) * 512 + ch]; b[j] = CB[(dir * 260 + c0 + j) * 512 + ch]; }
                UNR for (int j = 0; j < 13; ++j) { HIN[(dir * 260 + c0 + j) * 512 + ch] = h; h = __expf(a[j]) * h + b[j]; } } }
        __syncthreads(); asm volatile("" : "+v"(tid));
        { GemmArgs g{A5, (const bf16_t*)(ws + W_S5Y), 512, 512, 512}; S5Order S; S.init(254, bid);
          gemm_phase(lds, g, S, EpiS5Y{ZA, XC, IN(I_S5D) + L * 512}, tid); }
    } break;
    case 6: {
        for (int ct = bid; ct < 260; ct += gridDim.x) { const int ch = tid;
            float h = HIN[(0 * 260 + ct) * 512 + ch];
            for (int j0 = 0; j0 < 64; j0 += 16) { float la[16], uu[16];
                UNR for (int j = 0; j < 16; ++j) { const size_t o = (size_t)(ct * 64 + j0 + j) * 512 + ch; la[j] = bf2f(LA[o]); uu[j] = bf2f(LU[o]); }
                UNR for (int j = 0; j < 16; ++j) { const size_t o = (size_t)(ct * 64 + j0 + j) * 512 + ch; h = __expf(la[j]) * h + uu[j]; YA[o] = f2bf(h); } }
            const int c1 = ct < 4 ? 3 - ct : 263 - ct; h = HIN[(1 * 260 + c1) * 512 + ch];
            for (int j0 = 0; j0 < 64; j0 += 16) { float la[16], uu[16], ga[16], hf[16];
                UNR for (int j = 0; j < 16; ++j) { const int tk = ct * 64 + 63 - j0 - j; const size_t o = (size_t)tk * 512 + ch, o1 = (size_t)TOK * 512 + o;
                    la[j] = bf2f(LA[o1]); uu[j] = bf2f(LU[o1]); ga[j] = bf2f(ZA[(size_t)tk * 1536 + 512 + ch]); hf[j] = bf2f(YA[o]); }
                UNR for (int j = 0; j < 16; ++j) { const int tk = ct * 64 + 63 - j0 - j; const size_t o = (size_t)tk * 512 + ch;
                    h = __expf(la[j]) * h + uu[j]; YA[o] = f2bf(gelu_t(ga[j]) * (hf[j] + h)); } } }
        __syncthreads(); asm volatile("" : "+v"(tid));
        { GemmArgs g{XC, (const bf16_t*)(ws + W_GLU), 512, 512, 512}; StaticOrder S; S.init(TOK, 512, bid);
          gemm_phase(lds, g, S, EpiGlu{XC, YC, IN(I_BGLU) + L * 512}, tid); }
    } break;
    case 7: {
        const float* mu = IN(I_MU) + L * 1920;
        for (size_t i = gtid; i < (size_t)TOK * 384; i += gthreads) { const int tk = (int)(i / 384), q = (int)(i % 384);
            const float z = zshift(ZB, tk, 1536 + q, mu[1536 + q]);
            LORAA[i] = f2bf(q < 128 ? tanhf(z) : (q < 256 ? z : sigm(z))); }
    } break;
    case 8: {
        GemmArgs g{LORAA, (const bf16_t*)(ws + W_LORA), 384, 384, 384}; StaticOrder S; S.init(TOK, 2560, bid);
        gemm_phase(lds, g, S, EpiLora{LW, IC, GG, IN(I_W0) + L * 1024, IN(I_A0) + L * 1024}, tid);
    } break;
    case 9: {
        const float* mu = IN(I_MU) + L * 1920; const float* kkw = IN(I_KK) + L * 512; const float* kaw = IN(I_KA) + L * 512;
        for (int t4 = bid; t4 < 16 * WNC / 4; t4 += gridDim.x) {
            const int q = wid >> 1, half = wid & 1, task = t4 * 4 + q, hd = task / WNC, c = task % WNC;
            const int sub = tid & 3, row0 = ((tid & 63) >> 2) * 4;
            f32x2 s[4][8];
            UNR for (int r = 0; r < 4; ++r) UNR for (int i = 0; i < 8; ++i) { const int ch = sub * 16 + 2 * i;
                s[r][i] = (f32x2){(half == 1 && row0 + r == ch) ? 1.f : 0.f, (half == 1 && row0 + r == ch + 1) ? 1.f : 0.f}; }
            for (int sc = 0; sc < WCH / WSC; ++sc) {
                __syncthreads();
                for (int pr = wid; pr < 4 * WSC; pr += 8) { const int qq = pr / WSC, jj = pr % WSC, tk2 = t4 * 4 + qq, hd2 = tk2 / WNC, c2 = tk2 % WNC;
                    wkv_stage1(sm + (qq * WSC + jj) * WVEC, ZB, LW, IC, mu, kkw, kaw, hd2 >> 3, hd2 & 7, c2 * WCH + sc * WSC + jj, lane); }
                __syncthreads();
                wkv_steps<4, false>(s, sm + q * WSC * WVEC, nullptr, WSC, row0, half == 0, sub);
            }
            UNR for (int r = 0; r < 4; ++r) { float* dst = PQ + ((size_t)hd * WNC + c) * 8192 + half * 4096 + (row0 + r) * 64 + sub * 16;
                UNR for (int i = 0; i < 8; i += 2) *(f32x4*)(dst + 2 * i) = (f32x4){s[r][i][0], s[r][i][1], s[r][i + 1][0], s[r][i + 1][1]}; }
        }
    } break;
    case 10: {
        for (int task = bid; task < 128; task += gridDim.x) { const int hd = task >> 3, rg = task & 7, r = tid >> 6, i = tid & 63, vrow = rg * 8 + r;
            float sv = 0.f; float* Ps = sm + 512;
            const float* P0 = PQ + ((size_t)hd * WNC) * 8192;
            f32x4 pa = *(const f32x4*)(P0 + 4096 + tid * 8), pb = *(const f32x4*)(P0 + 4096 + tid * 8 + 4); float qc = P0[vrow * 64 + i];
            for (int c = 0; c < WNC; ++c) {
                __syncthreads();
                *(f32x4*)(Ps + tid * 8) = pa; *(f32x4*)(Ps + tid * 8 + 4) = pb; sm[r * 64 + i] = sv;
                SCS[((size_t)hd * WNC + c) * 4096 + vrow * 64 + i] = sv;
                float a2 = qc;
                if (c + 1 < WNC) { const float* P1 = PQ + ((size_t)hd * WNC + c + 1) * 8192; pa = *(const f32x4*)(P1 + 4096 + tid * 8); pb = *(const f32x4*)(P1 + 4096 + tid * 8 + 4); qc = P1[vrow * 64 + i]; }
                __syncthreads();
#pragma unroll 16
                for (int a = 0; a < 64; ++a) a2 += sm[r * 64 + a] * Ps[a * 64 + i];
                sv = a2;
            }
            __syncthreads();
        }
    } break;
    case 11: {
        const float* mu = IN(I_MU) + L * 1920; const float* kkw = IN(I_KK) + L * 512; const float* kaw = IN(I_KA) + L * 512;
        for (int t4 = bid; t4 < 16 * WNC / 4; t4 += gridDim.x) {
            const int q = wid >> 1, task = t4 * 4 + q, hd = task / WNC, c = task % WNC;
            const int sub = tid & 3, row0 = ((tid & 127) >> 2) * 2;
            f32x2 s[2][8]; float* sy = sm + 4 * WSC * WVEC;
            UNR for (int r = 0; r < 2; ++r) { const float* src = SCS + ((size_t)hd * WNC + c) * 4096 + (row0 + r) * 64 + sub * 16;
                UNR for (int i = 0; i < 8; i += 2) { const f32x4 t = *(const f32x4*)(src + 2 * i); s[r][i] = (f32x2){t[0], t[1]}; s[r][i + 1] = (f32x2){t[2], t[3]}; } }
            for (int sc = 0; sc < WCH / WSC; ++sc) {
                __syncthreads();
                for (int pr = wid; pr < 4 * WSC; pr += 8) { const int qq = pr / WSC, jj = pr % WSC, tk2 = t4 * 4 + qq, hd2 = tk2 / WNC, c2 = tk2 % WNC;
                    wkv_stage1(sm + (qq * WSC + jj) * WVEC, ZB, LW, IC, mu, kkw, kaw, hd2 >> 3, hd2 & 7, c2 * WCH + sc * WSC + jj, lane); }
                __syncthreads();
                wkv_steps<2, true>(s, sm + q * WSC * WVEC, sy + q * WSC * 64, WSC, row0, true, sub);
                __syncthreads();
                for (int e = tid; e < 4 * WSC * 64; e += NTHR) { const int qq = e / (WSC * 64), jj = (e / 64) % WSC, vch = e & 63, tk2 = t4 * 4 + qq, hd2 = tk2 / WNC, c2 = tk2 % WNC, d2 = hd2 >> 3;
                    bf16_t* YD = d2 == 0 ? YB : YD1; YD[(size_t)tok_of(d2, c2 * WCH + sc * WSC + jj) * 512 + (hd2 & 7) * 64 + vch] = f2bf(sy[e]); }
            }
        }
    } break;
    case 12: {
        const float* mu = IN(I_MU) + L * 1920; const float* kaw = IN(I_KA) + L * 512; const float* rk = IN(I_RK) + L * 512;
        const float* lnw = IN(I_LNW) + L * 512; const float* lnb = IN(I_LNB) + L * 512;
        for (int wt = bid * 8 + wid; wt < TOK * 8; wt += gridDim.x * 8) { const int tk = wt >> 3, head = wt & 7, col = head * 64 + lane; const size_t o = (size_t)tk * 512 + col;
            const float y = bf2f(YB[o]) + bf2f(YD1[o]);
            const float mean = wave_sum(y, lane) * (1.0f / 64.0f); const float dv = y - mean; const float var = wave_sum(dv * dv, lane) * (1.0f / 64.0f);
            float yn = dv * rsqrtf(var + 64e-5f) * lnw[col] + lnb[col];
            const float r = zshift(ZB, tk, col, mu[col]), kx = zshift(ZB, tk, 512 + col, mu[512 + col]), v = zshift(ZB, tk, 1024 + col, mu[1024 + col]);
            const float ic0 = bf2f(IC[o]), ic1 = bf2f(IC[(size_t)TOK * 512 + o]);
            const float kd0 = kx * (1.0f + (ic0 - 1.0f) * kaw[col]), kd1 = kx * (1.0f + (ic1 - 1.0f) * kaw[col]);
            const float bon = wave_sum(r * (kd0 + kd1) * rk[col], lane);
            yn += bon * v;
            YB[o] = f2bf(yn * bf2f(GG[o])); }
        __syncthreads();
        conv_T(IN(I_WIN) + (size_t)L * 1024 * 6528, 6528, (bf16_t*)(ws + W_INZG), 3072, 1024, MapOff{3456}, sm, 0, tid, bid);
        for (int kb = 0; kb < 3; ++kb) conv_T(IN(I_WBR) + ((size_t)L * 3 + kb) * 512 * 1024, 1024, (bf16_t*)(ws + W_BR) + (size_t)kb * 1024 * 512, 1024, 512, MapOff{0}, sm, kb * 64, tid, bid);
        conv_T(IN(I_WOUT) + (size_t)L * 1024 * 1024, 1024, (bf16_t*)(ws + W_OUT), 1024, 1024, MapOff{0}, sm, 192, tid, bid);
        conv_T(IN(I_WFIN) + (size_t)L * 1024 * 5632, 5632, (bf16_t*)(ws + W_FIN), 5632, 1024, MapFfn(), sm, 0, tid, bid);
        conv_T(IN(I_WFOUT) + (size_t)L * 2816 * 1024, 1024, (bf16_t*)(ws + W_FOUT), 1024, 2816, MapOff{0}, sm, 128, tid, bid);
        norm_rows(H, IN(I_NORM1) + L * 1024, modl, modc, 0, 1024, HN, row0, tid, bid);
    } break;
    case 13: {
        GemmArgs g{HN + (size_t)row0 * 1024, (const bf16_t*)(ws + W_INZG), 1024, 1024, 1024}; StaticOrder S; S.init(Mrows, 3072, bid);
        gemm_phase(lds, g, S, EpiZg{ZG, row0}, tid);
    } break;
    case 14: {
        GemmArgs g{YS + (size_t)row0 * 512, (const bf16_t*)(ws + W_BR), 512, 512, 512}; TripleOrder S; S.init(Mrows, bid);
        gemm_phase(lds, g, S, EpiMerge1{ZG, MM, row0}, tid);
    } break;
    case 15: {
        GemmArgs g{MM + (size_t)row0 * 1024, (const bf16_t*)(ws + W_OUT), 1024, 1024, 1024}; StaticOrder S; S.init(Mrows, 1024, bid);
        gemm_phase(lds, g, S, EpiRes{H, modl + 2048, modc + 2048, row0}, tid);
    } break;
    case 16: {
        norm_rows(H, IN(I_NORM2) + L * 1024, modl, modc, 3072, 4096, HN, row0, tid, bid);
    } break;
    case 17: {
        GemmArgs g{HN + (size_t)row0 * 1024, (const bf16_t*)(ws + W_FIN), 1024, 1024, 1024}; StaticOrder S; S.init(Mrows, 5632, bid);
        gemm_phase(lds, g, S, EpiFfn{ACT, row0}, tid);
    } break;
    case 18: {
        GemmArgs g{ACT + (size_t)row0 * 2816, (const bf16_t*)(ws + W_FOUT), 2816, 2816, 2816}; StaticOrder S; S.init(Mrows, 1024, bid);
        gemm_phase(lds, g, S, EpiRes{H, modl + 5120, modc + 5120, row0}, tid);
    } break;
    }
}

#undef wid
#undef lane
#undef gtid
#undef gthreads
__device__ __forceinline__ void grid_bar(unsigned* ctr, unsigned target) {
    asm volatile("s_waitcnt vmcnt(0) lgkmcnt(0)" ::: "memory");
    __syncthreads();
    if (threadIdx.x == 0) {
        __builtin_amdgcn_fence(__ATOMIC_RELEASE, "agent");
        asm volatile("s_waitcnt vmcnt(0)" ::: "memory");
        __hip_atomic_fetch_add(ctr, 1u, __ATOMIC_RELAXED, __HIP_MEMORY_SCOPE_AGENT);
        while (__hip_atomic_load(ctr, __ATOMIC_RELAXED, __HIP_MEMORY_SCOPE_AGENT) < target) __builtin_amdgcn_s_sleep(1);
    }
    __syncthreads();
    __builtin_amdgcn_fence(__ATOMIC_ACQUIRE, "agent");
    asm volatile("s_waitcnt vmcnt(0)" ::: "memory");
}
#if SINGLE_LAUNCH
__global__ void __launch_bounds__(NTHR, 2) fwd_megakernel(Params p, int ph_lo, int ph_hi) {
    extern __shared__ __attribute__((aligned(16))) unsigned char shm[];
    if (blockIdx.x == 0 && threadIdx.x == 0) __hip_atomic_store((unsigned*)(p.ws + M_BAR), 0u, __ATOMIC_RELAXED, __HIP_MEMORY_SCOPE_AGENT);
    { cg::grid_group grid = cg::this_grid(); grid.sync(); }
    const int wv = __builtin_amdgcn_readfirstlane(threadIdx.x >> 6);
    unsigned nbar = 0;
#ifdef USE_CG_SYNC
#define MK_SYNC do { asm volatile("s_waitcnt vmcnt(0) lgkmcnt(0)" ::: "memory"); __syncthreads(); cg::this_grid().sync(); } while (0)
#else
#define MK_SYNC do { nbar += gridDim.x; grid_bar((unsigned*)(p.ws + M_BAR), nbar); } while (0)
#endif
#ifdef MK_SWITCH
    for (int ph = 0; ph < NPHASE; ++ph) { run_phase<-1>(p, ph, shm, wv); if (ph + 1 < NPHASE) MK_SYNC; }
}
#else
    run_phase<100>(p, 0, shm, wv); MK_SYNC;
#define MK_LAYER(LL) do { const int base = 1 + (LL) * PH_PER_LAYER; \
        run_phase<0>(p, base + 0, shm, wv); MK_SYNC;   run_phase<1>(p, base + 1, shm, wv); MK_SYNC;   run_phase<2>(p, base + 2, shm, wv); MK_SYNC; \
        run_phase<3>(p, base + 3, shm, wv); MK_SYNC;   run_phase<4>(p, base + 4, shm, wv); MK_SYNC;   run_phase<5>(p, base + 5, shm, wv); MK_SYNC; \
        run_phase<6>(p, base + 6, shm, wv); MK_SYNC;   run_phase<7>(p, base + 7, shm, wv); MK_SYNC;   run_phase<8>(p, base + 8, shm, wv); MK_SYNC; \
        run_phase<9>(p, base + 9, shm, wv); MK_SYNC;   run_phase<10>(p, base + 10, shm, wv); MK_SYNC; run_phase<11>(p, base + 11, shm, wv); MK_SYNC; \
        run_phase<12>(p, base + 12, shm, wv); MK_SYNC; run_phase<13>(p, base + 13, shm, wv); MK_SYNC; run_phase<14>(p, base + 14, shm, wv); MK_SYNC; \
        run_phase<15>(p, base + 15, shm, wv); MK_SYNC; run_phase<16>(p, base + 16, shm, wv); MK_SYNC; run_phase<17>(p, base + 17, shm, wv); MK_SYNC; \
        run_phase<18>(p, base + 18, shm, wv); MK_SYNC; } while (0)
    MK_LAYER(0); MK_LAYER(1); MK_LAYER(2); MK_LAYER(3);
    run_phase<101>(p, NPHASE - 1, shm, wv);
}
#endif
#endif
template <int KSEL>
__global__ void __launch_bounds__(NTHR, 2) phase_kernel(Params p, int ph) {
    extern __shared__ __attribute__((aligned(16))) unsigned char shm[];
    run_phase<KSEL>(p, ph, shm, __builtin_amdgcn_readfirstlane(threadIdx.x >> 6));
}
template <int KSEL> static void launch_phase(const Params& p, int ph, int grid, hipStream_t stream) {
    static bool attr = false;
    if (!attr) { (void)hipFuncSetAttribute((const void*)phase_kernel<KSEL>, hipFuncAttributeMaxDynamicSharedMemorySize, LDS_BYTES); attr = true; }
    phase_kernel<KSEL><<<grid, NTHR, LDS_BYTES, stream>>>(p, ph);
}

extern "C" void kernel_launch(void* const* d_in, const int* in_sizes, int n_in, void* d_out, int out_size, void* d_ws, size_t ws_size, hipStream_t stream) {
    static int grid = 0;
    if (grid == 0) {
        if (n_in != 42 || ws_size < WS_END) { fprintf(stderr, "kernel_launch: unexpected n_in %d or ws %zu < %zu\n", n_in, ws_size, (size_t)WS_END); grid = -1; return; }
        int dev = 0, cus = 0;
        (void)hipGetDevice(&dev); (void)hipDeviceGetAttribute(&cus, hipDeviceAttributeMultiprocessorCount, dev);
#if SINGLE_LAUNCH
        if (hipFuncSetAttribute((const void*)fwd_megakernel, hipFuncAttributeMaxDynamicSharedMemorySize, LDS_BYTES) != hipSuccess) { fprintf(stderr, "hipFuncSetAttribute failed\n"); grid = -1; return; }
#endif
        (void)hipGetLastError();
        grid = cus;
    }
    if (grid < 0) return;
    Params p{};
    for (int i = 0; i < 42; ++i) p.in[i] = (const float*)d_in[i];
    p.out = (float*)d_out; p.ws = (unsigned char*)d_ws;
#if SINGLE_LAUNCH
    (void)hipMemsetAsync((unsigned char*)d_ws + M_BAR, 0, 256, stream);
    int lo = 0, hi = NPHASE;
    void* args[] = {&p, &lo, &hi};
    hipError_t e = hipLaunchCooperativeKernel((const void*)fwd_megakernel, dim3(grid), dim3(NTHR), args, LDS_BYTES, stream);
    if (e != hipSuccess) fprintf(stderr, "cooperative launch failed: %s (grid %d)\n", hipGetErrorString(e), grid);
#else
    for (int ph = 0; ph < NPHASE; ++ph) {
        if (ph == 0) { launch_phase<100>(p, ph, grid, stream); continue; }
        if (ph == NPHASE - 1) { launch_phase<101>(p, ph, grid, stream); continue; }
        switch ((ph - 1) % PH_PER_LAYER) {
        case 0: launch_phase<0>(p, ph, grid, stream); break;   case 1: launch_phase<1>(p, ph, grid, stream); break;
        case 2: launch_phase<2>(p, ph, grid, stream); break;   case 3: launch_phase<3>(p, ph, grid, stream); break;
        case 4: launch_phase<4>(p, ph, grid, stream); break;   case 5: launch_phase<5>(p, ph, grid, stream); break;
        case 6: launch_phase<6>(p, ph, grid, stream); break;   case 7: launch_phase<7>(p, ph, grid, stream); break;
        case 8: launch_phase<8>(p, ph, grid, stream); break;   case 9: launch_phase<9>(p, ph, grid, stream); break;
        case 10: launch_phase<10>(p, ph, grid, stream); break; case 11: launch_phase<11>(p, ph, grid, stream); break;
        case 12: launch_phase<12>(p, ph, grid, stream); break; case 13: launch_phase<13>(p, ph, grid, stream); break;
        case 14: launch_phase<14>(p, ph, grid, stream); break; case 15: launch_phase<15>(p, ph, grid, stream); break;
        case 16: launch_phase<16>(p, ph, grid, stream); break; case 17: launch_phase<17>(p, ph, grid, stream); break;
        case 18: launch_phase<18>(p, ph, grid, stream); break;
        }
    }
#endif
}
```

```cpp
#define TID_MBCNT 1
#include <hip/hip_runtime.h>
#include <hip/hip_cooperative_groups.h>
#include <cstdio>
namespace cg = cooperative_groups;

#define LAS __attribute__((address_space(3)))
#define UNR _Pragma("unroll")
typedef unsigned short bf16_t;
typedef short bf16x8 __attribute__((ext_vector_type(8)));
typedef float f32x4 __attribute__((ext_vector_type(4)));
typedef unsigned u32x2 __attribute__((ext_vector_type(2)));
typedef unsigned u32x4 __attribute__((ext_vector_type(4)));

constexpr int TOK = 16640, NLAYER = 4;
#ifndef SINGLE_LAUNCH
#define SINGLE_LAUNCH 1
#endif
constexpr int NTHR = 512;
constexpr int LDS_STAGE = 131072;
constexpr int LDS_BYTES = LDS_STAGE + 16;

constexpr size_t SZ_TB512 = (size_t)TOK * 512 * 2;
constexpr size_t OFF_H = 0;
constexpr size_t OFF_HN = OFF_H + (size_t)TOK * 1024 * 4;
constexpr size_t OFF_W1 = OFF_HN + (size_t)TOK * 1024 * 2;
constexpr size_t W_INA = OFF_W1;
constexpr size_t W_LRU = W_INA + (size_t)3584 * 1024 * 2;
constexpr size_t W_LORA = W_LRU + (size_t)2048 * 512 * 2;
constexpr size_t W_S5Y = W_LORA + (size_t)2560 * 384 * 2;
constexpr size_t W_S5E = W_S5Y + (size_t)32 * 256 * 512 * 2;
constexpr size_t W_GLU = W_S5E + (size_t)32 * 256 * 256 * 2;
constexpr size_t OFF_YS = W_GLU + (size_t)512 * 512 * 2;
constexpr size_t OFF_ZB = OFF_YS + 3 * SZ_TB512;
constexpr size_t OFF_MISC = OFF_ZB + (size_t)TOK * 2048 * 2;
constexpr size_t M_MODV = OFF_MISC;
constexpr size_t M_PW = M_MODV + (size_t)4 * 2 * 6144 * 4;
constexpr size_t M_BB = M_PW + (size_t)4 * 2 * 32 * 64 * 17 * 2 * 4;
constexpr size_t M_CA = M_BB + (size_t)4 * 2 * 32 * 64 * 16 * 2 * 4;
constexpr size_t M_CB = M_CA + (size_t)2 * 260 * 512 * 4;
constexpr size_t M_HIN = M_CB + (size_t)2 * 260 * 512 * 4;
constexpr size_t M_KT = M_HIN + (size_t)2 * 260 * 512 * 4;
constexpr size_t M_BAR = OFF_MISC + 16777216 - 16384;
constexpr size_t OFF_X = OFF_MISC + 16777216;
constexpr size_t X_ZA = OFF_X;
constexpr size_t X_XC = X_ZA + (size_t)TOK * 1536 * 2;
constexpr size_t X_LA = X_XC + SZ_TB512;
constexpr size_t X_LU = X_LA + 2 * SZ_TB512;
constexpr size_t X_A5 = X_LU + 2 * SZ_TB512;
constexpr size_t X_LW = OFF_X;
constexpr size_t X_IC = X_LW + 2 * SZ_TB512;
constexpr size_t X_G = X_IC + 2 * SZ_TB512;
constexpr size_t X_YD1 = X_G + SZ_TB512;
constexpr size_t X_LORAA = X_YD1 + SZ_TB512;
constexpr size_t X_PQ = X_LORAA + (size_t)TOK * 384 * 2;
constexpr size_t X_SC = X_PQ + (size_t)16 * 64 * 8192 * 4;
constexpr size_t X_ZG = OFF_X;
constexpr size_t X_ACT = OFF_X;
constexpr size_t W_INZG = X_PQ;
constexpr size_t W_BR = W_INZG + (size_t)3072 * 1024 * 2;
constexpr size_t W_OUT = W_BR + (size_t)3 * 1024 * 512 * 2;
constexpr size_t W_FIN = W_OUT + (size_t)1024 * 1024 * 2;
constexpr size_t W_FOUT = W_FIN + (size_t)5632 * 1024 * 2;
constexpr size_t X_M = W_FOUT + (size_t)1024 * 2816 * 2;
constexpr size_t WS_END = X_M + (size_t)TOK * 1024 * 2 + 1048576;

struct Params { const float* in[42]; float* out; unsigned char* ws; };

enum { I_X = 0, I_C, I_CTX, I_CCTX, I_WMOD, I_BMOD, I_NORM1, I_NORM2, I_NORMF, I_WIN, I_CONVW, I_CONVB, I_WA, I_BA, I_WX, I_BX, I_LAM,
       I_MU, I_W0, I_W2, I_A0, I_A2, I_G2, I_KK, I_KA, I_RK, I_LNW, I_LNB, I_S5LRE, I_S5LIM, I_S5STEP, I_S5BRE, I_S5BIM, I_S5CRE, I_S5CIM,
       I_S5D, I_WGLU, I_BGLU, I_WBR, I_WOUT, I_WFIN, I_WFOUT };

__device__ __forceinline__ bf16_t f2bf(float f) { unsigned u = __float_as_uint(f); u += 0x7FFFu + ((u >> 16) & 1u); return (bf16_t)(u >> 16); }
__device__ __forceinline__ float bf2f(bf16_t b) { return __uint_as_float(((unsigned)b) << 16); }
typedef __bf16 bf16x2_t __attribute__((ext_vector_type(2)));
typedef float f32x2_t __attribute__((ext_vector_type(2)));
__device__ __forceinline__ unsigned pack2(float a, float b) { f32x2_t v = {a, b}; bf16x2_t r = __builtin_convertvector(v, bf16x2_t); return __builtin_bit_cast(unsigned, r); }
__device__ __forceinline__ void st4bf(bf16_t* p, float a, float b, float c, float d) { u32x2 w; w.x = pack2(a, b); w.y = pack2(c, d); *(u32x2*)p = w; }
__device__ __forceinline__ void ld4bf(const bf16_t* p, float (&o)[4]) { u32x2 w = *(const u32x2*)p; o[0] = __uint_as_float(w.x << 16); o[1] = __uint_as_float(w.x & 0xFFFF0000u); o[2] = __uint_as_float(w.y << 16); o[3] = __uint_as_float(w.y & 0xFFFF0000u); }
#ifdef OLD_SIGM
__device__ __forceinline__ float sigm(float x) { return 1.0f / (1.0f + __expf(-x)); }
#else
__device__ __forceinline__ float sigm(float x) { return __builtin_amdgcn_rcpf(1.0f + __expf(-x)); }
#endif
__device__ __forceinline__ float softplusf(float x) { return x > 15.f ? x : __logf(1.0f + __expf(x)); }
__device__ __forceinline__ float gelu_t(float x) { float t = tanhf(0.7978845608028654f * (x + 0.044715f * x * x * x)); return 0.5f * x * (1.0f + t); }
__device__ __forceinline__ float silu(float x) { return x * sigm(x); }
__device__ __forceinline__ int tok_of(int dir, int p) { return dir == 0 ? p : (p < 256 ? 255 - p : 16895 - p); }
__device__ __forceinline__ int s5_tok(int p) { if (p < 256) return p; int q = p - 256; return 256 + (q & 255) * 64 + (q >> 8); }
__device__ __forceinline__ float shx(float v, int o, int lane) { return __int_as_float(__builtin_amdgcn_ds_bpermute((lane ^ o) << 2, __float_as_int(v))); }
__device__ __forceinline__ float wave_sum(float v, int lane) {
#pragma unroll
    for (int o = 32; o >= 1; o >>= 1) v += shx(v, o, lane);
    return v;
}
__device__ __forceinline__ float zshift(const bf16_t* ZB, int tk, int col, float mu) {
    const int lo = tk < 256 ? 0 : 256, hi = tk < 256 ? 256 : TOK;
    const float z = bf2f(ZB[(size_t)tk * 2048 + col]);
    const float zp = (tk - 1 >= lo) ? bf2f(ZB[(size_t)(tk - 1) * 2048 + col]) : 0.f;
    const float zn = (tk + 1 < hi) ? bf2f(ZB[(size_t)(tk + 1) * 2048 + col]) : 0.f;
    return z + mu * (0.5f * (zp + zn) - z);
}

constexpr int BM = 256, BK = 64, HALF = 128, HTB = HALF * BK * 2, NXCD = 8, WGM = 8;
__device__ __forceinline__ int lds_byte(int r, int c) { const int st = (r >> 4) * 2 + (c >> 5), rr = r & 15, cc = c & 31, ob = rr * 64 + cc * 2; return st * 1024 + (ob ^ (((ob >> 9) & 1) << 5)); }
__device__ __forceinline__ void stage_rc(int b, int& R, int& C) { const int st = b / 1024, sb = b % 1024, swz = sb ^ (((sb >> 9) & 1) << 5); R = (st >> 1) * 16 + swz / 64; C = (st & 1) * 32 + (swz % 64) / 2; }

struct Unit { int pm, pn, g; };
struct GemmArgs { const bf16_t* A; const bf16_t* Bt; int lda, ldb, K; };

struct StaticOrder {
    int nM, nN, nwg, G, c;
    __device__ void init(int M, int N, int bid_l) { nM = M / BM; nN = N / BM; nwg = nM * nN; G = gridDim.x; c = bid_l; }
    __device__ bool next(int i, Unit& u) const {
        const long L = (long)i * G + c; if (L >= nwg) return false;
        int wgid = (int)L; { const int q = nwg / NXCD, r = nwg % NXCD, xcd = wgid % NXCD, off = wgid / NXCD; wgid = (xcd < r ? xcd * (q + 1) : r * (q + 1) + (xcd - r) * q) + off; }
        const int nig = WGM * nN, gid = wgid / nig, fm = gid * WGM, gsz = (nM - fm) < WGM ? (nM - fm) : WGM;
        u.pm = fm + ((wgid % nig) % gsz); u.pn = (wgid % nig) / gsz; u.g = 0; return true;
    }
    __device__ const char* aptr(const GemmArgs& g, const Unit& u) const { return (const char*)g.A + (size_t)u.pm * 256 * g.lda * 2; }
    __device__ const char* bptr(const GemmArgs& g, const Unit& u) const { return (const char*)g.Bt + (size_t)u.pn * 256 * g.ldb * 2; }
};
struct S5Order {
    int G, c;
    __device__ void init(int shift, int bid_l) { G = gridDim.x; c = (bid_l + shift) % gridDim.x; }
    __device__ bool next(int i, Unit& u) const { const int L = i * G + c; if (L >= 160) return false; u.g = L / 5; u.pm = L % 5; u.pn = 0; return true; }
    __device__ const char* aptr(const GemmArgs& g, const Unit& u) const { return (const char*)g.A + (size_t)(u.g * 1040 + u.pm * 256) * g.lda * 2; }
    __device__ const char* bptr(const GemmArgs& g, const Unit& u) const { return (const char*)g.Bt + (size_t)u.g * 256 * g.ldb * 2; }
};
struct TripleOrder {
    int nM, G, c;
    __device__ void init(int M, int bid_l) { nM = M / BM; G = gridDim.x; c = bid_l; }
    __device__ bool next(int i, Unit& u) const { const int L = (i / 3) * G + c; if (L >= nM * 4) return false; u.pm = L >> 2; u.pn = L & 3; u.g = i % 3; return true; }
    __device__ const char* aptr(const GemmArgs& g, const Unit& u) const { return (const char*)g.A + (size_t)u.g * SZ_TB512 + (size_t)u.pm * 256 * 512 * 2; }
    __device__ const char* bptr(const GemmArgs& g, const Unit& u) const { return (const char*)g.Bt + (size_t)(u.g * 1024 + u.pn * 256) * 512 * 2; }
};

template <class Epi, class Ord>
__device__ __forceinline__ void gemm_phase(LAS unsigned char* lds, const GemmArgs g, const Ord& S, const Epi& E, int tid_l) {
    const int tid = tid_l, wid = __builtin_amdgcn_readfirstlane(tid >> 6), lane = tid & 63, wr = wid >> 2, wc = wid & 3, fr = lane & 15, fq = lane >> 4;
    const int K = g.K, nt = K / BK;
    unsigned voffA, voffB;
    { int R, C; stage_rc(tid * 16, R, C); voffA = (unsigned)(R * g.lda + C) * 2u; voffB = (unsigned)(R * g.ldb + C) * 2u; }
    const size_t p64A = (size_t)64 * g.lda * 2, p64B = (size_t)64 * g.ldb * 2;
    const size_t kstep = (size_t)(BK * 2);
    const size_t hstepA = (size_t)HALF * g.lda * 2, hstepB = (size_t)HALF * g.ldb * 2;
    const unsigned ldsw = (unsigned)wid * 1024u;
    const int aoff = lds_byte(wr * 64 + fr, fq * 8), boff = lds_byte(wc * 32 + fr, fq * 8);
#define PG8_SA(b, h) (((b) * 2 + (h)) * HTB)
#define PG8_SB(b, h) ((4 + (b) * 2 + (h)) * HTB)
#define PG8_STAGE(bufoff, gbase, voff) do { _Pragma("unroll") for (int _i = 0; _i < 2; ++_i) \
        __builtin_amdgcn_global_load_lds((const unsigned*)((const char*)(gbase) + _i * p64_##voff + v_##voff), (LAS unsigned*)(lds + (bufoff) + ldsw + _i * 8192), 16, 0, 0); } while (0)
#define PG8_LDA(dst, b, h) do { _Pragma("unroll") for (int m = 0; m < 4; ++m) _Pragma("unroll") for (int k = 0; k < 2; ++k) dst[m][k] = *(const LAS bf16x8*)(lds + PG8_SA(b, h) + aoff + m * 2048 + k * 1024); } while (0)
#define PG8_LDB(dst, b, h) do { _Pragma("unroll") for (int n = 0; n < 2; ++n) _Pragma("unroll") for (int k = 0; k < 2; ++k) dst[n][k] = *(const LAS bf16x8*)(lds + PG8_SB(b, h) + boff + n * 2048 + k * 1024); } while (0)
#define PG8_MMA(ai, bj, At, Bt) do { __builtin_amdgcn_s_setprio(1); _Pragma("unroll") for (int m = 0; m < 4; ++m) _Pragma("unroll") for (int n = 0; n < 2; ++n) _Pragma("unroll") for (int k = 0; k < 2; ++k) \
        acc[ai][bj][m][n] = __builtin_amdgcn_mfma_f32_16x16x32_bf16(Bt[n][k], At[m][k], acc[ai][bj][m][n], 0, 0, 0); __builtin_amdgcn_s_setprio(0); } while (0)
#define p64_offA p64A
#define p64_offB p64B
#define v_offA voffA
#define v_offB voffB
#define PG8_WAIT_V(n) asm volatile("s_waitcnt vmcnt(" #n ")" ::: "memory")
#define PG8_WAIT_L(n) asm volatile("s_waitcnt lgkmcnt(" #n ")" ::: "memory")
#define PG8_BAR __builtin_amdgcn_s_barrier()
#define PG8_SCHED __builtin_amdgcn_sched_barrier(0)
    Unit cur, nxt; int ui = 0;
    if (!S.next(0, cur)) return;
    f32x4 acc[2][2][4][2];
#pragma unroll
    for (int a = 0; a < 2; ++a)
#pragma unroll
        for (int b = 0; b < 2; ++b)
#pragma unroll
            for (int m = 0; m < 4; ++m)
#pragma unroll
                for (int n = 0; n < 2; ++n) acc[a][b][m][n] = (f32x4){0.f, 0.f, 0.f, 0.f};
    bf16x8 At[4][2], B0[2][2], B1[2][2];
    const char* cA = S.aptr(g, cur); const char* cB = S.bptr(g, cur);
    PG8_STAGE(PG8_SB(0, 0), cB, offB); PG8_STAGE(PG8_SA(0, 0), cA, offA); PG8_STAGE(PG8_SB(0, 1), cB + hstepB, offB); PG8_STAGE(PG8_SA(0, 1), cA + hstepA, offA);
    if (wr == 1) PG8_BAR;
    PG8_WAIT_V(4); PG8_BAR;
    PG8_STAGE(PG8_SB(1, 0), cB + kstep, offB); PG8_STAGE(PG8_SA(1, 0), cA + kstep, offA); PG8_STAGE(PG8_SB(1, 1), cB + hstepB + kstep, offB);
    PG8_WAIT_V(6); PG8_BAR;
    for (;;) {
        const bool has_next = S.next(ui + 1, nxt);
        const char* nA = has_next ? S.aptr(g, nxt) : cA; const char* nB = has_next ? S.bptr(g, nxt) : cB;
        for (int t = 0; t < nt; t += 2) {
            const bool last = (t == nt - 2);
            const char* a1 = cA + (size_t)(t + 1) * kstep;
            const char* a2 = last ? nA : cA + (size_t)(t + 2) * kstep; const char* b2 = last ? nB : cB + (size_t)(t + 2) * kstep;
            const char* a3 = a2 + kstep; const char* b3 = b2 + kstep;
            PG8_LDB(B0, 0, 0); PG8_SCHED; PG8_LDA(At, 0, 0); PG8_STAGE(PG8_SA(1, 1), a1 + hstepA, offA);
            PG8_WAIT_L(8); PG8_BAR; PG8_WAIT_L(0); PG8_MMA(0, 0, At, B0); PG8_BAR; PG8_SCHED;
            PG8_LDB(B1, 0, 1); PG8_STAGE(PG8_SB(0, 0), b2, offB);
            PG8_BAR; PG8_WAIT_L(0); PG8_MMA(0, 1, At, B1); PG8_BAR;
            PG8_LDA(At, 0, 1); PG8_STAGE(PG8_SA(0, 0), a2, offA);
            PG8_BAR; PG8_WAIT_L(0); PG8_MMA(1, 0, At, B0); PG8_BAR; PG8_SCHED;
            PG8_STAGE(PG8_SB(0, 1), b2 + hstepB, offB);
            PG8_WAIT_V(6); PG8_BAR; PG8_MMA(1, 1, At, B1); PG8_BAR;
            PG8_LDB(B0, 1, 0); PG8_SCHED; PG8_LDA(At, 1, 0); PG8_STAGE(PG8_SA(0, 1), a2 + hstepA, offA);
            PG8_WAIT_L(8); PG8_BAR; PG8_WAIT_L(0); PG8_MMA(0, 0, At, B0); PG8_BAR; PG8_SCHED;
            PG8_LDB(B1, 1, 1); PG8_STAGE(PG8_SB(1, 0), b3, offB);
            PG8_BAR; PG8_WAIT_L(0); PG8_MMA(0, 1, At, B1); PG8_BAR;
            PG8_LDA(At, 1, 1); PG8_STAGE(PG8_SA(1, 0), a3, offA);
            PG8_BAR; PG8_WAIT_L(0); PG8_MMA(1, 0, At, B0); PG8_BAR; PG8_SCHED;
            PG8_STAGE(PG8_SB(1, 1), b3 + hstepB, offB);
            PG8_WAIT_V(6); PG8_BAR; PG8_MMA(1, 1, At, B1); PG8_BAR;
        }
        E(acc, cur, wr, wc, fr, fq);
        if (!has_next) break;
#pragma unroll
        for (int a = 0; a < 2; ++a)
#pragma unroll
            for (int b = 0; b < 2; ++b)
#pragma unroll
                for (int m = 0; m < 4; ++m)
#pragma unroll
                    for (int n = 0; n < 2; ++n) acc[a][b][m][n] = (f32x4){0.f, 0.f, 0.f, 0.f};
        cur = nxt; cA = nA; cB = nB; ++ui;
    }
    PG8_WAIT_V(0);
    if (wr == 0) PG8_BAR;
    PG8_BAR;
#undef p64_offA
#undef p64_offB
#undef v_offA
#undef v_offB
#undef PG8_SA
#undef PG8_SB
#undef PG8_STAGE
#undef PG8_LDA
#undef PG8_LDB
#undef PG8_MMA
#undef PG8_WAIT_V
#undef PG8_WAIT_L
#undef PG8_BAR
#undef PG8_SCHED
}

typedef f32x4 AccT[2][2][4][2];
#define EPI_ROWS _Pragma("unroll") for (int ai = 0; ai < 2; ++ai) _Pragma("unroll") for (int m = 0; m < 4; ++m)
#define EPI_BN _Pragma("unroll") for (int bj = 0; bj < 2; ++bj) _Pragma("unroll") for (int n = 0; n < 2; ++n)
#define EPI_B _Pragma("unroll") for (int bj = 0; bj < 2; ++bj)

#define EPI_ROW (__builtin_amdgcn_sched_barrier(0), u.pm * 256 + ai * 128 + wr * 64 + m * 16 + fr)
#define EPI_COL(bj, n) (u.pn * 256 + (bj) * 128 + wc * 32 + (n) * 16 + 4 * fq)

struct EpiZ {
    bf16_t* ZA; bf16_t* ZB;
    __device__ __forceinline__ void operator()(const AccT& acc, const Unit& u, int wr, int wc, int fr, int fq) const {
        EPI_ROWS { const int row = EPI_ROW;
            EPI_BN { const int col = EPI_COL(bj, n); const f32x4 v = acc[ai][bj][m][n];
                bf16_t* dst = col < 1536 ? ZA + (size_t)row * 1536 + col : ZB + (size_t)row * 2048 + (col - 1536);
                st4bf(dst, v[0], v[1], v[2], v[3]); } }
    }
};
struct EpiLruGate {
    const bf16_t* XC; bf16_t* LA; bf16_t* LU; const float* ba; const float* bx; const float* lam;
    __device__ __forceinline__ void operator()(const AccT& acc, const Unit& u, int wr, int wc, int fr, int fq) const {
        EPI_B { __builtin_amdgcn_sched_barrier(0);
            const int g32 = (u.pn * 256 + bj * 128 + wc * 32) >> 5, dir = g32 >> 5, ch = (g32 & 31) * 16 + 4 * fq;
            float pba[4], pbx[4], psp[4];
            UNR for (int j = 0; j < 4; ++j) { const int c = dir * 512 + ch + j; pba[j] = ba[c]; pbx[j] = bx[c]; psp[j] = -8.0f * softplusf(-lam[c]); }
            EPI_ROWS { const int row = EPI_ROW;
                const f32x4 va = acc[ai][bj][m][0], vx = acc[ai][bj][m][1];
                float xc[4]; ld4bf(XC + (size_t)row * 512 + ch, xc);
                float la[4], uu[4];
                UNR for (int j = 0; j < 4; ++j) {
                    const float gr = sigm(va[j] + pba[j]), gi = sigm(vx[j] + pbx[j]);
                    la[j] = gr * psp[j];
                    uu[j] = __fsqrt_rn(fmaxf(1.0f - __expf(2.0f * la[j]), 0.f)) * gi * xc[j]; }
                const size_t o = ((size_t)dir * TOK + row) * 512 + ch;
                st4bf(LA + o, la[0], la[1], la[2], la[3]); st4bf(LU + o, uu[0], uu[1], uu[2], uu[3]); } }
    }
};
struct EpiS5E {
    float* E;
    __device__ __forceinline__ void operator()(const AccT& acc, const Unit& u, int wr, int wc, int fr, int fq) const {
        EPI_ROWS { const int row = EPI_ROW; if (row < 1040) {
            EPI_BN { const int col = EPI_COL(bj, n);
                *(f32x4*)(E + ((size_t)u.g * 1040 + row) * 256 + col) = acc[ai][bj][m][n]; } } }
    }
};
struct EpiS5Y {
    const bf16_t* ZA; bf16_t* YG; const float* dsk;
    __device__ __forceinline__ void operator()(const AccT& acc, const Unit& u, int wr, int wc, int fr, int fq) const {
        EPI_ROWS { const int row = EPI_ROW; if (row < 1040) {
            EPI_BN { const int col = EPI_COL(bj, n); const f32x4 v = acc[ai][bj][m][n];
                const int t = col >> 4, cp = col & 15, tk = s5_tok(row * 16 + t), ch = u.g * 16 + cp;
                float uv[4]; ld4bf(ZA + (size_t)tk * 1536 + 1024 + ch, uv);
                float y[4]; UNR for (int j = 0; j < 4; ++j) y[j] = gelu_t(v[j] + dsk[ch + j] * uv[j]);
                st4bf(YG + (size_t)tk * 512 + ch, y[0], y[1], y[2], y[3]); } } }
    }
};
struct EpiGlu {
    const bf16_t* YG; bf16_t* YC; const float* bg;
    __device__ __forceinline__ void operator()(const AccT& acc, const Unit& u, int wr, int wc, int fr, int fq) const {
        EPI_ROWS { const int row = EPI_ROW;
            EPI_BN { const int col = EPI_COL(bj, n); const f32x4 v = acc[ai][bj][m][n];
                float y[4]; ld4bf(YG + (size_t)row * 512 + col, y);
                UNR for (int j = 0; j < 4; ++j) y[j] *= sigm(v[j] + bg[col + j]);
                st4bf(YC + (size_t)row * 512 + col, y[0], y[1], y[2], y[3]); } }
    }
};
struct EpiLora {
    bf16_t* LW; bf16_t* IC; bf16_t* G; const float* w0; const float* a0;
    __device__ __forceinline__ void operator()(const AccT& acc, const Unit& u, int wr, int wc, int fr, int fq) const {
        const int blk = u.pn >> 1;
        if (blk < 2) {
            EPI_BN { __builtin_amdgcn_sched_barrier(0); const int col = EPI_COL(bj, n); float b[4];
                UNR for (int j = 0; j < 4; ++j) b[j] = w0[col + j];
                EPI_ROWS { const int row = EPI_ROW; const f32x4 v = acc[ai][bj][m][n]; float o[4];
                    UNR for (int j = 0; j < 4; ++j) { const float wl = -softplusf(-(b[j] + v[j])) - 0.5f; o[j] = -__expf(wl); }
                    st4bf(LW + ((size_t)blk * TOK + row) * 512 + (col & 511), o[0], o[1], o[2], o[3]); } }
        } else if (blk < 4) {
            EPI_BN { __builtin_amdgcn_sched_barrier(0); const int col = EPI_COL(bj, n) - 1024; float b[4];
                UNR for (int j = 0; j < 4; ++j) b[j] = a0[col + j];
                EPI_ROWS { const int row = EPI_ROW; const f32x4 v = acc[ai][bj][m][n]; float o[4];
                    UNR for (int j = 0; j < 4; ++j) o[j] = sigm(b[j] + v[j]);
                    st4bf(IC + ((size_t)(blk - 2) * TOK + row) * 512 + (col & 511), o[0], o[1], o[2], o[3]); } }
        } else {
            EPI_ROWS { const int row = EPI_ROW;
                EPI_BN { const int col = EPI_COL(bj, n) - 2048; const f32x4 v = acc[ai][bj][m][n];
                    st4bf(G + (size_t)row * 512 + col, v[0], v[1], v[2], v[3]); } }
        }
    }
};
struct EpiZg {
    bf16_t* ZG; int row0;
    __device__ __forceinline__ void operator()(const AccT& acc, const Unit& u, int wr, int wc, int fr, int fq) const {
        EPI_ROWS { const int row = row0 + EPI_ROW;
            EPI_BN { const int col = EPI_COL(bj, n); const f32x4 v = acc[ai][bj][m][n];
                st4bf(ZG + (size_t)row * 3072 + col, sigm(v[0]), sigm(v[1]), sigm(v[2]), sigm(v[3])); } }
    }
};
struct EpiMerge1 {
    const bf16_t* ZG; bf16_t* M; int row0;
    __device__ __forceinline__ void operator()(const AccT& acc, const Unit& u, int wr, int wc, int fr, int fq) const {
        EPI_ROWS { const int row = row0 + EPI_ROW;
            EPI_BN { const int col = EPI_COL(bj, n); const f32x4 v = acc[ai][bj][m][n];
                float gt[4]; ld4bf(ZG + (size_t)row * 3072 + u.g * 1024 + col, gt);
                float mv[4] = {0.f, 0.f, 0.f, 0.f}; if (u.g) ld4bf(M + (size_t)row * 1024 + col, mv);
                st4bf(M + (size_t)row * 1024 + col, mv[0] + gt[0] * v[0], mv[1] + gt[1] * v[1], mv[2] + gt[2] * v[2], mv[3] + gt[3] * v[3]); } }
    }
};
struct EpiRes {
    float* H; const float* gl; const float* gc; int row0;
    __device__ __forceinline__ void operator()(const AccT& acc, const Unit& u, int wr, int wc, int fr, int fq) const {
        EPI_ROWS { const int row = row0 + EPI_ROW; const float* gv = row < 256 ? gc : gl;
            EPI_BN { const int col = EPI_COL(bj, n); const f32x4 v = acc[ai][bj][m][n];
                float* hp = H + (size_t)row * 1024 + col; f32x4 hv = *(f32x4*)hp; const f32x4 gg = *(const f32x4*)(gv + col);
                hv += gg * v; *(f32x4*)hp = hv; } }
    }
};
struct EpiFfn {
    bf16_t* ACT; int row0;
    __device__ __forceinline__ void operator()(const AccT& acc, const Unit& u, int wr, int wc, int fr, int fq) const {
        EPI_ROWS { const int row = row0 + EPI_ROW;
            EPI_B { const int g32 = (u.pn * 256 + bj * 128 + wc * 32) >> 5, oc = g32 * 16 + 4 * fq;
                const f32x4 g = acc[ai][bj][m][0], up = acc[ai][bj][m][1];
                st4bf(ACT + (size_t)row * 2816 + oc, silu(g[0]) * up[0], silu(g[1]) * up[1], silu(g[2]) * up[2], silu(g[3]) * up[3]); } }
    }
};

template <class Map>
__device__ __forceinline__ void conv_T(const float* src, int src_ld, bf16_t* dst, int Nd, int K, Map map, float* sm, int shift, int tid_l, int bid_l) {
    const int tk = K / 64, ntile = (Nd / 64) * tk;
    for (int t = (bid_l + shift) % gridDim.x; t < ntile; t += gridDim.x) {
        const int n0 = (t / tk) * 64, k0 = (t % tk) * 64;
        { const int n = tid_l & 63, kq = tid_l >> 6; const int col = map(n0 + n);
            for (int e = 0; e < 8; ++e) { const int k = e * 8 + kq; sm[k * 65 + n] = col >= 0 ? src[(size_t)(k0 + k) * src_ld + col] : 0.f; } }
        __syncthreads();
        { const int k = tid_l & 63, nq = tid_l >> 6;
            for (int e = 0; e < 8; ++e) { const int n2 = e * 8 + nq; dst[(size_t)(n0 + n2) * K + k0 + k] = f2bf(sm[k * 65 + n2]); } }
        __syncthreads();
    }
}
struct MapIna { __device__ int operator()(int n) const { return n < 1024 ? n : (n < 1536 ? 2944 + (n - 1024) : (n < 3456 ? 1024 + (n - 1536) : -1)); } };
struct MapOff { int off; __device__ int operator()(int n) const { return off + n; } };
struct MapFfn { __device__ int operator()(int n) const { const int g32 = n >> 5, w = n & 31; return w < 16 ? g32 * 16 + w : 2816 + g32 * 16 + (w - 16); } };

__device__ __forceinline__ void norm_rows(const float* H, const float* nw, const float* modl, const float* modc, int shoff, int scoff, bf16_t* HN, int row_begin, int tid_l, int bid_l) {
    const int wid = tid_l >> 6, lane = tid_l & 63;
    for (int row = row_begin + bid_l * 8 + wid; row < TOK; row += gridDim.x * 8) {
        const float* hp = H + (size_t)row * 1024; const float* mv = row < 256 ? modc : modl;
        f32x4 x[4]; float ss = 0.f;
        UNR for (int e = 0; e < 4; ++e) { x[e] = *(const f32x4*)(hp + e * 256 + lane * 4); ss += x[e][0] * x[e][0] + x[e][1] * x[e][1] + x[e][2] * x[e][2] + x[e][3] * x[e][3]; }
        ss = wave_sum(ss, lane); const float sc = rsqrtf(ss * (1.0f / 1024.0f) + 1e-6f);
        UNR for (int e = 0; e < 4; ++e) { const int c = e * 256 + lane * 4; float y[4];
            UNR for (int j = 0; j < 4; ++j) y[j] = x[e][j] * sc * nw[c + j] * (1.0f + mv[scoff + c + j]) + mv[shoff + c + j];
            st4bf(HN + (size_t)row * 1024 + c, y[0], y[1], y[2], y[3]); }
    }
}

typedef float f32x2 __attribute__((ext_vector_type(2)));
__device__ __forceinline__ float quad_sum(float v) {
    v += __int_as_float(__builtin_amdgcn_mov_dpp(__float_as_int(v), 0xB1, 0xF, 0xF, true));
    v += __int_as_float(__builtin_amdgcn_mov_dpp(__float_as_int(v), 0x4E, 0xF, 0xF, true));
    return v;
}
constexpr int WCH = 260, WNC = 64, WSC = 13, WVEC = 6 * 64;
template <int R, bool WITH_Y>
__device__ __forceinline__ void wkv_steps(f32x2 (&s)[R][8], const float* stg, float* sy, int nst, int row0, bool hasv, int sub) {
    for (int jj = 0; jj < nst; ++jj) {
        const float* base = stg + jj * WVEC + sub * 16;
        f32x2 kk[8];
#pragma unroll
        for (int i = 0; i < 4; ++i) { const f32x4 t = *(const f32x4*)(base + 64 + i * 4); kk[2 * i] = (f32x2){t[0], t[1]}; kk[2 * i + 1] = (f32x2){t[2], t[3]}; }
        float nsa[R], vv[R];
#pragma unroll
        for (int r = 0; r < R; ++r) { f32x2 a = s[r][0] * kk[0];
#pragma unroll
            for (int i = 1; i < 8; ++i) a = __builtin_elementwise_fma(s[r][i], kk[i], a);
            nsa[r] = -quad_sum(a[0] + a[1]); vv[r] = hasv ? stg[jj * WVEC + 320 + row0 + r] : 0.f; }
        f32x2 w[8], bb[8], kd[8];
#pragma unroll
        for (int i = 0; i < 4; ++i) { const f32x4 t0 = *(const f32x4*)(base + i * 4), t1 = *(const f32x4*)(base + 128 + i * 4), t2 = *(const f32x4*)(base + 192 + i * 4);
            w[2 * i] = (f32x2){t0[0], t0[1]}; w[2 * i + 1] = (f32x2){t0[2], t0[3]}; bb[2 * i] = (f32x2){t1[0], t1[1]}; bb[2 * i + 1] = (f32x2){t1[2], t1[3]};
            kd[2 * i] = (f32x2){t2[0], t2[1]}; kd[2 * i + 1] = (f32x2){t2[2], t2[3]}; }
#pragma unroll
        for (int r = 0; r < R; ++r) { const f32x2 v2 = (f32x2){vv[r], vv[r]}, n2 = (f32x2){nsa[r], nsa[r]};
#pragma unroll
            for (int i = 0; i < 8; ++i) { const f32x2 t = __builtin_elementwise_fma(n2, bb[i], v2 * kd[i]); s[r][i] = __builtin_elementwise_fma(s[r][i], w[i], t); } }
        if (WITH_Y) {
            f32x2 rr[8];
#pragma unroll
            for (int i = 0; i < 4; ++i) { const f32x4 t = *(const f32x4*)(base + 256 + i * 4); rr[2 * i] = (f32x2){t[0], t[1]}; rr[2 * i + 1] = (f32x2){t[2], t[3]}; }
#pragma unroll
            for (int r = 0; r < R; ++r) { f32x2 a = s[r][0] * rr[0];
#pragma unroll
                for (int i = 1; i < 8; ++i) a = __builtin_elementwise_fma(s[r][i], rr[i], a);
                const float y = quad_sum(a[0] + a[1]); if (sub == 0) sy[jj * 64 + row0 + r] = y; }
        }
    }
}
__device__ __forceinline__ void wkv_stage1(float* dst, const bf16_t* ZBp, const bf16_t* LWp, const bf16_t* ICp, const float* mu, const float* kkw, const float* kaw,
                                           int dir, int head, int pos, int ln) {
    const int col = head * 64 + ln, tk = tok_of(dir, pos);
    const float r = zshift(ZBp, tk, col, mu[col]), k = zshift(ZBp, tk, 512 + col, mu[512 + col]), v = zshift(ZBp, tk, 1024 + col, mu[1024 + col]);
    const float kx = k * kkw[col]; const float ssq = wave_sum(kx * kx, ln); const float kk = kx * rsqrtf(ssq + 1e-12f);
    const size_t o = ((size_t)dir * TOK + tk) * 512 + col;
    const float w = __expf(bf2f(LWp[o])), ic = bf2f(ICp[o]);
    dst[ln] = w; dst[64 + ln] = kk; dst[128 + ln] = kk * ic; dst[192 + ln] = k * (1.0f + (ic - 1.0f) * kaw[col]); dst[256 + ln] = r; dst[320 + ln] = v;
}

__device__ __forceinline__ int launder_s(int i) { asm volatile("" : "+s"(i)); return i; }
#define IN(i) (p.in[launder_s(i)])
constexpr int PH_PER_LAYER = 19;
constexpr int NPHASE = 1 + NLAYER * PH_PER_LAYER + 1;

#define ZA ((bf16_t*)(ws + X_ZA))
#define ZB ((bf16_t*)(ws + OFF_ZB))
#define XC ((bf16_t*)(ws + X_XC))
#define LA ((bf16_t*)(ws + X_LA))
#define LU ((bf16_t*)(ws + X_LU))
#define A5 ((bf16_t*)(ws + X_A5))
#define YS ((bf16_t*)(ws + OFF_YS))
#define YA YS
#define YB (YS + (size_t)TOK * 512)
#define YC (YS + (size_t)2 * TOK * 512)
#define S5E ((float*)(ws + OFF_HN))
#define CA ((float*)(ws + M_CA))
#define CB ((float*)(ws + M_CB))
#define HIN ((float*)(ws + M_HIN))
#define LW ((bf16_t*)(ws + X_LW))
#define IC ((bf16_t*)(ws + X_IC))
#define GG ((bf16_t*)(ws + X_G))
#define YD1 ((bf16_t*)(ws + X_YD1))
#define LORAA ((bf16_t*)(ws + X_LORAA))
#define PQ ((float*)(ws + X_PQ))
#define SCS ((float*)(ws + X_SC))
#define ZG ((bf16_t*)(ws + X_ZG))
#define ACT ((bf16_t*)(ws + X_ACT))
#define MM ((bf16_t*)(ws + X_M))
template <int KSEL>
__device__ __forceinline__ void run_phase(const Params& p, int ph, unsigned char* shm, int wv) {
    unsigned char* ws = p.ws;
    float* sm = (float*)shm;
    LAS unsigned char* lds = (LAS unsigned char*)shm;
#ifdef TID_MBCNT
    int tid; asm volatile("v_mbcnt_lo_u32_b32 %0, -1, 0\n\tv_mbcnt_hi_u32_b32 %0, -1, %0" : "=v"(tid)); tid += wv * 64;
#else
    int tid = threadIdx.x; asm volatile("" : "+v"(tid)); (void)wv;
#endif
    int bid = blockIdx.x; asm volatile("" : "+s"(bid));
#define wid (tid >> 6)
#define lane (tid & 63)
#define gtid ((size_t)bid * NTHR + tid)
#define gthreads ((size_t)gridDim.x * NTHR)
    float* H = (float*)(ws + OFF_H);
    bf16_t* HN = (bf16_t*)(ws + OFF_HN);
    float* MODV = (float*)(ws + M_MODV);
    float* PW = (float*)(ws + M_PW);
    float* BBT = (float*)(ws + M_BB);

    if (KSEL == 100 && ph != 0) return;
    if (KSEL == 101 && ph != NPHASE - 1) return;
    if (KSEL >= 0 && KSEL < 100 && (ph == 0 || ph == NPHASE - 1)) return;
    if (ph == 0) {
        for (int vb = bid; vb < 48 + 32 + 512; vb += gridDim.x) {
            if (vb < 48) {
                __syncthreads();
                for (int k = tid; k < 1024; k += NTHR) { sm[k] = silu(IN(I_C)[k]); sm[1024 + k] = silu(IN(I_CCTX)[k]); }
                __syncthreads();
                const int idx = vb * NTHR + tid, layer = idx / 6144, n = idx % 6144;
                const float* w = IN(I_WMOD) + (size_t)layer * 1024 * 6144 + n;
                float al = 0.f, ac = 0.f;
                for (int k = 0; k < 1024; ++k) { const float wv = w[(size_t)k * 6144]; al += sm[k] * wv; ac += sm[1024 + k] * wv; }
                const float b = IN(I_BMOD)[layer * 6144 + n];
                MODV[(layer * 2 + 0) * 6144 + n] = al + b; MODV[(layer * 2 + 1) * 6144 + n] = ac + b;
            } else if (vb < 80) {
                const int idx = (vb - 48) * NTHR + tid;
                const int pp = idx & 63, g = (idx >> 6) & 31, ld = idx >> 11;
                const float lre = IN(I_S5LRE)[idx], lim = IN(I_S5LIM)[idx], step = __expf(IN(I_S5STEP)[ld * 32 + g]);
                const float xr = lre * step, ang = lim * step;
                for (int t = 0; t <= 16; ++t) { const float mg = expf(xr * t); PW[((size_t)idx * 17 + t) * 2] = mg * cosf(ang * t); PW[((size_t)idx * 17 + t) * 2 + 1] = mg * sinf(ang * t); }
                const float mg = expf(xr), lbim = mg * sinf(ang), sh = sinf(0.5f * ang);
                const float nr = expm1f(xr) * cosf(ang) - 2.0f * sh * sh, den = lre * lre + lim * lim;
                const float fre = (nr * lre + lbim * lim) / den, fim = (lbim * lre - nr * lim) / den;
                for (int c = 0; c < 16; ++c) { const float br = IN(I_S5BRE)[(size_t)idx * 16 + c], bi = IN(I_S5BIM)[(size_t)idx * 16 + c];
                    BBT[((size_t)idx * 16 + c) * 2] = fre * br - fim * bi; BBT[((size_t)idx * 16 + c) * 2 + 1] = fre * bi + fim * br; }
                (void)pp;
            } else {
                const int cb = vb - 80;
                for (size_t i = (size_t)cb * NTHR + tid; i < (size_t)TOK * 256; i += (size_t)512 * NTHR) {
                    const f32x4 v = i < (size_t)256 * 256 ? ((const f32x4*)IN(I_CTX))[i] : ((const f32x4*)IN(I_X))[i - (size_t)256 * 256];
                    ((f32x4*)H)[i] = v; }
            }
        }
        return;
    }
    if (ph == NPHASE - 1) {
        const float* nw = IN(I_NORMF);
        for (int row = 256 + bid * 8 + wid; row < TOK; row += gridDim.x * 8) {
            const float* hp = H + (size_t)row * 1024; f32x4 x[4]; float ss = 0.f;
            UNR for (int e = 0; e < 4; ++e) { x[e] = *(const f32x4*)(hp + e * 256 + lane * 4); ss += x[e][0] * x[e][0] + x[e][1] * x[e][1] + x[e][2] * x[e][2] + x[e][3] * x[e][3]; }
            ss = wave_sum(ss, lane); const float sc = rsqrtf(ss * (1.0f / 1024.0f) + 1e-6f);
            UNR for (int e = 0; e < 4; ++e) { const int c = e * 256 + lane * 4; f32x4 y; UNR for (int j = 0; j < 4; ++j) y[j] = x[e][j] * sc * nw[c + j];
                *(f32x4*)(p.out + (size_t)(row - 256) * 1024 + c) = y; }
        }
        return;
    }
    const int L = (ph - 1) / PH_PER_LAYER, k = (ph - 1) % PH_PER_LAYER;
    const bool last = (L == NLAYER - 1);
    const float* modl = MODV + (L * 2 + 0) * 6144; const float* modc = MODV + (L * 2 + 1) * 6144;
    const int row0 = last ? 256 : 0, Mrows = last ? 16384 : TOK;

    if (KSEL >= 0 && k != KSEL) return;
    switch (k) {
    case 0: {
        conv_T(IN(I_WIN) + (size_t)L * 1024 * 6528, 6528, (bf16_t*)(ws + W_INA), 3584, 1024, MapIna(), sm, 0, tid, bid);
        conv_T(IN(I_WGLU) + (size_t)L * 512 * 512, 512, (bf16_t*)(ws + W_GLU), 512, 512, MapOff{0}, sm, 128, tid, bid);
        {
            bf16_t* W = (bf16_t*)(ws + W_LRU); const float* pwa = IN(I_WA); const float* pwx = IN(I_WX);
            for (size_t i = gtid; i < (size_t)2048 * 512; i += gthreads) { const int n = (int)(i >> 9), kk = (int)(i & 511);
                const int g32 = n >> 5, which = (n & 31) >> 4, dir = g32 >> 5, ch = (g32 & 31) * 16 + (n & 15), head = ch >> 6, j = ch & 63;
                float v = 0.f; if ((kk >> 6) == head) v = (which ? pwx : pwa)[((((size_t)L * 2 + dir) * 8 + head) * 64 + (kk & 63)) * 64 + j];
                W[i] = f2bf(v); }
        }
        {
            bf16_t* W = (bf16_t*)(ws + W_LORA);
            for (size_t i = gtid; i < (size_t)2560 * 384; i += gthreads) { const int n = (int)(i / 384), kk = (int)(i % 384);
                const int blk = n >> 9, ch = n & 511; float v = 0.f;
                if (blk < 2) { if ((kk >> 6) == blk) v = IN(I_W2)[(((size_t)L * 2 + blk) * 64 + (kk & 63)) * 512 + ch]; }
                else if (blk < 4) { if ((kk >> 6) == blk) v = IN(I_A2)[(((size_t)L * 2 + (blk - 2)) * 64 + (kk & 63)) * 512 + ch]; }
                else { if (kk >= 256) v = IN(I_G2)[((size_t)L * 128 + (kk - 256)) * 512 + ch]; }
                W[i] = f2bf(v); }
        }
        {
            float* KT = (float*)(ws + M_KT);
            const float* cre = IN(I_S5CRE) + (size_t)L * 2 * 32 * 16 * 64; const float* cim = IN(I_S5CIM) + (size_t)L * 2 * 32 * 16 * 64;
            const float* pw = PW + (size_t)L * 2 * 32 * 64 * 17 * 2; const float* bb = BBT + (size_t)L * 2 * 32 * 64 * 16 * 2;
            for (size_t i = gtid; i < (size_t)2 * 32 * 16 * 256; i += gthreads) {
                const int c = (int)(i & 15), cp = (int)((i >> 4) & 15), tau = (int)((i >> 8) & 15), dg = (int)(i >> 12);
                const float* cr = cre + ((size_t)dg * 16 + cp) * 64; const float* ci = cim + ((size_t)dg * 16 + cp) * 64;
                const float* pwd = pw + (size_t)dg * 64 * 34 + tau * 2; const float* bbd = bb + (size_t)dg * 64 * 32 + c * 2;
                float v = 0.f;
#pragma unroll 8
                for (int pp = 0; pp < 64; ++pp) { const float pr = pwd[pp * 34], pi = pwd[pp * 34 + 1], br = bbd[pp * 32], bi = bbd[pp * 32 + 1];
                    v += cr[pp] * (pr * br - pi * bi) - ci[pp] * (pr * bi + pi * br); }
                KT[i] = v; }
        }
        norm_rows(H, IN(I_NORM1) + L * 1024, modl, modc, 0, 1024, HN, 0, tid, bid);
    } break;
    case 1: {
        GemmArgs g{HN, (const bf16_t*)(ws + W_INA), 1024, 1024, 1024}; StaticOrder S; S.init(TOK, 3584, bid);
        gemm_phase(lds, g, S, EpiZ{ZA, ZB}, tid);
    } break;
    case 2: {
        const float* cw = IN(I_CONVW) + L * 2048; const float* cb = IN(I_CONVB) + L * 512;
        for (size_t i = gtid; i < (size_t)TOK * 512; i += gthreads) { const int tk = (int)(i >> 9), ch = (int)(i & 511);
            const int lo = tk < 256 ? 0 : 256, hi = tk < 256 ? 256 : TOK; float a = cb[ch];
            UNR for (int j = 0; j < 4; ++j) { const int t2 = tk + j - 2; if (t2 >= lo && t2 < hi) a += cw[j * 512 + ch] * bf2f(ZA[(size_t)t2 * 1536 + ch]); }
            XC[i] = f2bf(a); }
        for (size_t i = gtid; i < (size_t)32 * 1040 * 16; i += gthreads) { const int j = (int)(i & 15); const int s = (int)((i >> 4) % 1040), g = (int)((i >> 4) / 1040);
            const int tk = s5_tok(s * 16 + j); const u32x4* src = (const u32x4*)(ZA + (size_t)tk * 1536 + 1024 + g * 16); u32x4* dst = (u32x4*)(A5 + ((size_t)g * 1040 + s) * 512 + j * 16);
            dst[0] = src[0]; dst[1] = src[1]; }
        {
            bf16_t* WY = (bf16_t*)(ws + W_S5Y); bf16_t* WE = (bf16_t*)(ws + W_S5E); const float* KT = (const float*)(ws + M_KT);
            const float* cre = IN(I_S5CRE) + (size_t)L * 2 * 32 * 16 * 64; const float* cim = IN(I_S5CIM) + (size_t)L * 2 * 32 * 16 * 64;
            const float* pw = PW + (size_t)L * 2 * 32 * 64 * 17 * 2; const float* bb = BBT + (size_t)L * 2 * 32 * 64 * 16 * 2;
            for (size_t i = gtid; i < (size_t)32 * 256 * 512; i += gthreads) {
                const int kk = (int)(i & 511), n = (int)((i >> 9) & 255), g = (int)(i >> 17), t = n >> 4, cp = n & 15; float v = 0.f;
                if (kk < 256) { const int j = kk >> 4, c = kk & 15;
                    if (t >= j) v += KT[((((size_t)0 * 32 + g) * 16 + (t - j)) * 16 + cp) * 16 + c];
                    if (j >= t) v += KT[((((size_t)1 * 32 + g) * 16 + (j - t)) * 16 + cp) * 16 + c]; }
                else { const int d = (kk - 256) >> 7, pp = ((kk - 256) & 127) >> 1, ri = kk & 1; const int e = d == 0 ? t + 1 : 16 - t;
                    const float cr = cre[((size_t)(d * 32 + g) * 16 + cp) * 64 + pp], ci = cim[((size_t)(d * 32 + g) * 16 + cp) * 64 + pp];
                    const float pr = pw[((size_t)(d * 32 + g) * 64 + pp) * 34 + e * 2], pi = pw[((size_t)(d * 32 + g) * 64 + pp) * 34 + e * 2 + 1];
                    v = ri == 0 ? (cr * pr - ci * pi) : -(cr * pi + ci * pr); }
                WY[i] = f2bf(v); }
            for (size_t i = gtid; i < (size_t)32 * 256 * 256; i += gthreads) {
                const int kk = (int)(i & 255), n = (int)((i >> 8) & 255), g = (int)(i >> 16), d = n >> 7, pp = (n & 127) >> 1, ri = n & 1, j = kk >> 4, c = kk & 15;
                const int e = d == 0 ? 15 - j : j;
                const float pr = pw[((size_t)(d * 32 + g) * 64 + pp) * 34 + e * 2], pi = pw[((size_t)(d * 32 + g) * 64 + pp) * 34 + e * 2 + 1];
                const float br = bb[((size_t)(d * 32 + g) * 64 + pp) * 32 + c * 2], bi = bb[((size_t)(d * 32 + g) * 64 + pp) * 32 + c * 2 + 1];
                WE[i] = f2bf(ri == 0 ? pr * br - pi * bi : pr * bi + pi * br); }
        }
    } break;
    case 3: {
        { GemmArgs g{XC, (const bf16_t*)(ws + W_LRU), 512, 512, 512}; StaticOrder S; S.init(TOK, 2048, bid);
          gemm_phase(lds, g, S, EpiLruGate{XC, LA, LU, IN(I_BA) + L * 1024, IN(I_BX) + L * 1024, IN(I_LAM) + L * 1024}, tid); }
        asm volatile("" : "+v"(tid));
        { GemmArgs g{A5, (const bf16_t*)(ws + W_S5E), 512, 256, 256}; S5Order S; S.init(248, bid);
          gemm_phase(lds, g, S, EpiS5E{S5E}, tid); }
    } break;
    case 4: {
        for (int task = bid; task < 520 + 8; task += gridDim.x) {
            if (task < 520) { const int c = task >> 1, dir = task & 1, ch = tid; float As = 0.f, Bs = 0.f;
                for (int j0 = 0; j0 < 64; j0 += 16) { float la[16], uu[16];
                    UNR for (int j = 0; j < 16; ++j) { const int tk = tok_of(dir, c * 64 + j0 + j); const size_t o = ((size_t)dir * TOK + tk) * 512 + ch; la[j] = bf2f(LA[o]); uu[j] = bf2f(LU[o]); }
                    UNR for (int j = 0; j < 16; ++j) { As += la[j]; Bs = __expf(la[j]) * Bs + uu[j]; } }
                CA[(dir * 260 + c) * 512 + ch] = As; CB[(dir * 260 + c) * 512 + ch] = Bs;
            } else { const int idx = (task - 520) * NTHR + tid;
                const int pp = idx & 63, dir = (idx >> 6) & 1, g = idx >> 7;
                const float* pw = PW + ((((size_t)L * 2 + dir) * 32 + g) * 64 + pp) * 34; const float ar = pw[32], ai = pw[33];
                float hr = 0.f, hi = 0.f; const int cb = dir * 128 + pp * 2;
                for (int q0 = 0; q0 < 1040; q0 += 16) { float er[16], ei[16];
                    UNR for (int j = 0; j < 16; ++j) { const int q = q0 + j, s = dir == 0 ? q : (q < 16 ? 15 - q : 1055 - q); const float* ep = S5E + ((size_t)g * 1040 + s) * 256 + cb; er[j] = ep[0]; ei[j] = ep[1]; }
                    UNR for (int j = 0; j < 16; ++j) { const int q = q0 + j, s = dir == 0 ? q : (q < 16 ? 15 - q : 1055 - q);
                        *(unsigned*)(A5 + ((size_t)g * 1040 + s) * 512 + 256 + cb) = pack2(hr, hi);
                        const float nr = ar * hr - ai * hi + er[j], ni = ar * hi + ai * hr + ei[j]; hr = nr; hi = ni; } }
            }
        }
    } break;
    case 5: {
        if (bid < 2) { const int dir = bid, ch = tid; float h = 0.f;
            for (int c0 = 0; c0 < 260; c0 += 13) { float a[13], b[13];
                UNR for (int j = 0; j < 13; ++j) { a[j] = CA[(dir * 260 + c0 + j) * 512 + ch]; b[j] = CB[(dir * 260 + c0 + j) * 512 + ch]; }
                UNR for (int j = 0; j < 13; ++j) { HIN[(dir * 260 + c0 + j) * 512 + ch] = h; h = __expf(a[j]) * h + b[j]; } } }
        __syncthreads(); asm volatile("" : "+v"(tid));
        { GemmArgs g{A5, (const bf16_t*)(ws + W_S5Y), 512, 512, 512}; S5Order S; S.init(254, bid);
          gemm_phase(lds, g, S, EpiS5Y{ZA, XC, IN(I_S5D) + L * 512}, tid); }
    } break;
    case 6: {
        for (int ct = bid; ct < 260; ct += gridDim.x) { const int ch = tid;
            float h = HIN[(0 * 260 + ct) * 512 + ch];
            for (int j0 = 0; j0 < 64; j0 += 16) { float la[16], uu[16];
                UNR for (int j = 0; j < 16; ++j) { const size_t o = (size_t)(ct * 64 + j0 + j) * 512 + ch; la[j] = bf2f(LA[o]); uu[j] = bf2f(LU[o]); }
                UNR for (int j = 0; j < 16; ++j) { const size_t o = (size_t)(ct * 64 + j0 + j) * 512 + ch; h = __expf(la[j]) * h + uu[j]; YA[o] = f2bf(h); } }
            const int c1 = ct < 4 ? 3 - ct : 263 - ct; h = HIN[(1 * 260 + c1) * 512 + ch];
            for (int j0 = 0; j0 < 64; j0 += 16) { float la[16], uu[16], ga[16], hf[16];
                UNR for (int j = 0; j < 16; ++j) { const int tk = ct * 64 + 63 - j0 - j; const size_t o = (size_t)tk * 512 + ch, o1 = (size_t)TOK * 512 + o;
                    la[j] = bf2f(LA[o1]); uu[j] = bf2f(LU[o1]); ga[j] = bf2f(ZA[(size_t)tk * 1536 + 512 + ch]); hf[j] = bf2f(YA[o]); }
                UNR for (int j = 0; j < 16; ++j) { const int tk = ct * 64 + 63 - j0 - j; const size_t o = (size_t)tk * 512 + ch;
                    h = __expf(la[j]) * h + uu[j]; YA[o] = f2bf(gelu_t(ga[j]) * (hf[j] + h)); } } }
        __syncthreads(); asm volatile("" : "+v"(tid));
        { GemmArgs g{XC, (const bf16_t*)(ws + W_GLU), 512, 512, 512}; StaticOrder S; S.init(TOK, 512, bid);
          gemm_phase(lds, g, S, EpiGlu{XC, YC, IN(I_BGLU) + L * 512}, tid); }
    } break;
    case 7: {
        const float* mu = IN(I_MU) + L * 1920;
        for (size_t i = gtid; i < (size_t)TOK * 384; i += gthreads) { const int tk = (int)(i / 384), q = (int)(i % 384);
            const float z = zshift(ZB, tk, 1536 + q, mu[1536 + q]);
            LORAA[i] = f2bf(q < 128 ? tanhf(z) : (q < 256 ? z : sigm(z))); }
    } break;
    case 8: {
        GemmArgs g{LORAA, (const bf16_t*)(ws + W_LORA), 384, 384, 384}; StaticOrder S; S.init(TOK, 2560, bid);
        gemm_phase(lds, g, S, EpiLora{LW, IC, GG, IN(I_W0) + L * 1024, IN(I_A0) + L * 1024}, tid);
    } break;
    case 9: {
        const float* mu = IN(I_MU) + L * 1920; const float* kkw = IN(I_KK) + L * 512; const float* kaw = IN(I_KA) + L * 512;
        for (int t4 = bid; t4 < 16 * WNC / 4; t4 += gridDim.x) {
            const int q = wid >> 1, half = wid & 1, task = t4 * 4 + q, hd = task / WNC, c = task % WNC;
            const int sub = tid & 3, row0 = ((tid & 63) >> 2) * 4;
            f32x2 s[4][8];
            UNR for (int r = 0; r < 4; ++r) UNR for (int i = 0; i < 8; ++i) { const int ch = sub * 16 + 2 * i;
                s[r][i] = (f32x2){(half == 1 && row0 + r == ch) ? 1.f : 0.f, (half == 1 && row0 + r == ch + 1) ? 1.f : 0.f}; }
            for (int sc = 0; sc < WCH / WSC; ++sc) {
                __syncthreads();
                for (int pr = wid; pr < 4 * WSC; pr += 8) { const int qq = pr / WSC, jj = pr % WSC, tk2 = t4 * 4 + qq, hd2 = tk2 / WNC, c2 = tk2 % WNC;
                    wkv_stage1(sm + (qq * WSC + jj) * WVEC, ZB, LW, IC, mu, kkw, kaw, hd2 >> 3, hd2 & 7, c2 * WCH + sc * WSC + jj, lane); }
                __syncthreads();
                wkv_steps<4, false>(s, sm + q * WSC * WVEC, nullptr, WSC, row0, half == 0, sub);
            }
            UNR for (int r = 0; r < 4; ++r) { float* dst = PQ + ((size_t)hd * WNC + c) * 8192 + half * 4096 + (row0 + r) * 64 + sub * 16;
                UNR for (int i = 0; i < 8; i += 2) *(f32x4*)(dst + 2 * i) = (f32x4){s[r][i][0], s[r][i][1], s[r][i + 1][0], s[r][i + 1][1]}; }
        }
    } break;
    case 10: {
        for (int task = bid; task < 128; task += gridDim.x) { const int hd = task >> 3, rg = task & 7, r = tid >> 6, i = tid & 63, vrow = rg * 8 + r;
            float sv = 0.f; float* Ps = sm + 512;
            const float* P0 = PQ + ((size_t)hd * WNC) * 8192;
            f32x4 pa = *(const f32x4*)(P0 + 4096 + tid * 8), pb = *(const f32x4*)(P0 + 4096 + tid * 8 + 4); float qc = P0[vrow * 64 + i];
            for (int c = 0; c < WNC; ++c) {
                __syncthreads();
                *(f32x4*)(Ps + tid * 8) = pa; *(f32x4*)(Ps + tid * 8 + 4) = pb; sm[r * 64 + i] = sv;
                SCS[((size_t)hd * WNC + c) * 4096 + vrow * 64 + i] = sv;
                float a2 = qc;
                if (c + 1 < WNC) { const float* P1 = PQ + ((size_t)hd * WNC + c + 1) * 8192; pa = *(const f32x4*)(P1 + 4096 + tid * 8); pb = *(const f32x4*)(P1 + 4096 + tid * 8 + 4); qc = P1[vrow * 64 + i]; }
                __syncthreads();
#pragma unroll 16
                for (int a = 0; a < 64; ++a) a2 += sm[r * 64 + a] * Ps[a * 64 + i];
                sv = a2;
            }
            __syncthreads();
        }
    } break;
    case 11: {
        const float* mu = IN(I_MU) + L * 1920; const float* kkw = IN(I_KK) + L * 512; const float* kaw = IN(I_KA) + L * 512;
        for (int t4 = bid; t4 < 16 * WNC / 4; t4 += gridDim.x) {
            const int q = wid >> 1, task = t4 * 4 + q, hd = task / WNC, c = task % WNC;
            const int sub = tid & 3, row0 = ((tid & 127) >> 2) * 2;
            f32x2 s[2][8]; float* sy = sm + 4 * WSC * WVEC;
            UNR for (int r = 0; r < 2; ++r) { const float* src = SCS + ((size_t)hd * WNC + c) * 4096 + (row0 + r) * 64 + sub * 16;
                UNR for (int i = 0; i < 8; i += 2) { const f32x4 t = *(const f32x4*)(src + 2 * i); s[r][i] = (f32x2){t[0], t[1]}; s[r][i + 1] = (f32x2){t[2], t[3]}; } }
            for (int sc = 0; sc < WCH / WSC; ++sc) {
                __syncthreads();
                for (int pr = wid; pr < 4 * WSC; pr += 8) { const int qq = pr / WSC, jj = pr % WSC, tk2 = t4 * 4 + qq, hd2 = tk2 / WNC, c2 = tk2 % WNC;
                    wkv_stage1(sm + (qq * WSC + jj) * WVEC, ZB, LW, IC, mu, kkw, kaw, hd2 >> 3, hd2 & 7, c2 * WCH + sc * WSC + jj, lane); }
                __syncthreads();
                wkv_steps<2, true>(s, sm + q * WSC * WVEC, sy + q * WSC * 64, WSC, row0, true, sub);
                __syncthreads();
                for (int e = tid; e < 4 * WSC * 64; e += NTHR) { const int qq = e / (WSC * 64), jj = (e / 64) % WSC, vch = e & 63, tk2 = t4 * 4 + qq, hd2 = tk2 / WNC, c2 = tk2 % WNC, d2 = hd2 >> 3;
                    bf16_t* YD = d2 == 0 ? YB : YD1; YD[(size_t)tok_of(d2, c2 * WCH + sc * WSC + jj) * 512 + (hd2 & 7) * 64 + vch] = f2bf(sy[e]); }
            }
        }
    } break;
    case 12: {
        const float* mu = IN(I_MU) + L * 1920; const float* kaw = IN(I_KA) + L * 512; const float* rk = IN(I_RK) + L * 512;
        const float* lnw = IN(I_LNW) + L * 512; const float* lnb = IN(I_LNB) + L * 512;
        for (int wt = bid * 8 + wid; wt < TOK * 8; wt += gridDim.x * 8) { const int tk = wt >> 3, head = wt & 7, col = head * 64 + lane; const size_t o = (size_t)tk * 512 + col;
            const float y = bf2f(YB[o]) + bf2f(YD1[o]);
            const float mean = wave_sum(y, lane) * (1.0f / 64.0f); const float dv = y - mean; const float var = wave_sum(dv * dv, lane) * (1.0f / 64.0f);
            float yn = dv * rsqrtf(var + 64e-5f) * lnw[col] + lnb[col];
            const float r = zshift(ZB, tk, col, mu[col]), kx = zshift(ZB, tk, 512 + col, mu[512 + col]), v = zshift(ZB, tk, 1024 + col, mu[1024 + col]);
            const float ic0 = bf2f(IC[o]), ic1 = bf2f(IC[(size_t)TOK * 512 + o]);
            const float kd0 = kx * (1.0f + (ic0 - 1.0f) * kaw[col]), kd1 = kx * (1.0f + (ic1 - 1.0f) * kaw[col]);
            const float bon = wave_sum(r * (kd0 + kd1) * rk[col], lane);
            yn += bon * v;
            YB[o] = f2bf(yn * bf2f(GG[o])); }
        __syncthreads();
        conv_T(IN(I_WIN) + (size_t)L * 1024 * 6528, 6528, (bf16_t*)(ws + W_INZG), 3072, 1024, MapOff{3456}, sm, 0, tid, bid);
        for (int kb = 0; kb < 3; ++kb) conv_T(IN(I_WBR) + ((size_t)L * 3 + kb) * 512 * 1024, 1024, (bf16_t*)(ws + W_BR) + (size_t)kb * 1024 * 512, 1024, 512, MapOff{0}, sm, kb * 64, tid, bid);
        conv_T(IN(I_WOUT) + (size_t)L * 1024 * 1024, 1024, (bf16_t*)(ws + W_OUT), 1024, 1024, MapOff{0}, sm, 192, tid, bid);
        conv_T(IN(I_WFIN) + (size_t)L * 1024 * 5632, 5632, (bf16_t*)(ws + W_FIN), 5632, 1024, MapFfn(), sm, 0, tid, bid);
        conv_T(IN(I_WFOUT) + (size_t)L * 2816 * 1024, 1024, (bf16_t*)(ws + W_FOUT), 1024, 2816, MapOff{0}, sm, 128, tid, bid);
        norm_rows(H, IN(I_NORM1) + L * 1024, modl, modc, 0, 1024, HN, row0, tid, bid);
    } break;
    case 13: {
        GemmArgs g{HN + (size_t)row0 * 1024, (const bf16_t*)(ws + W_INZG), 1024, 1024, 1024}; StaticOrder S; S.init(Mrows, 3072, bid);
        gemm_phase(lds, g, S, EpiZg{ZG, row0}, tid);
    } break;
    case 14: {
        GemmArgs g{YS + (size_t)row0 * 512, (const bf16_t*)(ws + W_BR), 512, 512, 512}; TripleOrder S; S.init(Mrows, bid);
        gemm_phase(lds, g, S, EpiMerge1{ZG, MM, row0}, tid);
    } break;
    case 15: {
        GemmArgs g{MM + (size_t)row0 * 1024, (const bf16_t*)(ws + W_OUT), 1024, 1024, 1024}; StaticOrder S; S.init(Mrows, 1024, bid);
        gemm_phase(lds, g, S, EpiRes{H, modl + 2048, modc + 2048, row0}, tid);
    } break;
    case 16: {
        norm_rows(H, IN(I_NORM2) + L * 1024, modl, modc, 3072, 4096, HN, row0, tid, bid);
    } break;
    case 17: {
        GemmArgs g{HN + (size_t)row0 * 1024, (const bf16_t*)(ws + W_FIN), 1024, 1024, 1024}; StaticOrder S; S.init(Mrows, 5632, bid);
        gemm_phase(lds, g, S, EpiFfn{ACT, row0}, tid);
    } break;
    case 18: {
        GemmArgs g{ACT + (size_t)row0 * 2816, (const bf16_t*)(ws + W_FOUT), 2816, 2816, 2816}; StaticOrder S; S.init(Mrows, 1024, bid);
        gemm_phase(lds, g, S, EpiRes{H, modl + 5120, modc + 5120, row0}, tid);
    } break;
    }
}

#undef wid
#undef lane
#undef gtid
#undef gthreads
#define XB_TMO      128
#define XB_XCNT(j)  (256  + 64 * (j))
#define XB_XSUB(j)  (1280 + 64 * (j))
#define XB_XGEN(j)  (2304 + 64 * (j))
#define XB_TOP      3328
#define XB_TOPGEN   3392
#define XCD_BAR_WORDS 3456
#define XB_SPIN_CAP (1u << 18)
__device__ __forceinline__ unsigned xb_ld(unsigned* p)              { return __hip_atomic_load(p, __ATOMIC_RELAXED, __HIP_MEMORY_SCOPE_AGENT); }
__device__ __forceinline__ unsigned xb_add(unsigned* p, unsigned v) { return __hip_atomic_fetch_add(p, v, __ATOMIC_RELAXED, __HIP_MEMORY_SCOPE_AGENT); }
__device__ __forceinline__ unsigned xb_xcc_id() { return (unsigned)__builtin_amdgcn_s_getreg((3 << 11) | 20) & 0xFu; }
#define XB_SPIN(cond, bar) do { unsigned _sp = 0; while (cond) { __builtin_amdgcn_s_sleep(1); \
    if ((++_sp & 255u) == 0u) { if (xb_ld(&(bar)[XB_TMO])) break; if (_sp > XB_SPIN_CAP) { atomicAdd(&(bar)[XB_TMO], 1u); break; } } } } while (0)
struct XcdBarrier { unsigned* bar; unsigned x; volatile LAS unsigned* st; };
__device__ __forceinline__ XcdBarrier xcd_barrier_post(unsigned* bar, volatile LAS unsigned* st) {
    XcdBarrier b; b.bar = bar; b.x = xb_xcc_id(); b.st = st;
    if (threadIdx.x == 0) (void)xb_add(&bar[XB_XCNT(b.x)], 1u);
    return b;
}
__device__ __forceinline__ void xcd_barrier_complete(unsigned* bar, unsigned x, unsigned& nloc, unsigned& nx) {
    const unsigned G = gridDim.x * gridDim.y * gridDim.z;
    unsigned sum, cnt, mine, sp = 0u;
    for (;;) {
        sum = 0u; cnt = 0u; mine = 0u;
#pragma unroll
        for (unsigned j = 0; j < 16; ++j) { const unsigned c = xb_ld(&bar[XB_XCNT(j)]); sum += c; cnt += (c > 0u) ? 1u : 0u; mine = (j == x) ? c : mine; }
        if (sum == G) break;
        __builtin_amdgcn_s_sleep(1);
        if ((++sp & 255u) == 0u) { if (xb_ld(&bar[XB_TMO])) break; if (sp > XB_SPIN_CAP) { atomicAdd(&bar[XB_TMO], 1u); break; } }
    }
    nloc = mine > 0u ? mine : 1u; nx = cnt > 0u ? cnt : 1u;
}
__device__ __forceinline__ void xcd_barrier(const XcdBarrier& b) {
    asm volatile("s_waitcnt vmcnt(0) lgkmcnt(0)" ::: "memory");
    __syncthreads();
    if (threadIdx.x == 0) {
        unsigned* bar = b.bar;
        __builtin_amdgcn_s_waitcnt(0);
        unsigned nloc = b.st[0], nx = b.st[1];
        if (nloc == 0u) { xcd_barrier_complete(bar, b.x, nloc, nx); b.st[0] = nloc; b.st[1] = nx; }
        const unsigned old = xb_add(&bar[XB_XSUB(b.x)], 1u);
        const unsigned gen = old / nloc;
        if (old + 1u == (gen + 1u) * nloc) {
            __builtin_amdgcn_fence(__ATOMIC_RELEASE, "agent");
            asm volatile("s_waitcnt vmcnt(0)" ::: "memory");
            const unsigned og = xb_add(&bar[XB_TOP], 1u);
            const unsigned tg = og / nx;
            if (og + 1u == (tg + 1u) * nx) xb_add(&bar[XB_TOPGEN], 1u);
            else XB_SPIN(xb_ld(&bar[XB_TOPGEN]) == tg, bar);
            __builtin_amdgcn_fence(__ATOMIC_ACQUIRE, "agent");
            xb_add(&bar[XB_XGEN(b.x)], 1u);
            asm volatile("s_waitcnt vmcnt(0)" ::: "memory");
        } else {
            XB_SPIN(xb_ld(&bar[XB_XGEN(b.x)]) == gen, bar);
            __builtin_amdgcn_fence(__ATOMIC_ACQUIRE, "agent");
            asm volatile("s_waitcnt vmcnt(0)" ::: "memory");
        }
    }
    __syncthreads();
}
__device__ __forceinline__ void grid_bar(unsigned* ctr, unsigned target) {
    asm volatile("s_waitcnt vmcnt(0) lgkmcnt(0)" ::: "memory");
    __syncthreads();
    if (threadIdx.x == 0) {
        __builtin_amdgcn_fence(__ATOMIC_RELEASE, "agent");
        asm volatile("s_waitcnt vmcnt(0)" ::: "memory");
        __hip_atomic_fetch_add(ctr, 1u, __ATOMIC_RELAXED, __HIP_MEMORY_SCOPE_AGENT);
        while (__hip_atomic_load(ctr, __ATOMIC_RELAXED, __HIP_MEMORY_SCOPE_AGENT) < target) __builtin_amdgcn_s_sleep(2);
    }
    if (threadIdx.x < 64) {
        __builtin_amdgcn_fence(__ATOMIC_ACQUIRE, "agent");
        asm volatile("s_waitcnt vmcnt(0)" ::: "memory");
    }
    __syncthreads();
}
#if SINGLE_LAUNCH
__global__ void __launch_bounds__(NTHR, 2) fwd_megakernel(Params p, int ph_lo, int ph_hi) {
    extern __shared__ __attribute__((aligned(16))) unsigned char shm[];
    volatile LAS unsigned* xst = (volatile LAS unsigned*)((LAS unsigned char*)shm + LDS_STAGE);
    if (threadIdx.x < 2) xst[threadIdx.x] = 0u;
    if (blockIdx.x == 0) for (int i = threadIdx.x; i < XCD_BAR_WORDS; i += NTHR) __hip_atomic_store((unsigned*)(p.ws + M_BAR) + i, 0u, __ATOMIC_RELAXED, __HIP_MEMORY_SCOPE_AGENT);
    __syncthreads();
    { cg::grid_group grid = cg::this_grid(); grid.sync(); }
    const int wv = __builtin_amdgcn_readfirstlane(threadIdx.x >> 6);
    const XcdBarrier xb = xcd_barrier_post((unsigned*)(p.ws + M_BAR), xst);
#ifdef USE_CG_SYNC
#define MK_SYNC do { asm volatile("s_waitcnt vmcnt(0) lgkmcnt(0)" ::: "memory"); __syncthreads(); cg::this_grid().sync(); } while (0)
#else
#define MK_SYNC xcd_barrier(xb)
#endif
#ifdef MK_SWITCH
    for (int ph = 0; ph < NPHASE; ++ph) { run_phase<-1>(p, ph, shm, wv); if (ph + 1 < NPHASE) MK_SYNC; }
}
#else
    run_phase<100>(p, 0, shm, wv); MK_SYNC;
#define MK_LAYER(LL) do { const int base = 1 + (LL) * PH_PER_LAYER; \
        run_phase<0>(p, base + 0, shm, wv); MK_SYNC;   run_phase<1>(p, base + 1, shm, wv); MK_SYNC;   run_phase<2>(p, base + 2, shm, wv); MK_SYNC; \
        run_phase<3>(p, base + 3, shm, wv); MK_SYNC;   run_phase<4>(p, base + 4, shm, wv); MK_SYNC;   run_phase<5>(p, base + 5, shm, wv); MK_SYNC; \
        run_phase<6>(p, base + 6, shm, wv); MK_SYNC;   run_phase<7>(p, base + 7, shm, wv); MK_SYNC;   run_phase<8>(p, base + 8, shm, wv); MK_SYNC; \
        run_phase<9>(p, base + 9, shm, wv); MK_SYNC;   run_phase<10>(p, base + 10, shm, wv); MK_SYNC; run_phase<11>(p, base + 11, shm, wv); MK_SYNC; \
        run_phase<12>(p, base + 12, shm, wv); MK_SYNC; run_phase<13>(p, base + 13, shm, wv); MK_SYNC; run_phase<14>(p, base + 14, shm, wv); MK_SYNC; \
        run_phase<15>(p, base + 15, shm, wv); MK_SYNC; run_phase<16>(p, base + 16, shm, wv); MK_SYNC; run_phase<17>(p, base + 17, shm, wv); MK_SYNC; \
        run_phase<18>(p, base + 18, shm, wv); MK_SYNC; } while (0)
    MK_LAYER(0); MK_LAYER(1); MK_LAYER(2); MK_LAYER(3);
    run_phase<101>(p, NPHASE - 1, shm, wv);
}
#endif
#endif
template <int KSEL>
__global__ void __launch_bounds__(NTHR, 2) phase_kernel(Params p, int ph) {
    extern __shared__ __attribute__((aligned(16))) unsigned char shm[];
    run_phase<KSEL>(p, ph, shm, __builtin_amdgcn_readfirstlane(threadIdx.x >> 6));
}
template <int KSEL> static void launch_phase(const Params& p, int ph, int grid, hipStream_t stream) {
    static bool attr = false;
    if (!attr) { (void)hipFuncSetAttribute((const void*)phase_kernel<KSEL>, hipFuncAttributeMaxDynamicSharedMemorySize, LDS_BYTES); attr = true; }
    phase_kernel<KSEL><<<grid, NTHR, LDS_BYTES, stream>>>(p, ph);
}

extern "C" void kernel_launch(void* const* d_in, const int* in_sizes, int n_in, void* d_out, int out_size, void* d_ws, size_t ws_size, hipStream_t stream) {
    static int grid = 0;
    if (grid == 0) {
        if (n_in != 42 || ws_size < WS_END) { fprintf(stderr, "kernel_launch: unexpected n_in %d or ws %zu < %zu\n", n_in, ws_size, (size_t)WS_END); grid = -1; return; }
        int dev = 0, cus = 0;
        (void)hipGetDevice(&dev); (void)hipDeviceGetAttribute(&cus, hipDeviceAttributeMultiprocessorCount, dev);
#if SINGLE_LAUNCH
        if (hipFuncSetAttribute((const void*)fwd_megakernel, hipFuncAttributeMaxDynamicSharedMemorySize, LDS_BYTES) != hipSuccess) { fprintf(stderr, "hipFuncSetAttribute failed\n"); grid = -1; return; }
#endif
        (void)hipGetLastError();
        grid = cus;
    }
    if (grid < 0) return;
    Params p{};
    for (int i = 0; i < 42; ++i) p.in[i] = (const float*)d_in[i];
    p.out = (float*)d_out; p.ws = (unsigned char*)d_ws;
#if SINGLE_LAUNCH
    (void)hipMemsetAsync((unsigned char*)d_ws + M_BAR, 0, 16384, stream);
    int lo = 0, hi = NPHASE;
    void* args[] = {&p, &lo, &hi};
    hipError_t e = hipLaunchCooperativeKernel((const void*)fwd_megakernel, dim3(grid), dim3(NTHR), args, LDS_BYTES, stream);
    if (e != hipSuccess) fprintf(stderr, "cooperative launch failed: %s (grid %d)\n", hipGetErrorString(e), grid);
#else
    for (int ph = 0; ph < NPHASE; ++ph) {
        if (ph == 0) { launch_phase<100>(p, ph, grid, stream); continue; }
        if (ph == NPHASE - 1) { launch_phase<101>(p, ph, grid, stream); continue; }
        switch ((ph - 1) % PH_PER_LAYER) {
        case 0: launch_phase<0>(p, ph, grid, stream); break;   case 1: launch_phase<1>(p, ph, grid, stream); break;
        case 2: launch_phase<2>(p, ph, grid, stream); break;   case 3: launch_phase<3>(p, ph, grid, stream); break;
        case 4: launch_phase<4>(p, ph, grid, stream); break;   case 5: launch_phase<5>(p, ph, grid, stream); break;
        case 6: launch_phase<6>(p, ph, grid, stream); break;   case 7: launch_phase<7>(p, ph, grid, stream); break;
        case 8: launch_phase<8>(p, ph, grid, stream); break;   case 9: launch_phase<9>(p, ph, grid, stream); break;
        case 10: launch_phase<10>(p, ph, grid, stream); break; case 11: launch_phase<11>(p, ph, grid, stream); break;
        case 12: launch_phase<12>(p, ph, grid, stream); break; case 13: launch_phase<13>(p, ph, grid, stream); break;
        case 14: launch_phase<14>(p, ph, grid, stream); break; case 15: launch_phase<15>(p, ph, grid, stream); break;
        case 16: launch_phase<16>(p, ph, grid, stream); break; case 17: launch_phase<17>(p, ph, grid, stream); break;
        case 18: launch_phase<18>(p, ph, grid, stream); break;
        }
    }
#endif
}
```

```cpp
#define TID_MBCNT 1
#include <hip/hip_runtime.h>
#include <hip/hip_cooperative_groups.h>
#include <cstdio>
namespace cg = cooperative_groups;

#define LAS __attribute__((address_space(3)))
#define UNR _Pragma("unroll")
typedef unsigned short bf16_t;
typedef short bf16x8 __attribute__((ext_vector_type(8)));
typedef float f32x4 __attribute__((ext_vector_type(4)));
typedef unsigned u32x2 __attribute__((ext_vector_type(2)));
typedef unsigned u32x4 __attribute__((ext_vector_type(4)));

constexpr int TOK = 16640, NLAYER = 4;
#ifndef SINGLE_LAUNCH
#define SINGLE_LAUNCH 1
#endif
constexpr int NTHR = 512;
constexpr int LDS_STAGE = 131072;
constexpr int LDS_BYTES = LDS_STAGE + 16;

constexpr size_t SZ_TB512 = (size_t)TOK * 512 * 2;
constexpr size_t OFF_H = 0;
constexpr size_t OFF_HN = OFF_H + (size_t)TOK * 1024 * 4;
constexpr size_t OFF_W1 = OFF_HN + (size_t)TOK * 1024 * 2;
constexpr size_t W_INA = OFF_W1;
constexpr size_t W_LRU = W_INA + (size_t)3584 * 1024 * 2;
constexpr size_t W_LORA = W_LRU + (size_t)2048 * 512 * 2;
constexpr size_t W_S5Y = W_LORA + (size_t)2560 * 384 * 2;
constexpr size_t W_S5E = W_S5Y + (size_t)32 * 256 * 512 * 2;
constexpr size_t W_GLU = W_S5E + (size_t)32 * 256 * 256 * 2;
constexpr size_t OFF_YS = W_GLU + (size_t)512 * 512 * 2;
constexpr size_t OFF_ZB = OFF_YS + 3 * SZ_TB512;
constexpr size_t OFF_MISC = OFF_ZB + (size_t)TOK * 2048 * 2;
constexpr size_t M_MODV = OFF_MISC;
constexpr size_t M_PW = M_MODV + (size_t)4 * 2 * 6144 * 4;
constexpr size_t M_BB = M_PW + (size_t)4 * 2 * 32 * 64 * 17 * 2 * 4;
constexpr size_t M_CA = M_BB + (size_t)4 * 2 * 32 * 64 * 16 * 2 * 4;
constexpr size_t M_CB = M_CA + (size_t)2 * 260 * 512 * 4;
constexpr size_t M_HIN = M_CB + (size_t)2 * 260 * 512 * 4;
constexpr size_t M_KT = M_HIN + (size_t)2 * 260 * 512 * 4;
constexpr size_t M_BAR = OFF_MISC + 16777216 - 16384;
constexpr size_t OFF_X = OFF_MISC + 16777216;
constexpr size_t X_ZA = OFF_X;
constexpr size_t X_XC = X_ZA + (size_t)TOK * 1536 * 2;
constexpr size_t X_LA = X_XC + SZ_TB512;
constexpr size_t X_LU = X_LA + 2 * SZ_TB512;
constexpr size_t X_A5 = X_LU + 2 * SZ_TB512;
constexpr size_t X_LW = OFF_X;
constexpr size_t X_IC = X_LW + 2 * SZ_TB512;
constexpr size_t X_G = X_IC + 2 * SZ_TB512;
constexpr size_t X_YD1 = X_G + SZ_TB512;
constexpr size_t X_LORAA = X_YD1 + SZ_TB512;
constexpr size_t X_PQ = X_LORAA + (size_t)TOK * 384 * 2;
constexpr size_t X_SC = X_PQ + (size_t)16 * 64 * 8192 * 4;
constexpr size_t X_ZG = OFF_X;
constexpr size_t X_ACT = OFF_X;
constexpr size_t W_INZG = X_PQ;
constexpr size_t W_BR = W_INZG + (size_t)3072 * 1024 * 2;
constexpr size_t W_OUT = W_BR + (size_t)3 * 1024 * 512 * 2;
constexpr size_t W_FIN = W_OUT + (size_t)1024 * 1024 * 2;
constexpr size_t W_FOUT = W_FIN + (size_t)5632 * 1024 * 2;
constexpr size_t X_M = W_FOUT + (size_t)1024 * 2816 * 2;
constexpr size_t WS_END = X_M + (size_t)TOK * 1024 * 2 + 1048576;

struct Params { const float* in[42]; float* out; unsigned char* ws; };

enum { I_X = 0, I_C, I_CTX, I_CCTX, I_WMOD, I_BMOD, I_NORM1, I_NORM2, I_NORMF, I_WIN, I_CONVW, I_CONVB, I_WA, I_BA, I_WX, I_BX, I_LAM,
       I_MU, I_W0, I_W2, I_A0, I_A2, I_G2, I_KK, I_KA, I_RK, I_LNW, I_LNB, I_S5LRE, I_S5LIM, I_S5STEP, I_S5BRE, I_S5BIM, I_S5CRE, I_S5CIM,
       I_S5D, I_WGLU, I_BGLU, I_WBR, I_WOUT, I_WFIN, I_WFOUT };

__device__ __forceinline__ bf16_t f2bf(float f) { unsigned u = __float_as_uint(f); u += 0x7FFFu + ((u >> 16) & 1u); return (bf16_t)(u >> 16); }
__device__ __forceinline__ float bf2f(bf16_t b) { return __uint_as_float(((unsigned)b) << 16); }
typedef __bf16 bf16x2_t __attribute__((ext_vector_type(2)));
typedef float f32x2_t __attribute__((ext_vector_type(2)));
__device__ __forceinline__ unsigned pack2(float a, float b) { f32x2_t v = {a, b}; bf16x2_t r = __builtin_convertvector(v, bf16x2_t); return __builtin_bit_cast(unsigned, r); }
__device__ __forceinline__ void st4bf(bf16_t* p, float a, float b, float c, float d) { u32x2 w; w.x = pack2(a, b); w.y = pack2(c, d); *(u32x2*)p = w; }
__device__ __forceinline__ void ld4bf(const bf16_t* p, float (&o)[4]) { u32x2 w = *(const u32x2*)p; o[0] = __uint_as_float(w.x << 16); o[1] = __uint_as_float(w.x & 0xFFFF0000u); o[2] = __uint_as_float(w.y << 16); o[3] = __uint_as_float(w.y & 0xFFFF0000u); }
__device__ __forceinline__ void ld8bf(const bf16_t* p, float (&o)[8]) { const u32x4 w = *(const u32x4*)p;
    o[0] = __uint_as_float(w.x << 16); o[1] = __uint_as_float(w.x & 0xFFFF0000u); o[2] = __uint_as_float(w.y << 16); o[3] = __uint_as_float(w.y & 0xFFFF0000u);
    o[4] = __uint_as_float(w.z << 16); o[5] = __uint_as_float(w.z & 0xFFFF0000u); o[6] = __uint_as_float(w.w << 16); o[7] = __uint_as_float(w.w & 0xFFFF0000u); }
__device__ __forceinline__ void st8bf(bf16_t* p, const float (&v)[8]) { u32x4 w; w.x = pack2(v[0], v[1]); w.y = pack2(v[2], v[3]); w.z = pack2(v[4], v[5]); w.w = pack2(v[6], v[7]); *(u32x4*)p = w; }
#ifdef OLD_SIGM
__device__ __forceinline__ float sigm(float x) { return 1.0f / (1.0f + __expf(-x)); }
#else
__device__ __forceinline__ float sigm(float x) { return __builtin_amdgcn_rcpf(1.0f + __expf(-x)); }
#endif
__device__ __forceinline__ float softplusf(float x) { return x > 15.f ? x : __logf(1.0f + __expf(x)); }
__device__ __forceinline__ float gelu_t(float x) { float t = tanhf(0.7978845608028654f * (x + 0.044715f * x * x * x)); return 0.5f * x * (1.0f + t); }
__device__ __forceinline__ float silu(float x) { return x * sigm(x); }
__device__ __forceinline__ int tok_of(int dir, int p) { return dir == 0 ? p : (p < 256 ? 255 - p : 16895 - p); }
__device__ __forceinline__ int s5_tok(int p) { if (p < 256) return p; int q = p - 256; return 256 + (q & 255) * 64 + (q >> 8); }
__device__ __forceinline__ float shx(float v, int o, int lane) { return __int_as_float(__builtin_amdgcn_ds_bpermute((lane ^ o) << 2, __float_as_int(v))); }
__device__ __forceinline__ float wave_sum(float v, int lane) {
#pragma unroll
    for (int o = 32; o >= 1; o >>= 1) v += shx(v, o, lane);
    return v;
}
__device__ __forceinline__ float zshift(const bf16_t* ZB, int tk, int col, float mu) {
    const int lo = tk < 256 ? 0 : 256, hi = tk < 256 ? 256 : TOK;
    const float z = bf2f(ZB[(size_t)tk * 2048 + col]);
    const float zp = (tk - 1 >= lo) ? bf2f(ZB[(size_t)(tk - 1) * 2048 + col]) : 0.f;
    const float zn = (tk + 1 < hi) ? bf2f(ZB[(size_t)(tk + 1) * 2048 + col]) : 0.f;
    return z + mu * (0.5f * (zp + zn) - z);
}

constexpr int BM = 256, BK = 64, HALF = 128, HTB = HALF * BK * 2, NXCD = 8, WGM = 8;
__device__ __forceinline__ int lds_byte(int r, int c) { const int st = (r >> 4) * 2 + (c >> 5), rr = r & 15, cc = c & 31, ob = rr * 64 + cc * 2; return st * 1024 + (ob ^ (((ob >> 9) & 1) << 5)); }
__device__ __forceinline__ void stage_rc(int b, int& R, int& C) { const int st = b / 1024, sb = b % 1024, swz = sb ^ (((sb >> 9) & 1) << 5); R = (st >> 1) * 16 + swz / 64; C = (st & 1) * 32 + (swz % 64) / 2; }

struct Unit { int pm, pn, g; };
struct GemmArgs { const bf16_t* A; const bf16_t* Bt; int lda, ldb, K; };

struct StaticOrder {
    int nM, nN, nwg, G, c;
    __device__ void init(int M, int N, int bid_l) { nM = M / BM; nN = N / BM; nwg = nM * nN; G = gridDim.x; c = bid_l; }
    __device__ bool next(int i, Unit& u) const {
        const long L = (long)i * G + c; if (L >= nwg) return false;
        int wgid = (int)L; { const int q = nwg / NXCD, r = nwg % NXCD, xcd = wgid % NXCD, off = wgid / NXCD; wgid = (xcd < r ? xcd * (q + 1) : r * (q + 1) + (xcd - r) * q) + off; }
        const int nig = WGM * nN, gid = wgid / nig, fm = gid * WGM, gsz = (nM - fm) < WGM ? (nM - fm) : WGM;
        u.pm = fm + ((wgid % nig) % gsz); u.pn = (wgid % nig) / gsz; u.g = 0; return true;
    }
    __device__ const char* aptr(const GemmArgs& g, const Unit& u) const { return (const char*)g.A + (size_t)u.pm * 256 * g.lda * 2; }
    __device__ const char* bptr(const GemmArgs& g, const Unit& u) const { return (const char*)g.Bt + (size_t)u.pn * 256 * g.ldb * 2; }
};
struct S5Order {
    int G, c;
    __device__ void init(int shift, int bid_l) { G = gridDim.x; c = (bid_l + shift) % gridDim.x; }
    __device__ bool next(int i, Unit& u) const { const int L = i * G + c; if (L >= 160) return false; u.g = L / 5; u.pm = L % 5; u.pn = 0; return true; }
    __device__ const char* aptr(const GemmArgs& g, const Unit& u) const { return (const char*)g.A + (size_t)(u.g * 1040 + u.pm * 256) * g.lda * 2; }
    __device__ const char* bptr(const GemmArgs& g, const Unit& u) const { return (const char*)g.Bt + (size_t)u.g * 256 * g.ldb * 2; }
};
struct TripleOrder {
    int nM, G, c;
    __device__ void init(int M, int bid_l) { nM = M / BM; G = gridDim.x; c = bid_l; }
    __device__ bool next(int i, Unit& u) const { const int L = (i / 3) * G + c; if (L >= nM * 4) return false; u.pm = L >> 2; u.pn = L & 3; u.g = i % 3; return true; }
    __device__ const char* aptr(const GemmArgs& g, const Unit& u) const { return (const char*)g.A + (size_t)u.g * SZ_TB512 + (size_t)u.pm * 256 * 512 * 2; }
    __device__ const char* bptr(const GemmArgs& g, const Unit& u) const { return (const char*)g.Bt + (size_t)(u.g * 1024 + u.pn * 256) * 512 * 2; }
};

template <class Epi, class Ord>
__device__ __forceinline__ void gemm_phase(LAS unsigned char* lds, const GemmArgs g, const Ord& S, const Epi& E, int tid_l) {
    const int tid = tid_l, wid = __builtin_amdgcn_readfirstlane(tid >> 6), lane = tid & 63, wr = wid >> 2, wc = wid & 3, fr = lane & 15, fq = lane >> 4;
    const int K = g.K, nt = K / BK;
    unsigned voffA, voffB;
    { int R, C; stage_rc(tid * 16, R, C); voffA = (unsigned)(R * g.lda + C) * 2u; voffB = (unsigned)(R * g.ldb + C) * 2u; }
    const size_t p64A = (size_t)64 * g.lda * 2, p64B = (size_t)64 * g.ldb * 2;
    const size_t kstep = (size_t)(BK * 2);
    const size_t hstepA = (size_t)HALF * g.lda * 2, hstepB = (size_t)HALF * g.ldb * 2;
    const unsigned ldsw = (unsigned)wid * 1024u;
    const int aoff = lds_byte(wr * 64 + fr, fq * 8), boff = lds_byte(wc * 32 + fr, fq * 8);
#define PG8_SA(b, h) (((b) * 2 + (h)) * HTB)
#define PG8_SB(b, h) ((4 + (b) * 2 + (h)) * HTB)
#define PG8_STAGE(bufoff, gbase, voff) do { _Pragma("unroll") for (int _i = 0; _i < 2; ++_i) \
        __builtin_amdgcn_global_load_lds((const unsigned*)((const char*)(gbase) + _i * p64_##voff + v_##voff), (LAS unsigned*)(lds + (bufoff) + ldsw + _i * 8192), 16, 0, 0); } while (0)
#define PG8_LDA(dst, b, h) do { _Pragma("unroll") for (int m = 0; m < 4; ++m) _Pragma("unroll") for (int k = 0; k < 2; ++k) dst[m][k] = *(const LAS bf16x8*)(lds + PG8_SA(b, h) + aoff + m * 2048 + k * 1024); } while (0)
#define PG8_LDB(dst, b, h) do { _Pragma("unroll") for (int n = 0; n < 2; ++n) _Pragma("unroll") for (int k = 0; k < 2; ++k) dst[n][k] = *(const LAS bf16x8*)(lds + PG8_SB(b, h) + boff + n * 2048 + k * 1024); } while (0)
#define PG8_MMA(ai, bj, At, Bt) do { __builtin_amdgcn_s_setprio(1); _Pragma("unroll") for (int m = 0; m < 4; ++m) _Pragma("unroll") for (int n = 0; n < 2; ++n) _Pragma("unroll") for (int k = 0; k < 2; ++k) \
        acc[ai][bj][m][n] = __builtin_amdgcn_mfma_f32_16x16x32_bf16(Bt[n][k], At[m][k], acc[ai][bj][m][n], 0, 0, 0); __builtin_amdgcn_s_setprio(0); } while (0)
#define p64_offA p64A
#define p64_offB p64B
#define v_offA voffA
#define v_offB voffB
#define PG8_WAIT_V(n) asm volatile("s_waitcnt vmcnt(" #n ")" ::: "memory")
#define PG8_WAIT_L(n) asm volatile("s_waitcnt lgkmcnt(" #n ")" ::: "memory")
#define PG8_BAR __builtin_amdgcn_s_barrier()
#define PG8_SCHED __builtin_amdgcn_sched_barrier(0)
    Unit cur, nxt; int ui = 0;
    if (!S.next(0, cur)) return;
    f32x4 acc[2][2][4][2];
#pragma unroll
    for (int a = 0; a < 2; ++a)
#pragma unroll
        for (int b = 0; b < 2; ++b)
#pragma unroll
            for (int m = 0; m < 4; ++m)
#pragma unroll
                for (int n = 0; n < 2; ++n) acc[a][b][m][n] = (f32x4){0.f, 0.f, 0.f, 0.f};
    bf16x8 At[4][2], B0[2][2], B1[2][2];
    const char* cA = S.aptr(g, cur); const char* cB = S.bptr(g, cur);
    PG8_STAGE(PG8_SB(0, 0), cB, offB); PG8_STAGE(PG8_SA(0, 0), cA, offA); PG8_STAGE(PG8_SB(0, 1), cB + hstepB, offB); PG8_STAGE(PG8_SA(0, 1), cA + hstepA, offA);
    if (wr == 1) PG8_BAR;
    PG8_WAIT_V(4); PG8_BAR;
    PG8_STAGE(PG8_SB(1, 0), cB + kstep, offB); PG8_STAGE(PG8_SA(1, 0), cA + kstep, offA); PG8_STAGE(PG8_SB(1, 1), cB + hstepB + kstep, offB);
    PG8_WAIT_V(6); PG8_BAR;
    for (;;) {
        const bool has_next = S.next(ui + 1, nxt);
        const char* nA = has_next ? S.aptr(g, nxt) : cA; const char* nB = has_next ? S.bptr(g, nxt) : cB;
        for (int t = 0; t < nt; t += 2) {
            const bool last = (t == nt - 2);
            const char* a1 = cA + (size_t)(t + 1) * kstep;
            const char* a2 = last ? nA : cA + (size_t)(t + 2) * kstep; const char* b2 = last ? nB : cB + (size_t)(t + 2) * kstep;
            const char* a3 = a2 + kstep; const char* b3 = b2 + kstep;
            PG8_LDB(B0, 0, 0); PG8_SCHED; PG8_LDA(At, 0, 0); PG8_STAGE(PG8_SA(1, 1), a1 + hstepA, offA);
            PG8_WAIT_L(8); PG8_BAR; PG8_WAIT_L(0); PG8_MMA(0, 0, At, B0); PG8_BAR; PG8_SCHED;
            PG8_LDB(B1, 0, 1); PG8_STAGE(PG8_SB(0, 0), b2, offB);
            PG8_BAR; PG8_WAIT_L(0); PG8_MMA(0, 1, At, B1); PG8_BAR;
            PG8_LDA(At, 0, 1); PG8_STAGE(PG8_SA(0, 0), a2, offA);
            PG8_BAR; PG8_WAIT_L(0); PG8_MMA(1, 0, At, B0); PG8_BAR; PG8_SCHED;
            PG8_STAGE(PG8_SB(0, 1), b2 + hstepB, offB);
            PG8_WAIT_V(6); PG8_BAR; PG8_MMA(1, 1, At, B1); PG8_BAR;
            PG8_LDB(B0, 1, 0); PG8_SCHED; PG8_LDA(At, 1, 0); PG8_STAGE(PG8_SA(0, 1), a2 + hstepA, offA);
            PG8_WAIT_L(8); PG8_BAR; PG8_WAIT_L(0); PG8_MMA(0, 0, At, B0); PG8_BAR; PG8_SCHED;
            PG8_LDB(B1, 1, 1); PG8_STAGE(PG8_SB(1, 0), b3, offB);
            PG8_BAR; PG8_WAIT_L(0); PG8_MMA(0, 1, At, B1); PG8_BAR;
            PG8_LDA(At, 1, 1); PG8_STAGE(PG8_SA(1, 0), a3, offA);
            PG8_BAR; PG8_WAIT_L(0); PG8_MMA(1, 0, At, B0); PG8_BAR; PG8_SCHED;
            PG8_STAGE(PG8_SB(1, 1), b3 + hstepB, offB);
            PG8_WAIT_V(6); PG8_BAR; PG8_MMA(1, 1, At, B1); PG8_BAR;
        }
        E(acc, cur, wr, wc, fr, fq);
        if (!has_next) break;
#pragma unroll
        for (int a = 0; a < 2; ++a)
#pragma unroll
            for (int b = 0; b < 2; ++b)
#pragma unroll
                for (int m = 0; m < 4; ++m)
#pragma unroll
                    for (int n = 0; n < 2; ++n) acc[a][b][m][n] = (f32x4){0.f, 0.f, 0.f, 0.f};
        cur = nxt; cA = nA; cB = nB; ++ui;
    }
    PG8_WAIT_V(0);
    if (wr == 0) PG8_BAR;
    PG8_BAR;
#undef p64_offA
#undef p64_offB
#undef v_offA
#undef v_offB
#undef PG8_SA
#undef PG8_SB
#undef PG8_STAGE
#undef PG8_LDA
#undef PG8_LDB
#undef PG8_MMA
#undef PG8_WAIT_V
#undef PG8_WAIT_L
#undef PG8_BAR
#undef PG8_SCHED
}

typedef f32x4 AccT[2][2][4][2];
#define EPI_ROWS _Pragma("unroll") for (int ai = 0; ai < 2; ++ai) _Pragma("unroll") for (int m = 0; m < 4; ++m)
#define EPI_BN _Pragma("unroll") for (int bj = 0; bj < 2; ++bj) _Pragma("unroll") for (int n = 0; n < 2; ++n)
#define EPI_B _Pragma("unroll") for (int bj = 0; bj < 2; ++bj)

#define EPI_ROW (__builtin_amdgcn_sched_barrier(0), u.pm * 256 + ai * 128 + wr * 64 + m * 16 + fr)
#define EPI_COL(bj, n) (u.pn * 256 + (bj) * 128 + wc * 32 + (n) * 16 + 4 * fq)

struct EpiZ {
    bf16_t* ZA; bf16_t* ZB;
    __device__ __forceinline__ void operator()(const AccT& acc, const Unit& u, int wr, int wc, int fr, int fq) const {
        EPI_ROWS { const int row = EPI_ROW;
            EPI_BN { const int col = EPI_COL(bj, n); const f32x4 v = acc[ai][bj][m][n];
                bf16_t* dst = col < 1536 ? ZA + (size_t)row * 1536 + col : ZB + (size_t)row * 2048 + (col - 1536);
                st4bf(dst, v[0], v[1], v[2], v[3]); } }
    }
};
struct EpiLruGate {
    const bf16_t* XC; bf16_t* LA; bf16_t* LU; const float* ba; const float* bx; const float* lam;
    __device__ __forceinline__ void operator()(const AccT& acc, const Unit& u, int wr, int wc, int fr, int fq) const {
        EPI_B { __builtin_amdgcn_sched_barrier(0);
            const int g32 = (u.pn * 256 + bj * 128 + wc * 32) >> 5, dir = g32 >> 5, ch = (g32 & 31) * 16 + 4 * fq;
            float pba[4], pbx[4], psp[4];
            UNR for (int j = 0; j < 4; ++j) { const int c = dir * 512 + ch + j; pba[j] = ba[c]; pbx[j] = bx[c]; psp[j] = -8.0f * softplusf(-lam[c]); }
            EPI_ROWS { const int row = EPI_ROW;
                const f32x4 va = acc[ai][bj][m][0], vx = acc[ai][bj][m][1];
                float xc[4]; ld4bf(XC + (size_t)row * 512 + ch, xc);
                float la[4], uu[4];
                UNR for (int j = 0; j < 4; ++j) {
                    const float gr = sigm(va[j] + pba[j]), gi = sigm(vx[j] + pbx[j]);
                    la[j] = gr * psp[j];
                    uu[j] = __fsqrt_rn(fmaxf(1.0f - __expf(2.0f * la[j]), 0.f)) * gi * xc[j]; }
                const size_t o = ((size_t)dir * TOK + row) * 512 + ch;
                st4bf(LA + o, la[0], la[1], la[2], la[3]); st4bf(LU + o, uu[0], uu[1], uu[2], uu[3]); } }
    }
};
struct EpiS5E {
    float* E;
    __device__ __forceinline__ void operator()(const AccT& acc, const Unit& u, int wr, int wc, int fr, int fq) const {
        EPI_ROWS { const int row = EPI_ROW; if (row < 1040) {
            EPI_BN { const int col = EPI_COL(bj, n);
                *(f32x4*)(E + ((size_t)u.g * 1040 + row) * 256 + col) = acc[ai][bj][m][n]; } } }
    }
};
struct EpiS5Y {
    const bf16_t* ZA; bf16_t* YG; const float* dsk;
    __device__ __forceinline__ void operator()(const AccT& acc, const Unit& u, int wr, int wc, int fr, int fq) const {
        EPI_ROWS { const int row = EPI_ROW; if (row < 1040) {
            EPI_BN { const int col = EPI_COL(bj, n); const f32x4 v = acc[ai][bj][m][n];
                const int t = col >> 4, cp = col & 15, tk = s5_tok(row * 16 + t), ch = u.g * 16 + cp;
                float uv[4]; ld4bf(ZA + (size_t)tk * 1536 + 1024 + ch, uv);
                float y[4]; UNR for (int j = 0; j < 4; ++j) y[j] = gelu_t(v[j] + dsk[ch + j] * uv[j]);
                st4bf(YG + (size_t)tk * 512 + ch, y[0], y[1], y[2], y[3]); } } }
    }
};
struct EpiGlu {
    const bf16_t* YG; bf16_t* YC; const float* bg;
    __device__ __forceinline__ void operator()(const AccT& acc, const Unit& u, int wr, int wc, int fr, int fq) const {
        EPI_ROWS { const int row = EPI_ROW;
            EPI_BN { const int col = EPI_COL(bj, n); const f32x4 v = acc[ai][bj][m][n];
                float y[4]; ld4bf(YG + (size_t)row * 512 + col, y);
                UNR for (int j = 0; j < 4; ++j) y[j] *= sigm(v[j] + bg[col + j]);
                st4bf(YC + (size_t)row * 512 + col, y[0], y[1], y[2], y[3]); } }
    }
};
struct EpiLora {
    bf16_t* LW; bf16_t* IC; bf16_t* G; const float* w0; const float* a0;
    __device__ __forceinline__ void operator()(const AccT& acc, const Unit& u, int wr, int wc, int fr, int fq) const {
        const int blk = u.pn >> 1;
        if (blk < 2) {
            EPI_BN { __builtin_amdgcn_sched_barrier(0); const int col = EPI_COL(bj, n); float b[4];
                UNR for (int j = 0; j < 4; ++j) b[j] = w0[col + j];
                EPI_ROWS { const int row = EPI_ROW; const f32x4 v = acc[ai][bj][m][n]; float o[4];
                    UNR for (int j = 0; j < 4; ++j) { const float wl = -softplusf(-(b[j] + v[j])) - 0.5f; o[j] = -__expf(wl); }
                    st4bf(LW + ((size_t)blk * TOK + row) * 512 + (col & 511), o[0], o[1], o[2], o[3]); } }
        } else if (blk < 4) {
            EPI_BN { __builtin_amdgcn_sched_barrier(0); const int col = EPI_COL(bj, n) - 1024; float b[4];
                UNR for (int j = 0; j < 4; ++j) b[j] = a0[col + j];
                EPI_ROWS { const int row = EPI_ROW; const f32x4 v = acc[ai][bj][m][n]; float o[4];
                    UNR for (int j = 0; j < 4; ++j) o[j] = sigm(b[j] + v[j]);
                    st4bf(IC + ((size_t)(blk - 2) * TOK + row) * 512 + (col & 511), o[0], o[1], o[2], o[3]); } }
        } else {
            EPI_ROWS { const int row = EPI_ROW;
                EPI_BN { const int col = EPI_COL(bj, n) - 2048; const f32x4 v = acc[ai][bj][m][n];
                    st4bf(G + (size_t)row * 512 + col, v[0], v[1], v[2], v[3]); } }
        }
    }
};
struct EpiZg {
    bf16_t* ZG; int row0;
    __device__ __forceinline__ void operator()(const AccT& acc, const Unit& u, int wr, int wc, int fr, int fq) const {
        EPI_ROWS { const int row = row0 + EPI_ROW;
            EPI_BN { const int col = EPI_COL(bj, n); const f32x4 v = acc[ai][bj][m][n];
                st4bf(ZG + (size_t)row * 3072 + col, sigm(v[0]), sigm(v[1]), sigm(v[2]), sigm(v[3])); } }
    }
};
struct EpiMerge1 {
    const bf16_t* ZG; bf16_t* M; int row0;
    __device__ __forceinline__ void operator()(const AccT& acc, const Unit& u, int wr, int wc, int fr, int fq) const {
        EPI_ROWS { const int row = row0 + EPI_ROW;
            EPI_BN { const int col = EPI_COL(bj, n); const f32x4 v = acc[ai][bj][m][n];
                float gt[4]; ld4bf(ZG + (size_t)row * 3072 + u.g * 1024 + col, gt);
                float mv[4] = {0.f, 0.f, 0.f, 0.f}; if (u.g) ld4bf(M + (size_t)row * 1024 + col, mv);
                st4bf(M + (size_t)row * 1024 + col, mv[0] + gt[0] * v[0], mv[1] + gt[1] * v[1], mv[2] + gt[2] * v[2], mv[3] + gt[3] * v[3]); } }
    }
};
struct EpiRes {
    float* H; const float* gl; const float* gc; int row0;
    __device__ __forceinline__ void operator()(const AccT& acc, const Unit& u, int wr, int wc, int fr, int fq) const {
        EPI_ROWS { const int row = row0 + EPI_ROW; const float* gv = row < 256 ? gc : gl;
            EPI_BN { const int col = EPI_COL(bj, n); const f32x4 v = acc[ai][bj][m][n];
                float* hp = H + (size_t)row * 1024 + col; f32x4 hv = *(f32x4*)hp; const f32x4 gg = *(const f32x4*)(gv + col);
                hv += gg * v; *(f32x4*)hp = hv; } }
    }
};
struct EpiFfn {
    bf16_t* ACT; int row0;
    __device__ __forceinline__ void operator()(const AccT& acc, const Unit& u, int wr, int wc, int fr, int fq) const {
        EPI_ROWS { const int row = row0 + EPI_ROW;
            EPI_B { const int g32 = (u.pn * 256 + bj * 128 + wc * 32) >> 5, oc = g32 * 16 + 4 * fq;
                const f32x4 g = acc[ai][bj][m][0], up = acc[ai][bj][m][1];
                st4bf(ACT + (size_t)row * 2816 + oc, silu(g[0]) * up[0], silu(g[1]) * up[1], silu(g[2]) * up[2], silu(g[3]) * up[3]); } }
    }
};

template <class Map>
__device__ __forceinline__ void conv_T(const float* src, int src_ld, bf16_t* dst, int Nd, int K, Map map, float* sm, int shift, int tid_l, int bid_l) {
    const int tk = K / 64, ntile = (Nd / 64) * tk;
    for (int t = (bid_l + shift) % gridDim.x; t < ntile; t += gridDim.x) {
        const int n0 = (t / tk) * 64, k0 = (t % tk) * 64;
        { const int n = tid_l & 63, kq = tid_l >> 6; const int col = map(n0 + n);
            for (int e = 0; e < 8; ++e) { const int k = e * 8 + kq; sm[k * 65 + n] = col >= 0 ? src[(size_t)(k0 + k) * src_ld + col] : 0.f; } }
        __syncthreads();
        { const int k = tid_l & 63, nq = tid_l >> 6;
            for (int e = 0; e < 8; ++e) { const int n2 = e * 8 + nq; dst[(size_t)(n0 + n2) * K + k0 + k] = f2bf(sm[k * 65 + n2]); } }
        __syncthreads();
    }
}
struct MapIna { __device__ int operator()(int n) const { return n < 1024 ? n : (n < 1536 ? 2944 + (n - 1024) : (n < 3456 ? 1024 + (n - 1536) : -1)); } };
struct MapOff { int off; __device__ int operator()(int n) const { return off + n; } };
struct MapFfn { __device__ int operator()(int n) const { const int g32 = n >> 5, w = n & 31; return w < 16 ? g32 * 16 + w : 2816 + g32 * 16 + (w - 16); } };

__device__ __forceinline__ void norm_rows(const float* H, const float* nw, const float* modl, const float* modc, int shoff, int scoff, bf16_t* HN, int row_begin, int tid_l, int bid_l) {
    const int wid = tid_l >> 6, lane = tid_l & 63;
    for (int row = row_begin + bid_l * 8 + wid; row < TOK; row += gridDim.x * 8) {
        const float* hp = H + (size_t)row * 1024; const float* mv = row < 256 ? modc : modl;
        f32x4 x[4]; float ss = 0.f;
        UNR for (int e = 0; e < 4; ++e) { x[e] = *(const f32x4*)(hp + e * 256 + lane * 4); ss += x[e][0] * x[e][0] + x[e][1] * x[e][1] + x[e][2] * x[e][2] + x[e][3] * x[e][3]; }
        ss = wave_sum(ss, lane); const float sc = rsqrtf(ss * (1.0f / 1024.0f) + 1e-6f);
        UNR for (int e = 0; e < 4; ++e) { const int c = e * 256 + lane * 4; float y[4];
            UNR for (int j = 0; j < 4; ++j) y[j] = x[e][j] * sc * nw[c + j] * (1.0f + mv[scoff + c + j]) + mv[shoff + c + j];
            st4bf(HN + (size_t)row * 1024 + c, y[0], y[1], y[2], y[3]); }
    }
}

typedef float f32x2 __attribute__((ext_vector_type(2)));
__device__ __forceinline__ float quad_sum(float v) {
    v += __int_as_float(__builtin_amdgcn_mov_dpp(__float_as_int(v), 0xB1, 0xF, 0xF, true));
    v += __int_as_float(__builtin_amdgcn_mov_dpp(__float_as_int(v), 0x4E, 0xF, 0xF, true));
    return v;
}
constexpr int WCH = 260, WNC = 64, WSC = 13, WVEC = 6 * 64;
template <int R, bool WITH_Y>
__device__ __forceinline__ void wkv_steps(f32x2 (&s)[R][8], const float* stg, float* sy, int nst, int row0, bool hasv, int sub) {
    for (int jj = 0; jj < nst; ++jj) {
        const float* base = stg + jj * WVEC + sub * 16;
        f32x2 kk[8];
#pragma unroll
        for (int i = 0; i < 4; ++i) { const f32x4 t = *(const f32x4*)(base + 64 + i * 4); kk[2 * i] = (f32x2){t[0], t[1]}; kk[2 * i + 1] = (f32x2){t[2], t[3]}; }
        float nsa[R], vv[R];
#pragma unroll
        for (int r = 0; r < R; ++r) { f32x2 a = s[r][0] * kk[0];
#pragma unroll
            for (int i = 1; i < 8; ++i) a = __builtin_elementwise_fma(s[r][i], kk[i], a);
            nsa[r] = -quad_sum(a[0] + a[1]); vv[r] = hasv ? stg[jj * WVEC + 320 + row0 + r] : 0.f; }
        f32x2 w[8], bb[8], kd[8];
#pragma unroll
        for (int i = 0; i < 4; ++i) { const f32x4 t0 = *(const f32x4*)(base + i * 4), t1 = *(const f32x4*)(base + 128 + i * 4), t2 = *(const f32x4*)(base + 192 + i * 4);
            w[2 * i] = (f32x2){t0[0], t0[1]}; w[2 * i + 1] = (f32x2){t0[2], t0[3]}; bb[2 * i] = (f32x2){t1[0], t1[1]}; bb[2 * i + 1] = (f32x2){t1[2], t1[3]};
            kd[2 * i] = (f32x2){t2[0], t2[1]}; kd[2 * i + 1] = (f32x2){t2[2], t2[3]}; }
#pragma unroll
        for (int r = 0; r < R; ++r) { const f32x2 v2 = (f32x2){vv[r], vv[r]}, n2 = (f32x2){nsa[r], nsa[r]};
#pragma unroll
            for (int i = 0; i < 8; ++i) { const f32x2 t = __builtin_elementwise_fma(n2, bb[i], v2 * kd[i]); s[r][i] = __builtin_elementwise_fma(s[r][i], w[i], t); } }
        if (WITH_Y) {
            f32x2 rr[8];
#pragma unroll
            for (int i = 0; i < 4; ++i) { const f32x4 t = *(const f32x4*)(base + 256 + i * 4); rr[2 * i] = (f32x2){t[0], t[1]}; rr[2 * i + 1] = (f32x2){t[2], t[3]}; }
#pragma unroll
            for (int r = 0; r < R; ++r) { f32x2 a = s[r][0] * rr[0];
#pragma unroll
                for (int i = 1; i < 8; ++i) a = __builtin_elementwise_fma(s[r][i], rr[i], a);
                const float y = quad_sum(a[0] + a[1]); if (sub == 0) sy[jj * 64 + row0 + r] = y; }
        }
    }
}
__device__ __forceinline__ void wkv_stage_all(float* smem, const bf16_t* ZBp, const bf16_t* LWp, const bf16_t* ICp, float mur, float muk, float muv, float kkwv, float kawv,
                                              int dir, int head, int c0, int sc, int wd, int ln) {
    const int col = head * 64 + ln;
    float zr[7][3], zk[7][3], zv[7][3], lwv[7], icv[7];
#pragma unroll
    for (int it = 0; it < 7; ++it) { const int pr = wd + it * 8;
        if (pr < 4 * WSC) { const int qq = pr / WSC, jj = pr % WSC, tk = tok_of(dir, (c0 + qq) * WCH + sc * WSC + jj);
            const int lo = tk < 256 ? 0 : 256, hi = tk < 256 ? 256 : TOK; const bool hp = tk - 1 >= lo, hn = tk + 1 < hi;
            const bf16_t* z0 = ZBp + (size_t)tk * 2048 + col;
            zr[it][1] = bf2f(z0[0]); zk[it][1] = bf2f(z0[512]); zv[it][1] = bf2f(z0[1024]);
            zr[it][0] = hp ? bf2f(z0[-2048]) : 0.f; zk[it][0] = hp ? bf2f(z0[-2048 + 512]) : 0.f; zv[it][0] = hp ? bf2f(z0[-2048 + 1024]) : 0.f;
            zr[it][2] = hn ? bf2f(z0[2048]) : 0.f; zk[it][2] = hn ? bf2f(z0[2048 + 512]) : 0.f; zv[it][2] = hn ? bf2f(z0[2048 + 1024]) : 0.f;
            const size_t o = ((size_t)dir * TOK + tk) * 512 + col; lwv[it] = bf2f(LWp[o]); icv[it] = bf2f(ICp[o]); } }
#pragma unroll
    for (int it = 0; it < 7; ++it) { const int pr = wd + it * 8;
        if (pr < 4 * WSC) { float* dst = smem + pr * WVEC;
            const float r = zr[it][1] + mur * (0.5f * (zr[it][0] + zr[it][2]) - zr[it][1]);
            const float k = zk[it][1] + muk * (0.5f * (zk[it][0] + zk[it][2]) - zk[it][1]);
            const float v = zv[it][1] + muv * (0.5f * (zv[it][0] + zv[it][2]) - zv[it][1]);
            const float kx = k * kkwv; const float ssq = wave_sum(kx * kx, ln); const float kk = kx * rsqrtf(ssq + 1e-12f);
            const float w = __expf(lwv[it]), ic = icv[it];
            dst[ln] = w; dst[64 + ln] = kk; dst[128 + ln] = kk * ic; dst[192 + ln] = k * (1.0f + (ic - 1.0f) * kawv); dst[256 + ln] = r; dst[320 + ln] = v; } }
}

__device__ __forceinline__ int launder_s(int i) { asm volatile("" : "+s"(i)); return i; }
#define IN(i) (p.in[launder_s(i)])
constexpr int PH_PER_LAYER = 19;
constexpr int NPHASE = 1 + NLAYER * PH_PER_LAYER + 1;

#define ZA ((bf16_t*)(ws + X_ZA))
#define ZB ((bf16_t*)(ws + OFF_ZB))
#define XC ((bf16_t*)(ws + X_XC))
#define LA ((bf16_t*)(ws + X_LA))
#define LU ((bf16_t*)(ws + X_LU))
#define A5 ((bf16_t*)(ws + X_A5))
#define YS ((bf16_t*)(ws + OFF_YS))
#define YA YS
#define YB (YS + (size_t)TOK * 512)
#define YC (YS + (size_t)2 * TOK * 512)
#define S5E ((float*)(ws + OFF_HN))
#define CA ((float*)(ws + M_CA))
#define CB ((float*)(ws + M_CB))
#define HIN ((float*)(ws + M_HIN))
#define LW ((bf16_t*)(ws + X_LW))
#define IC ((bf16_t*)(ws + X_IC))
#define GG ((bf16_t*)(ws + X_G))
#define YD1 ((bf16_t*)(ws + X_YD1))
#define LORAA ((bf16_t*)(ws + X_LORAA))
#define PQ ((float*)(ws + X_PQ))
#define SCS ((float*)(ws + X_SC))
#define ZG ((bf16_t*)(ws + X_ZG))
#define ACT ((bf16_t*)(ws + X_ACT))
#define MM ((bf16_t*)(ws + X_M))
template <int KSEL>
__device__ __forceinline__ void run_phase(const Params& p, int ph, unsigned char* shm, int wv) {
    unsigned char* ws = p.ws;
    float* sm = (float*)shm;
    LAS unsigned char* lds = (LAS unsigned char*)shm;
#ifdef TID_MBCNT
    int tid; asm volatile("v_mbcnt_lo_u32_b32 %0, -1, 0\n\tv_mbcnt_hi_u32_b32 %0, -1, %0" : "=v"(tid)); tid += wv * 64;
#else
    int tid = threadIdx.x; asm volatile("" : "+v"(tid)); (void)wv;
#endif
    int bid = blockIdx.x; asm volatile("" : "+s"(bid));
#define wid (tid >> 6)
#define lane (tid & 63)
#define gtid ((size_t)bid * NTHR + tid)
#define gthreads ((size_t)gridDim.x * NTHR)
    float* H = (float*)(ws + OFF_H);
    bf16_t* HN = (bf16_t*)(ws + OFF_HN);
    float* MODV = (float*)(ws + M_MODV);
    float* PW = (float*)(ws + M_PW);
    float* BBT = (float*)(ws + M_BB);

    if (KSEL == 100 && ph != 0) return;
    if (KSEL == 101 && ph != NPHASE - 1) return;
    if (KSEL >= 0 && KSEL < 100 && (ph == 0 || ph == NPHASE - 1)) return;
    if (ph == 0) {
        for (int vb = bid; vb < 48 + 32 + 512; vb += gridDim.x) {
            if (vb < 48) {
                __syncthreads();
                for (int k = tid; k < 1024; k += NTHR) { sm[k] = silu(IN(I_C)[k]); sm[1024 + k] = silu(IN(I_CCTX)[k]); }
                __syncthreads();
                const int idx = vb * NTHR + tid, layer = idx / 6144, n = idx % 6144;
                const float* w = IN(I_WMOD) + (size_t)layer * 1024 * 6144 + n;
                float al = 0.f, ac = 0.f;
                for (int k = 0; k < 1024; ++k) { const float wv = w[(size_t)k * 6144]; al += sm[k] * wv; ac += sm[1024 + k] * wv; }
                const float b = IN(I_BMOD)[layer * 6144 + n];
                MODV[(layer * 2 + 0) * 6144 + n] = al + b; MODV[(layer * 2 + 1) * 6144 + n] = ac + b;
            } else if (vb < 80) {
                const int idx = (vb - 48) * NTHR + tid;
                const int pp = idx & 63, g = (idx >> 6) & 31, ld = idx >> 11;
                const float lre = IN(I_S5LRE)[idx], lim = IN(I_S5LIM)[idx], step = __expf(IN(I_S5STEP)[ld * 32 + g]);
                const float xr = lre * step, ang = lim * step;
                for (int t = 0; t <= 16; ++t) { const float mg = expf(xr * t); PW[((size_t)idx * 17 + t) * 2] = mg * cosf(ang * t); PW[((size_t)idx * 17 + t) * 2 + 1] = mg * sinf(ang * t); }
                const float mg = expf(xr), lbim = mg * sinf(ang), sh = sinf(0.5f * ang);
                const float nr = expm1f(xr) * cosf(ang) - 2.0f * sh * sh, den = lre * lre + lim * lim;
                const float fre = (nr * lre + lbim * lim) / den, fim = (lbim * lre - nr * lim) / den;
                for (int c = 0; c < 16; ++c) { const float br = IN(I_S5BRE)[(size_t)idx * 16 + c], bi = IN(I_S5BIM)[(size_t)idx * 16 + c];
                    BBT[((size_t)idx * 16 + c) * 2] = fre * br - fim * bi; BBT[((size_t)idx * 16 + c) * 2 + 1] = fre * bi + fim * br; }
                (void)pp;
            } else {
                const int cb = vb - 80;
                for (size_t i = (size_t)cb * NTHR + tid; i < (size_t)TOK * 256; i += (size_t)512 * NTHR) {
                    const f32x4 v = i < (size_t)256 * 256 ? ((const f32x4*)IN(I_CTX))[i] : ((const f32x4*)IN(I_X))[i - (size_t)256 * 256];
                    ((f32x4*)H)[i] = v; }
            }
        }
        return;
    }
    if (ph == NPHASE - 1) {
        const float* nw = IN(I_NORMF);
        for (int row = 256 + bid * 8 + wid; row < TOK; row += gridDim.x * 8) {
            const float* hp = H + (size_t)row * 1024; f32x4 x[4]; float ss = 0.f;
            UNR for (int e = 0; e < 4; ++e) { x[e] = *(const f32x4*)(hp + e * 256 + lane * 4); ss += x[e][0] * x[e][0] + x[e][1] * x[e][1] + x[e][2] * x[e][2] + x[e][3] * x[e][3]; }
            ss = wave_sum(ss, lane); const float sc = rsqrtf(ss * (1.0f / 1024.0f) + 1e-6f);
            UNR for (int e = 0; e < 4; ++e) { const int c = e * 256 + lane * 4; f32x4 y; UNR for (int j = 0; j < 4; ++j) y[j] = x[e][j] * sc * nw[c + j];
                *(f32x4*)(p.out + (size_t)(row - 256) * 1024 + c) = y; }
        }
        return;
    }
    const int L = (ph - 1) / PH_PER_LAYER, k = (ph - 1) % PH_PER_LAYER;
    const bool last = (L == NLAYER - 1);
    const float* modl = MODV + (L * 2 + 0) * 6144; const float* modc = MODV + (L * 2 + 1) * 6144;
    const int row0 = last ? 256 : 0, Mrows = last ? 16384 : TOK;

    if (KSEL >= 0 && k != KSEL) return;
    switch (k) {
    case 0: {
        conv_T(IN(I_WIN) + (size_t)L * 1024 * 6528, 6528, (bf16_t*)(ws + W_INA), 3584, 1024, MapIna(), sm, 0, tid, bid);
        conv_T(IN(I_WGLU) + (size_t)L * 512 * 512, 512, (bf16_t*)(ws + W_GLU), 512, 512, MapOff{0}, sm, 128, tid, bid);
        {
            bf16_t* W = (bf16_t*)(ws + W_LRU); const float* pwa = IN(I_WA); const float* pwx = IN(I_WX);
            for (size_t i = gtid; i < (size_t)2048 * 512; i += gthreads) { const int n = (int)(i >> 9), kk = (int)(i & 511);
                const int g32 = n >> 5, which = (n & 31) >> 4, dir = g32 >> 5, ch = (g32 & 31) * 16 + (n & 15), head = ch >> 6, j = ch & 63;
                float v = 0.f; if ((kk >> 6) == head) v = (which ? pwx : pwa)[((((size_t)L * 2 + dir) * 8 + head) * 64 + (kk & 63)) * 64 + j];
                W[i] = f2bf(v); }
        }
        {
            bf16_t* W = (bf16_t*)(ws + W_LORA);
            for (size_t i = gtid; i < (size_t)2560 * 384; i += gthreads) { const int n = (int)(i / 384), kk = (int)(i % 384);
                const int blk = n >> 9, ch = n & 511; float v = 0.f;
                if (blk < 2) { if ((kk >> 6) == blk) v = IN(I_W2)[(((size_t)L * 2 + blk) * 64 + (kk & 63)) * 512 + ch]; }
                else if (blk < 4) { if ((kk >> 6) == blk) v = IN(I_A2)[(((size_t)L * 2 + (blk - 2)) * 64 + (kk & 63)) * 512 + ch]; }
                else { if (kk >= 256) v = IN(I_G2)[((size_t)L * 128 + (kk - 256)) * 512 + ch]; }
                W[i] = f2bf(v); }
        }
        {
            float* KT = (float*)(ws + M_KT);
            const float* cre = IN(I_S5CRE) + (size_t)L * 2 * 32 * 16 * 64; const float* cim = IN(I_S5CIM) + (size_t)L * 2 * 32 * 16 * 64;
            const float* pw = PW + (size_t)L * 2 * 32 * 64 * 17 * 2; const float* bb = BBT + (size_t)L * 2 * 32 * 64 * 16 * 2;
            for (size_t i = gtid; i < (size_t)2 * 32 * 16 * 256; i += gthreads) {
                const int c = (int)(i & 15), cp = (int)((i >> 4) & 15), tau = (int)((i >> 8) & 15), dg = (int)(i >> 12);
                const float* cr = cre + ((size_t)dg * 16 + cp) * 64; const float* ci = cim + ((size_t)dg * 16 + cp) * 64;
                const float* pwd = pw + (size_t)dg * 64 * 34 + tau * 2; const float* bbd = bb + (size_t)dg * 64 * 32 + c * 2;
                float v = 0.f;
#pragma unroll 8
                for (int pp = 0; pp < 64; ++pp) { const float pr = pwd[pp * 34], pi = pwd[pp * 34 + 1], br = bbd[pp * 32], bi = bbd[pp * 32 + 1];
                    v += cr[pp] * (pr * br - pi * bi) - ci[pp] * (pr * bi + pi * br); }
                KT[i] = v; }
        }
        norm_rows(H, IN(I_NORM1) + L * 1024, modl, modc, 0, 1024, HN, 0, tid, bid);
    } break;
    case 1: {
        GemmArgs g{HN, (const bf16_t*)(ws + W_INA), 1024, 1024, 1024}; StaticOrder S; S.init(TOK, 3584, bid);
        gemm_phase(lds, g, S, EpiZ{ZA, ZB}, tid);
    } break;
    case 2: {
        const float* cw = IN(I_CONVW) + L * 2048; const float* cb = IN(I_CONVB) + L * 512;
        { const int cg8 = (int)(gtid & 63) * 8; float w0[8], w1[8], w2[8], w3[8], b8[8];
          UNR for (int e = 0; e < 8; ++e) { w0[e] = cw[cg8 + e]; w1[e] = cw[512 + cg8 + e]; w2[e] = cw[1024 + cg8 + e]; w3[e] = cw[1536 + cg8 + e]; b8[e] = cb[cg8 + e]; }
          for (size_t tk0 = gtid >> 6; tk0 < (size_t)TOK; tk0 += gthreads >> 6) { const int tk = (int)tk0, lo = tk < 256 ? 0 : 256, hi = tk < 256 ? 256 : TOK;
            float x0[8], x1[8], x2[8], x3[8], a[8]; const bf16_t* zp = ZA + (size_t)tk * 1536 + cg8;
            if (tk - 2 >= lo) ld8bf(zp - 2 * 1536, x0); else { UNR for (int e = 0; e < 8; ++e) x0[e] = 0.f; }
            if (tk - 1 >= lo) ld8bf(zp - 1536, x1); else { UNR for (int e = 0; e < 8; ++e) x1[e] = 0.f; }
            ld8bf(zp, x2);
            if (tk + 1 < hi) ld8bf(zp + 1536, x3); else { UNR for (int e = 0; e < 8; ++e) x3[e] = 0.f; }
            UNR for (int e = 0; e < 8; ++e) a[e] = b8[e] + w0[e] * x0[e] + w1[e] * x1[e] + w2[e] * x2[e] + w3[e] * x3[e];
            st8bf(XC + (size_t)tk * 512 + cg8, a); } }
        for (size_t i = gtid; i < (size_t)32 * 1040 * 16; i += gthreads) { const int j = (int)(i & 15); const int s = (int)((i >> 4) % 1040), g = (int)((i >> 4) / 1040);
            const int tk = s5_tok(s * 16 + j); const u32x4* src = (const u32x4*)(ZA + (size_t)tk * 1536 + 1024 + g * 16); u32x4* dst = (u32x4*)(A5 + ((size_t)g * 1040 + s) * 512 + j * 16);
            dst[0] = src[0]; dst[1] = src[1]; }
        {
            bf16_t* WY = (bf16_t*)(ws + W_S5Y); bf16_t* WE = (bf16_t*)(ws + W_S5E); const float* KT = (const float*)(ws + M_KT);
            const float* cre = IN(I_S5CRE) + (size_t)L * 2 * 32 * 16 * 64; const float* cim = IN(I_S5CIM) + (size_t)L * 2 * 32 * 16 * 64;
            const float* pw = PW + (size_t)L * 2 * 32 * 64 * 17 * 2; const float* bb = BBT + (size_t)L * 2 * 32 * 64 * 16 * 2;
            for (size_t i8 = gtid; i8 < (size_t)32 * 256 * 64; i8 += gthreads) {
                const int kk0 = (int)(i8 & 63) * 8, n = (int)((i8 >> 6) & 255), g = (int)(i8 >> 14), t = n >> 4, cp = n & 15; float v[8];
                if (kk0 < 256) { const int j = kk0 >> 4, c0 = kk0 & 15;
                    UNR for (int e = 0; e < 8; ++e) v[e] = 0.f;
                    if (t >= j) { const float* kp = KT + ((((size_t)0 * 32 + g) * 16 + (t - j)) * 16 + cp) * 16 + c0; const f32x4 a0 = *(const f32x4*)kp, a1 = *(const f32x4*)(kp + 4);
                        UNR for (int e = 0; e < 4; ++e) { v[e] += a0[e]; v[4 + e] += a1[e]; } }
                    if (j >= t) { const float* kp = KT + ((((size_t)1 * 32 + g) * 16 + (j - t)) * 16 + cp) * 16 + c0; const f32x4 a0 = *(const f32x4*)kp, a1 = *(const f32x4*)(kp + 4);
                        UNR for (int e = 0; e < 4; ++e) { v[e] += a0[e]; v[4 + e] += a1[e]; } } }
                else { const int d = (kk0 - 256) >> 7, pp0 = ((kk0 - 256) & 127) >> 1; const int ep = d == 0 ? t + 1 : 16 - t;
                    const f32x4 cr = *(const f32x4*)(cre + ((size_t)(d * 32 + g) * 16 + cp) * 64 + pp0), ci = *(const f32x4*)(cim + ((size_t)(d * 32 + g) * 16 + cp) * 64 + pp0);
                    UNR for (int e = 0; e < 4; ++e) { const float* pq = pw + ((size_t)(d * 32 + g) * 64 + pp0 + e) * 34 + ep * 2; const float pr = pq[0], pi = pq[1];
                        v[2 * e] = cr[e] * pr - ci[e] * pi; v[2 * e + 1] = -(cr[e] * pi + ci[e] * pr); } }
                st8bf(WY + i8 * 8, v); }
            for (size_t i8 = gtid; i8 < (size_t)32 * 256 * 32; i8 += gthreads) {
                const int kk0 = (int)(i8 & 31) * 8, n = (int)((i8 >> 5) & 255), g = (int)(i8 >> 13), d = n >> 7, pp = (n & 127) >> 1, ri = n & 1, j = kk0 >> 4, c0 = kk0 & 15;
                const int ep = d == 0 ? 15 - j : j;
                const float pr = pw[((size_t)(d * 32 + g) * 64 + pp) * 34 + ep * 2], pi = pw[((size_t)(d * 32 + g) * 64 + pp) * 34 + ep * 2 + 1];
                const float* bp = bb + ((size_t)(d * 32 + g) * 64 + pp) * 32 + c0 * 2; float v[8];
                UNR for (int e = 0; e < 8; e += 2) { const f32x4 b4 = *(const f32x4*)(bp + e * 2);
                    v[e] = ri == 0 ? pr * b4[0] - pi * b4[1] : pr * b4[1] + pi * b4[0]; v[e + 1] = ri == 0 ? pr * b4[2] - pi * b4[3] : pr * b4[3] + pi * b4[2]; }
                st8bf(WE + i8 * 8, v); }
        }
    } break;
    case 3: {
        { GemmArgs g{XC, (const bf16_t*)(ws + W_LRU), 512, 512, 512}; StaticOrder S; S.init(TOK, 2048, bid);
          gemm_phase(lds, g, S, EpiLruGate{XC, LA, LU, IN(I_BA) + L * 1024, IN(I_BX) + L * 1024, IN(I_LAM) + L * 1024}, tid); }
        asm volatile("" : "+v"(tid));
        { GemmArgs g{A5, (const bf16_t*)(ws + W_S5E), 512, 256, 256}; S5Order S; S.init(248, bid);
          gemm_phase(lds, g, S, EpiS5E{S5E}, tid); }
    } break;
    case 4: {
        for (int task = bid; task < 520 + 256; task += gridDim.x) {
            if (task < 520) { const int c = task >> 1, dir = task & 1, ch = tid; float As = 0.f, Bs = 0.f;
                for (int j0 = 0; j0 < 64; j0 += 16) { float la[16], uu[16];
                    UNR for (int j = 0; j < 16; ++j) { const int tk = tok_of(dir, c * 64 + j0 + j); const size_t o = ((size_t)dir * TOK + tk) * 512 + ch; la[j] = bf2f(LA[o]); uu[j] = bf2f(LU[o]); }
                    UNR for (int j = 0; j < 16; ++j) { As += la[j]; Bs = __expf(la[j]) * Bs + uu[j]; } }
                CA[(dir * 260 + c) * 512 + ch] = As; CB[(dir * 260 + c) * 512 + ch] = Bs;
            } else {
                const int idx = (task - 520) * 32 + (tid & 31), seg = tid >> 5;
                const int pp = idx & 63, dir = (idx >> 6) & 1, g = idx >> 7;
                const float* pw = PW + ((((size_t)L * 2 + dir) * 32 + g) * 64 + pp) * 34; const float ar = pw[32], ai = pw[33];
                const int cb = dir * 128 + pp * 2;
                float hr = 0.f, hi = 0.f, pr = 1.f, pi = 0.f;
                for (int q0 = seg * 65; q0 < seg * 65 + 65; q0 += 13) { float er[13], ei[13];
                    UNR for (int j = 0; j < 13; ++j) { const int q = q0 + j, sx = dir == 0 ? q : (q < 16 ? 15 - q : 1055 - q); const float* ep = S5E + ((size_t)g * 1040 + sx) * 256 + cb; er[j] = ep[0]; ei[j] = ep[1]; }
                    UNR for (int j = 0; j < 13; ++j) { const float nr = ar * hr - ai * hi + er[j], ni = ar * hi + ai * hr + ei[j]; hr = nr; hi = ni;
                        const float qr = ar * pr - ai * pi, qi = ar * pi + ai * pr; pr = qr; pi = qi; } }
                __syncthreads();
                sm[(seg * 32 + (tid & 31)) * 2] = hr; sm[(seg * 32 + (tid & 31)) * 2 + 1] = hi;
                __syncthreads();
                hr = 0.f; hi = 0.f;
                for (int k2 = 0; k2 < seg; ++k2) { const float er = sm[(k2 * 32 + (tid & 31)) * 2], ei = sm[(k2 * 32 + (tid & 31)) * 2 + 1];
                    const float nr = pr * hr - pi * hi + er, ni = pr * hi + pi * hr + ei; hr = nr; hi = ni; }
                for (int q0 = seg * 65; q0 < seg * 65 + 65; q0 += 13) { float er[13], ei[13];
                    UNR for (int j = 0; j < 13; ++j) { const int q = q0 + j, sx = dir == 0 ? q : (q < 16 ? 15 - q : 1055 - q); const float* ep = S5E + ((size_t)g * 1040 + sx) * 256 + cb; er[j] = ep[0]; ei[j] = ep[1]; }
                    UNR for (int j = 0; j < 13; ++j) { const int q = q0 + j, sx = dir == 0 ? q : (q < 16 ? 15 - q : 1055 - q);
                        *(unsigned*)(A5 + ((size_t)g * 1040 + sx) * 512 + 256 + cb) = pack2(hr, hi);
                        const float nr = ar * hr - ai * hi + er[j], ni = ar * hi + ai * hr + ei[j]; hr = nr; hi = ni; } }
                __syncthreads();
            }
        }
    } break;
    case 5: {
        if (bid < 2) { const int dir = bid, ch = tid; float h = 0.f;
            for (int c0 = 0; c0 < 260; c0 += 13) { float a[13], b[13];
                UNR for (int j = 0; j < 13; ++j) { a[j] = CA[(dir * 260 + c0 + j) * 512 + ch]; b[j] = CB[(dir * 260 + c0 + j) * 512 + ch]; }
                UNR for (int j = 0; j < 13; ++j) { HIN[(dir * 260 + c0 + j) * 512 + ch] = h; h = __expf(a[j]) * h + b[j]; } } }
        __syncthreads(); asm volatile("" : "+v"(tid));
        { GemmArgs g{A5, (const bf16_t*)(ws + W_S5Y), 512, 512, 512}; S5Order S; S.init(254, bid);
          gemm_phase(lds, g, S, EpiS5Y{ZA, XC, IN(I_S5D) + L * 512}, tid); }
    } break;
    case 6: {
        for (int ct = bid; ct < 260; ct += gridDim.x) { const int ch = tid;
            float h = HIN[(0 * 260 + ct) * 512 + ch];
            for (int j0 = 0; j0 < 64; j0 += 16) { float la[16], uu[16];
                UNR for (int j = 0; j < 16; ++j) { const size_t o = (size_t)(ct * 64 + j0 + j) * 512 + ch; la[j] = bf2f(LA[o]); uu[j] = bf2f(LU[o]); }
                UNR for (int j = 0; j < 16; ++j) { const size_t o = (size_t)(ct * 64 + j0 + j) * 512 + ch; h = __expf(la[j]) * h + uu[j]; YA[o] = f2bf(h); } }
            const int c1 = ct < 4 ? 3 - ct : 263 - ct; h = HIN[(1 * 260 + c1) * 512 + ch];
            for (int j0 = 0; j0 < 64; j0 += 16) { float la[16], uu[16], ga[16], hf[16];
                UNR for (int j = 0; j < 16; ++j) { const int tk = ct * 64 + 63 - j0 - j; const size_t o = (size_t)tk * 512 + ch, o1 = (size_t)TOK * 512 + o;
                    la[j] = bf2f(LA[o1]); uu[j] = bf2f(LU[o1]); ga[j] = bf2f(ZA[(size_t)tk * 1536 + 512 + ch]); hf[j] = bf2f(YA[o]); }
                UNR for (int j = 0; j < 16; ++j) { const int tk = ct * 64 + 63 - j0 - j; const size_t o = (size_t)tk * 512 + ch;
                    h = __expf(la[j]) * h + uu[j]; YA[o] = f2bf(gelu_t(ga[j]) * (hf[j] + h)); } } }
        __syncthreads(); asm volatile("" : "+v"(tid));
        { GemmArgs g{XC, (const bf16_t*)(ws + W_GLU), 512, 512, 512}; StaticOrder S; S.init(TOK, 512, bid);
          gemm_phase(lds, g, S, EpiGlu{XC, YC, IN(I_BGLU) + L * 512}, tid); }
    } break;
    case 7: {
        const float* mu = IN(I_MU) + L * 1920;
        for (size_t i = gtid; i < (size_t)TOK * 48; i += gthreads) { const int tk = (int)(i / 48), q = (int)(i % 48) * 8;
            const int lo = tk < 256 ? 0 : 256, hi = tk < 256 ? 256 : TOK; const bf16_t* zp = ZB + (size_t)tk * 2048 + 1536 + q;
            float z[8], zp1[8], zn1[8], o[8];
            ld8bf(zp, z);
            if (tk - 1 >= lo) ld8bf(zp - 2048, zp1); else { UNR for (int e = 0; e < 8; ++e) zp1[e] = 0.f; }
            if (tk + 1 < hi) ld8bf(zp + 2048, zn1); else { UNR for (int e = 0; e < 8; ++e) zn1[e] = 0.f; }
            UNR for (int e = 0; e < 8; ++e) { const float zz = z[e] + mu[1536 + q + e] * (0.5f * (zp1[e] + zn1[e]) - z[e]); o[e] = q < 128 ? tanhf(zz) : (q < 256 ? zz : sigm(zz)); }
            st8bf(LORAA + (size_t)tk * 384 + q, o); }
    } break;
    case 8: {
        GemmArgs g{LORAA, (const bf16_t*)(ws + W_LORA), 384, 384, 384}; StaticOrder S; S.init(TOK, 2560, bid);
        gemm_phase(lds, g, S, EpiLora{LW, IC, GG, IN(I_W0) + L * 1024, IN(I_A0) + L * 1024}, tid);
    } break;
    case 9: {
        const float* mu = IN(I_MU) + L * 1920; const float* kkw = IN(I_KK) + L * 512; const float* kaw = IN(I_KA) + L * 512;
        for (int t4 = bid; t4 < 16 * WNC / 4; t4 += gridDim.x) {
            const int q = wid >> 1, half = wid & 1, task = t4 * 4 + q, hd = task / WNC, c = task % WNC;
            const int sub = tid & 3, row0 = ((tid & 63) >> 2) * 4;
            const int pcol = (hd & 7) * 64 + lane; const float mur = mu[pcol], muk = mu[512 + pcol], muv = mu[1024 + pcol], kkwv = kkw[pcol], kawv = kaw[pcol];
            f32x2 s[4][8];
            UNR for (int r = 0; r < 4; ++r) UNR for (int i = 0; i < 8; ++i) { const int ch = sub * 16 + 2 * i;
                s[r][i] = (f32x2){(half == 1 && row0 + r == ch) ? 1.f : 0.f, (half == 1 && row0 + r == ch + 1) ? 1.f : 0.f}; }
            for (int sc = 0; sc < WCH / WSC; ++sc) {
                __syncthreads();
                wkv_stage_all(sm, ZB, LW, IC, mur, muk, muv, kkwv, kawv, hd >> 3, hd & 7, (t4 * 4) % WNC, sc, wid, lane);
                __syncthreads();
                wkv_steps<4, false>(s, sm + q * WSC * WVEC, nullptr, WSC, row0, half == 0, sub);
            }
            UNR for (int r = 0; r < 4; ++r) { float* dst = PQ + ((size_t)hd * WNC + c) * 8192 + half * 4096 + (row0 + r) * 64 + sub * 16;
                UNR for (int i = 0; i < 8; i += 2) *(f32x4*)(dst + 2 * i) = (f32x4){s[r][i][0], s[r][i][1], s[r][i + 1][0], s[r][i + 1][1]}; }
        }
    } break;
    case 10: {
        for (int task = bid; task < 128; task += gridDim.x) { const int hd = task >> 3, rg = task & 7, r = tid >> 6, i = tid & 63, vrow = rg * 8 + r;
            float sv = 0.f; float* Ps = sm + 512;
            const float* P0 = PQ + ((size_t)hd * WNC) * 8192;
            f32x4 pa = *(const f32x4*)(P0 + 4096 + tid * 8), pb = *(const f32x4*)(P0 + 4096 + tid * 8 + 4); float qc = P0[vrow * 64 + i];
            for (int c = 0; c < WNC; ++c) {
                __syncthreads();
                *(f32x4*)(Ps + tid * 8) = pa; *(f32x4*)(Ps + tid * 8 + 4) = pb; sm[r * 64 + i] = sv;
                SCS[((size_t)hd * WNC + c) * 4096 + vrow * 64 + i] = sv;
                float a2 = qc;
                if (c + 1 < WNC) { const float* P1 = PQ + ((size_t)hd * WNC + c + 1) * 8192; pa = *(const f32x4*)(P1 + 4096 + tid * 8); pb = *(const f32x4*)(P1 + 4096 + tid * 8 + 4); qc = P1[vrow * 64 + i]; }
                __syncthreads();
#pragma unroll 16
                for (int a = 0; a < 64; ++a) a2 += sm[r * 64 + a] * Ps[a * 64 + i];
                sv = a2;
            }
            __syncthreads();
        }
    } break;
    case 11: {
        const float* mu = IN(I_MU) + L * 1920; const float* kkw = IN(I_KK) + L * 512; const float* kaw = IN(I_KA) + L * 512;
        for (int t4 = bid; t4 < 16 * WNC / 4; t4 += gridDim.x) {
            const int q = wid >> 1, task = t4 * 4 + q, hd = task / WNC, c = task % WNC;
            const int sub = tid & 3, row0 = ((tid & 127) >> 2) * 2;
            const int pcol = (hd & 7) * 64 + lane; const float mur = mu[pcol], muk = mu[512 + pcol], muv = mu[1024 + pcol], kkwv = kkw[pcol], kawv = kaw[pcol];
            f32x2 s[2][8]; float* sy = sm + 4 * WSC * WVEC;
            UNR for (int r = 0; r < 2; ++r) { const float* src = SCS + ((size_t)hd * WNC + c) * 4096 + (row0 + r) * 64 + sub * 16;
                UNR for (int i = 0; i < 8; i += 2) { const f32x4 t = *(const f32x4*)(src + 2 * i); s[r][i] = (f32x2){t[0], t[1]}; s[r][i + 1] = (f32x2){t[2], t[3]}; } }
            for (int sc = 0; sc < WCH / WSC; ++sc) {
                __syncthreads();
                wkv_stage_all(sm, ZB, LW, IC, mur, muk, muv, kkwv, kawv, hd >> 3, hd & 7, (t4 * 4) % WNC, sc, wid, lane);
                __syncthreads();
                wkv_steps<2, true>(s, sm + q * WSC * WVEC, sy + q * WSC * 64, WSC, row0, true, sub);
                __syncthreads();
                for (int e = tid; e < 4 * WSC * 64; e += NTHR) { const int qq = e / (WSC * 64), jj = (e / 64) % WSC, vch = e & 63, tk2 = t4 * 4 + qq, hd2 = tk2 / WNC, c2 = tk2 % WNC, d2 = hd2 >> 3;
                    bf16_t* YD = d2 == 0 ? YB : YD1; YD[(size_t)tok_of(d2, c2 * WCH + sc * WSC + jj) * 512 + (hd2 & 7) * 64 + vch] = f2bf(sy[e]); }
            }
        }
    } break;
    case 12: {
        const float* mu = IN(I_MU) + L * 1920; const float* kaw = IN(I_KA) + L * 512; const float* rk = IN(I_RK) + L * 512;
        const float* lnw = IN(I_LNW) + L * 512; const float* lnb = IN(I_LNB) + L * 512;
        for (int wt0 = (bid * 8 + wid) * 4; wt0 < TOK * 8; wt0 += gridDim.x * 8 * 4) {
            float yv[4], rz[4][3], kz[4][3], vz[4][3], i0[4], i1[4], gv[4];
            UNR for (int u = 0; u < 4; ++u) { const int wt = wt0 + u, tk = wt >> 3, col = (wt & 7) * 64 + lane; const size_t o = (size_t)tk * 512 + col;
                const int lo = tk < 256 ? 0 : 256, hi = tk < 256 ? 256 : TOK; const bool hp = tk - 1 >= lo, hn = tk + 1 < hi; const bf16_t* z0 = ZB + (size_t)tk * 2048 + col;
                yv[u] = bf2f(YB[o]) + bf2f(YD1[o]); i0[u] = bf2f(IC[o]); i1[u] = bf2f(IC[(size_t)TOK * 512 + o]); gv[u] = bf2f(GG[o]);
                rz[u][1] = bf2f(z0[0]); kz[u][1] = bf2f(z0[512]); vz[u][1] = bf2f(z0[1024]);
                rz[u][0] = hp ? bf2f(z0[-2048]) : 0.f; kz[u][0] = hp ? bf2f(z0[-2048 + 512]) : 0.f; vz[u][0] = hp ? bf2f(z0[-2048 + 1024]) : 0.f;
                rz[u][2] = hn ? bf2f(z0[2048]) : 0.f; kz[u][2] = hn ? bf2f(z0[2048 + 512]) : 0.f; vz[u][2] = hn ? bf2f(z0[2048 + 1024]) : 0.f; }
            UNR for (int u = 0; u < 4; ++u) { const int wt = wt0 + u, tk = wt >> 3, col = (wt & 7) * 64 + lane; const size_t o = (size_t)tk * 512 + col;
                const float y = yv[u];
                const float mean = wave_sum(y, lane) * (1.0f / 64.0f); const float dv = y - mean; const float var = wave_sum(dv * dv, lane) * (1.0f / 64.0f);
                float yn = dv * rsqrtf(var + 64e-5f) * lnw[col] + lnb[col];
                const float r = rz[u][1] + mu[col] * (0.5f * (rz[u][0] + rz[u][2]) - rz[u][1]);
                const float kx = kz[u][1] + mu[512 + col] * (0.5f * (kz[u][0] + kz[u][2]) - kz[u][1]);
                const float v = vz[u][1] + mu[1024 + col] * (0.5f * (vz[u][0] + vz[u][2]) - vz[u][1]);
                const float kd0 = kx * (1.0f + (i0[u] - 1.0f) * kaw[col]), kd1 = kx * (1.0f + (i1[u] - 1.0f) * kaw[col]);
                const float bon = wave_sum(r * (kd0 + kd1) * rk[col], lane);
                yn += bon * v;
                YB[o] = f2bf(yn * gv[u]); } }
        __syncthreads();
        conv_T(IN(I_WIN) + (size_t)L * 1024 * 6528, 6528, (bf16_t*)(ws + W_INZG), 3072, 1024, MapOff{3456}, sm, 0, tid, bid);
        for (int kb = 0; kb < 3; ++kb) conv_T(IN(I_WBR) + ((size_t)L * 3 + kb) * 512 * 1024, 1024, (bf16_t*)(ws + W_BR) + (size_t)kb * 1024 * 512, 1024, 512, MapOff{0}, sm, kb * 64, tid, bid);
        conv_T(IN(I_WOUT) + (size_t)L * 1024 * 1024, 1024, (bf16_t*)(ws + W_OUT), 1024, 1024, MapOff{0}, sm, 192, tid, bid);
        conv_T(IN(I_WFIN) + (size_t)L * 1024 * 5632, 5632, (bf16_t*)(ws + W_FIN), 5632, 1024, MapFfn(), sm, 0, tid, bid);
        conv_T(IN(I_WFOUT) + (size_t)L * 2816 * 1024, 1024, (bf16_t*)(ws + W_FOUT), 1024, 2816, MapOff{0}, sm, 128, tid, bid);
        norm_rows(H, IN(I_NORM1) + L * 1024, modl, modc, 0, 1024, HN, row0, tid, bid);
    } break;
    case 13: {
        GemmArgs g{HN + (size_t)row0 * 1024, (const bf16_t*)(ws + W_INZG), 1024, 1024, 1024}; StaticOrder S; S.init(Mrows, 3072, bid);
        gemm_phase(lds, g, S, EpiZg{ZG, row0}, tid);
    } break;
    case 14: {
        GemmArgs g{YS + (size_t)row0 * 512, (const bf16_t*)(ws + W_BR), 512, 512, 512}; TripleOrder S; S.init(Mrows, bid);
        gemm_phase(lds, g, S, EpiMerge1{ZG, MM, row0}, tid);
    } break;
    case 15: {
        GemmArgs g{MM + (size_t)row0 * 1024, (const bf16_t*)(ws + W_OUT), 1024, 1024, 1024}; StaticOrder S; S.init(Mrows, 1024, bid);
        gemm_phase(lds, g, S, EpiRes{H, modl + 2048, modc + 2048, row0}, tid);
    } break;
    case 16: {
        norm_rows(H, IN(I_NORM2) + L * 1024, modl, modc, 3072, 4096, HN, row0, tid, bid);
    } break;
    case 17: {
        GemmArgs g{HN + (size_t)row0 * 1024, (const bf16_t*)(ws + W_FIN), 1024, 1024, 1024}; StaticOrder S; S.init(Mrows, 5632, bid);
        gemm_phase(lds, g, S, EpiFfn{ACT, row0}, tid);
    } break;
    case 18: {
        GemmArgs g{ACT + (size_t)row0 * 2816, (const bf16_t*)(ws + W_FOUT), 2816, 2816, 2816}; StaticOrder S; S.init(Mrows, 1024, bid);
        gemm_phase(lds, g, S, EpiRes{H, modl + 5120, modc + 5120, row0}, tid);
    } break;
    }
}

#undef wid
#undef lane
#undef gtid
#undef gthreads
#define XB_TMO      128
#define XB_XCNT(j)  (256  + 64 * (j))
#define XB_XSUB(j)  (1280 + 64 * (j))
#define XB_XGEN(j)  (2304 + 64 * (j))
#define XB_TOP      3328
#define XB_TOPGEN   3392
#define XCD_BAR_WORDS 3456
#define XB_SPIN_CAP (1u << 18)
__device__ __forceinline__ unsigned xb_ld(unsigned* p)              { return __hip_atomic_load(p, __ATOMIC_RELAXED, __HIP_MEMORY_SCOPE_AGENT); }
__device__ __forceinline__ unsigned xb_add(unsigned* p, unsigned v) { return __hip_atomic_fetch_add(p, v, __ATOMIC_RELAXED, __HIP_MEMORY_SCOPE_AGENT); }
__device__ __forceinline__ unsigned xb_xcc_id() { return (unsigned)__builtin_amdgcn_s_getreg((3 << 11) | 20) & 0xFu; }
#define XB_SPIN(cond, bar) do { unsigned _sp = 0; while (cond) { __builtin_amdgcn_s_sleep(1); \
    if ((++_sp & 255u) == 0u) { if (xb_ld(&(bar)[XB_TMO])) break; if (_sp > XB_SPIN_CAP) { atomicAdd(&(bar)[XB_TMO], 1u); break; } } } } while (0)
struct XcdBarrier { unsigned* bar; unsigned x; volatile LAS unsigned* st; };
__device__ __forceinline__ XcdBarrier xcd_barrier_post(unsigned* bar, volatile LAS unsigned* st) {
    XcdBarrier b; b.bar = bar; b.x = xb_xcc_id(); b.st = st;
    if (threadIdx.x == 0) (void)xb_add(&bar[XB_XCNT(b.x)], 1u);
    return b;
}
__device__ __forceinline__ void xcd_barrier_complete(unsigned* bar, unsigned x, unsigned& nloc, unsigned& nx) {
    const unsigned G = gridDim.x * gridDim.y * gridDim.z;
    unsigned sum, cnt, mine, sp = 0u;
    for (;;) {
        sum = 0u; cnt = 0u; mine = 0u;
#pragma unroll
        for (unsigned j = 0; j < 16; ++j) { const unsigned c = xb_ld(&bar[XB_XCNT(j)]); sum += c; cnt += (c > 0u) ? 1u : 0u; mine = (j == x) ? c : mine; }
        if (sum == G) break;
        __builtin_amdgcn_s_sleep(1);
        if ((++sp & 255u) == 0u) { if (xb_ld(&bar[XB_TMO])) break; if (sp > XB_SPIN_CAP) { atomicAdd(&bar[XB_TMO], 1u); break; } }
    }
    nloc = mine > 0u ? mine : 1u; nx = cnt > 0u ? cnt : 1u;
}
__device__ __forceinline__ void xcd_barrier(const XcdBarrier& b) {
    asm volatile("s_waitcnt vmcnt(0) lgkmcnt(0)" ::: "memory");
    __syncthreads();
    if (threadIdx.x == 0) {
        unsigned* bar = b.bar;
        __builtin_amdgcn_s_waitcnt(0);
        unsigned nloc = b.st[0], nx = b.st[1];
        if (nloc == 0u) { xcd_barrier_complete(bar, b.x, nloc, nx); b.st[0] = nloc; b.st[1] = nx; }
        const unsigned old = xb_add(&bar[XB_XSUB(b.x)], 1u);
        const unsigned gen = old / nloc;
        if (old + 1u == (gen + 1u) * nloc) {
            __builtin_amdgcn_fence(__ATOMIC_RELEASE, "agent");
            asm volatile("s_waitcnt vmcnt(0)" ::: "memory");
            const unsigned og = xb_add(&bar[XB_TOP], 1u);
            const unsigned tg = og / nx;
            if (og + 1u == (tg + 1u) * nx) xb_add(&bar[XB_TOPGEN], 1u);
            else XB_SPIN(xb_ld(&bar[XB_TOPGEN]) == tg, bar);
            __builtin_amdgcn_fence(__ATOMIC_ACQUIRE, "agent");
            xb_add(&bar[XB_XGEN(b.x)], 1u);
            asm volatile("s_waitcnt vmcnt(0)" ::: "memory");
        } else {
            XB_SPIN(xb_ld(&bar[XB_XGEN(b.x)]) == gen, bar);
            __builtin_amdgcn_fence(__ATOMIC_ACQUIRE, "agent");
            asm volatile("s_waitcnt vmcnt(0)" ::: "memory");
        }
    }
    __syncthreads();
}
__device__ __forceinline__ void grid_bar(unsigned* ctr, unsigned target) {
    asm volatile("s_waitcnt vmcnt(0) lgkmcnt(0)" ::: "memory");
    __syncthreads();
    if (threadIdx.x == 0) {
        __builtin_amdgcn_fence(__ATOMIC_RELEASE, "agent");
        asm volatile("s_waitcnt vmcnt(0)" ::: "memory");
        __hip_atomic_fetch_add(ctr, 1u, __ATOMIC_RELAXED, __HIP_MEMORY_SCOPE_AGENT);
        while (__hip_atomic_load(ctr, __ATOMIC_RELAXED, __HIP_MEMORY_SCOPE_AGENT) < target) __builtin_amdgcn_s_sleep(2);
    }
    if (threadIdx.x < 64) {
        __builtin_amdgcn_fence(__ATOMIC_ACQUIRE, "agent");
        asm volatile("s_waitcnt vmcnt(0)" ::: "memory");
    }
    __syncthreads();
}
#if SINGLE_LAUNCH
__global__ void __launch_bounds__(NTHR, 2) fwd_megakernel(Params p, int ph_lo, int ph_hi) {
    extern __shared__ __attribute__((aligned(16))) unsigned char shm[];
    volatile LAS unsigned* xst = (volatile LAS unsigned*)((LAS unsigned char*)shm + LDS_STAGE);
    if (threadIdx.x < 2) xst[threadIdx.x] = 0u;
    if (blockIdx.x == 0) for (int i = threadIdx.x; i < XCD_BAR_WORDS; i += NTHR) __hip_atomic_store((unsigned*)(p.ws + M_BAR) + i, 0u, __ATOMIC_RELAXED, __HIP_MEMORY_SCOPE_AGENT);
    __syncthreads();
    { cg::grid_group grid = cg::this_grid(); grid.sync(); }
    const int wv = __builtin_amdgcn_readfirstlane(threadIdx.x >> 6);
    const XcdBarrier xb = xcd_barrier_post((unsigned*)(p.ws + M_BAR), xst);
#ifdef USE_CG_SYNC
#define MK_SYNC do { asm volatile("s_waitcnt vmcnt(0) lgkmcnt(0)" ::: "memory"); __syncthreads(); cg::this_grid().sync(); } while (0)
#else
#define MK_SYNC xcd_barrier(xb)
#endif
#ifdef MK_SWITCH
    for (int ph = 0; ph < NPHASE; ++ph) { run_phase<-1>(p, ph, shm, wv); if (ph + 1 < NPHASE) MK_SYNC; }
}
#else
    run_phase<100>(p, 0, shm, wv); MK_SYNC;
#define MK_LAYER(LL) do { const int base = 1 + (LL) * PH_PER_LAYER; \
        run_phase<0>(p, base + 0, shm, wv); MK_SYNC;   run_phase<1>(p, base + 1, shm, wv); MK_SYNC;   run_phase<2>(p, base + 2, shm, wv); MK_SYNC; \
        run_phase<3>(p, base + 3, shm, wv); MK_SYNC;   run_phase<4>(p, base + 4, shm, wv); MK_SYNC;   run_phase<5>(p, base + 5, shm, wv); MK_SYNC; \
        run_phase<6>(p, base + 6, shm, wv); MK_SYNC;   run_phase<7>(p, base + 7, shm, wv); MK_SYNC;   run_phase<8>(p, base + 8, shm, wv); MK_SYNC; \
        run_phase<9>(p, base + 9, shm, wv); MK_SYNC;   run_phase<10>(p, base + 10, shm, wv); MK_SYNC; run_phase<11>(p, base + 11, shm, wv); MK_SYNC; \
        run_phase<12>(p, base + 12, shm, wv); MK_SYNC; run_phase<13>(p, base + 13, shm, wv); MK_SYNC; run_phase<14>(p, base + 14, shm, wv); MK_SYNC; \
        run_phase<15>(p, base + 15, shm, wv); MK_SYNC; run_phase<16>(p, base + 16, shm, wv); MK_SYNC; run_phase<17>(p, base + 17, shm, wv); MK_SYNC; \
        run_phase<18>(p, base + 18, shm, wv); MK_SYNC; } while (0)
    MK_LAYER(0); MK_LAYER(1); MK_LAYER(2); MK_LAYER(3);
    run_phase<101>(p, NPHASE - 1, shm, wv);
}
#endif
#endif
template <int KSEL>
__global__ void __launch_bounds__(NTHR, 2) phase_kernel(Params p, int ph) {
    extern __shared__ __attribute__((aligned(16))) unsigned char shm[];
    run_phase<KSEL>(p, ph, shm, __builtin_amdgcn_readfirstlane(threadIdx.x >> 6));
}
template <int KSEL> static void launch_phase(const Params& p, int ph, int grid, hipStream_t stream) {
    static bool attr = false;
    if (!attr) { (void)hipFuncSetAttribute((const void*)phase_kernel<KSEL>, hipFuncAttributeMaxDynamicSharedMemorySize, LDS_BYTES); attr = true; }
    phase_kernel<KSEL><<<grid, NTHR, LDS_BYTES, stream>>>(p, ph);
}

extern "C" void kernel_launch(void* const* d_in, const int* in_sizes, int n_in, void* d_out, int out_size, void* d_ws, size_t ws_size, hipStream_t stream) {
    static int grid = 0;
    if (grid == 0) {
        if (n_in != 42 || ws_size < WS_END) { fprintf(stderr, "kernel_launch: unexpected n_in %d or ws %zu < %zu\n", n_in, ws_size, (size_t)WS_END); grid = -1; return; }
        int dev = 0, cus = 0;
        (void)hipGetDevice(&dev); (void)hipDeviceGetAttribute(&cus, hipDeviceAttributeMultiprocessorCount, dev);
#if SINGLE_LAUNCH
        if (hipFuncSetAttribute((const void*)fwd_megakernel, hipFuncAttributeMaxDynamicSharedMemorySize, LDS_BYTES) != hipSuccess) { fprintf(stderr, "hipFuncSetAttribute failed\n"); grid = -1; return; }
#endif
        (void)hipGetLastError();
        grid = cus;
    }
    if (grid < 0) return;
    Params p{};
    for (int i = 0; i < 42; ++i) p.in[i] = (const float*)d_in[i];
    p.out = (float*)d_out; p.ws = (unsigned char*)d_ws;
#if SINGLE_LAUNCH
    (void)hipMemsetAsync((unsigned char*)d_ws + M_BAR, 0, 16384, stream);
    int lo = 0, hi = NPHASE;
    void* args[] = {&p, &lo, &hi};
    hipError_t e = hipLaunchCooperativeKernel((const void*)fwd_megakernel, dim3(grid), dim3(NTHR), args, LDS_BYTES, stream);
    if (e != hipSuccess) fprintf(stderr, "cooperative launch failed: %s (grid %d)\n", hipGetErrorString(e), grid);
#else
    for (int ph = 0; ph < NPHASE; ++ph) {
        if (ph == 0) { launch_phase<100>(p, ph, grid, stream); continue; }
        if (ph == NPHASE - 1) { launch_phase<101>(p, ph, grid, stream); continue; }
        switch ((ph - 1) % PH_PER_LAYER) {
        case 0: launch_phase<0>(p, ph, grid, stream); break;   case 1: launch_phase<1>(p, ph, grid, stream); break;
        case 2: launch_phase<2>(p, ph, grid, stream); break;   case 3: launch_phase<3>(p, ph, grid, stream); break;
        case 4: launch_phase<4>(p, ph, grid, stream); break;   case 5: launch_phase<5>(p, ph, grid, stream); break;
        case 6: launch_phase<6>(p, ph, grid, stream); break;   case 7: launch_phase<7>(p, ph, grid, stream); break;
        case 8: launch_phase<8>(p, ph, grid, stream); break;   case 9: launch_phase<9>(p, ph, grid, stream); break;
        case 10: launch_phase<10>(p, ph, grid, stream); break; case 11: launch_phase<11>(p, ph, grid, stream); break;
        case 12: launch_phase<12>(p, ph, grid, stream); break; case 13: launch_phase<13>(p, ph, grid, stream); break;
        case 14: launch_phase<14>(p, ph, grid, stream); break; case 15: launch_phase<15>(p, ph, grid, stream); break;
        case 16: launch_phase<16>(p, ph, grid, stream); break; case 17: launch_phase<17>(p, ph, grid, stream); break;
        case 18: launch_phase<18>(p, ph, grid, stream); break;
        }
    }
#endif
}
```

```cpp
#define TID_MBCNT 1
#include <hip/hip_runtime.h>
#include <hip/hip_cooperative_groups.h>
#include <cstdio>
namespace cg = cooperative_groups;

#define LAS __attribute__((address_space(3)))
#define UNR _Pragma("unroll")
typedef unsigned short bf16_t;
typedef short bf16x8 __attribute__((ext_vector_type(8)));
typedef float f32x4 __attribute__((ext_vector_type(4)));
typedef unsigned u32x2 __attribute__((ext_vector_type(2)));
typedef unsigned u32x4 __attribute__((ext_vector_type(4)));

constexpr int TOK = 16640, NLAYER = 4;
#ifndef SINGLE_LAUNCH
#define SINGLE_LAUNCH 1
#endif
constexpr int NTHR = 512;
constexpr int LDS_STAGE = 131072;
constexpr int LDS_BYTES = LDS_STAGE + 16;

constexpr size_t SZ_TB512 = (size_t)TOK * 512 * 2;
constexpr size_t OFF_H = 0;
constexpr size_t OFF_HN = OFF_H + (size_t)TOK * 1024 * 4;
constexpr size_t OFF_W1 = OFF_HN + (size_t)TOK * 1024 * 2;
constexpr size_t W_INA = OFF_W1;
constexpr size_t W_LRU = W_INA + (size_t)3584 * 1024 * 2;
constexpr size_t W_LORA = W_LRU + (size_t)2048 * 512 * 2;
constexpr size_t W_S5Y = W_LORA + (size_t)2560 * 384 * 2;
constexpr size_t W_S5E = W_S5Y + (size_t)32 * 256 * 512 * 2;
constexpr size_t W_GLU = W_S5E + (size_t)32 * 256 * 256 * 2;
constexpr size_t OFF_YS = W_GLU + (size_t)512 * 512 * 2;
constexpr size_t OFF_ZB = OFF_YS + 3 * SZ_TB512;
constexpr size_t OFF_MISC = OFF_ZB + (size_t)TOK * 2048 * 2;
constexpr size_t M_MODV = OFF_MISC;
constexpr size_t M_PW = M_MODV + (size_t)4 * 2 * 6144 * 4;
constexpr size_t M_BB = M_PW + (size_t)4 * 2 * 32 * 64 * 17 * 2 * 4;
constexpr size_t M_CA = M_BB + (size_t)4 * 2 * 32 * 64 * 16 * 2 * 4;
constexpr size_t M_CB = M_CA + (size_t)2 * 260 * 512 * 4;
constexpr size_t M_HIN = M_CB + (size_t)2 * 260 * 512 * 4;
constexpr size_t M_KT = M_HIN + (size_t)2 * 260 * 512 * 4;
constexpr size_t M_BAR = OFF_MISC + 16777216 - 16384;
constexpr size_t OFF_X = OFF_MISC + 16777216;
constexpr size_t X_ZA = OFF_X;
constexpr size_t X_XC = X_ZA + (size_t)TOK * 1536 * 2;
constexpr size_t X_LA = X_XC + SZ_TB512;
constexpr size_t X_LU = X_LA + 2 * SZ_TB512;
constexpr size_t X_A5 = X_LU + 2 * SZ_TB512;
constexpr size_t X_LW = OFF_X;
constexpr size_t X_IC = X_LW + 2 * SZ_TB512;
constexpr size_t X_G = X_IC + 2 * SZ_TB512;
constexpr size_t X_YD1 = X_G + SZ_TB512;
constexpr size_t X_LORAA = X_YD1 + SZ_TB512;
constexpr size_t X_PQ = X_LORAA + (size_t)TOK * 384 * 2;
constexpr size_t X_SC = X_PQ + (size_t)16 * 64 * 8192 * 4;
constexpr size_t X_ZG = OFF_X;
constexpr size_t X_ACT = OFF_X;
constexpr size_t W_INZG = X_PQ;
constexpr size_t W_BR = W_INZG + (size_t)3072 * 1024 * 2;
constexpr size_t W_OUT = W_BR + (size_t)3 * 1024 * 512 * 2;
constexpr size_t W_FIN = W_OUT + (size_t)1024 * 1024 * 2;
constexpr size_t W_FOUT = W_FIN + (size_t)5632 * 1024 * 2;
constexpr size_t X_M = W_FOUT + (size_t)1024 * 2816 * 2;
constexpr size_t X_RT = X_SC + (size_t)16 * 64 * 4096 * 4;
constexpr size_t WS_END = X_RT + 2 * SZ_TB512 + 1048576;

struct Params { const float* in[42]; float* out; unsigned char* ws; };

enum { I_X = 0, I_C, I_CTX, I_CCTX, I_WMOD, I_BMOD, I_NORM1, I_NORM2, I_NORMF, I_WIN, I_CONVW, I_CONVB, I_WA, I_BA, I_WX, I_BX, I_LAM,
       I_MU, I_W0, I_W2, I_A0, I_A2, I_G2, I_KK, I_KA, I_RK, I_LNW, I_LNB, I_S5LRE, I_S5LIM, I_S5STEP, I_S5BRE, I_S5BIM, I_S5CRE, I_S5CIM,
       I_S5D, I_WGLU, I_BGLU, I_WBR, I_WOUT, I_WFIN, I_WFOUT };

__device__ __forceinline__ bf16_t f2bf(float f) { unsigned u = __float_as_uint(f); u += 0x7FFFu + ((u >> 16) & 1u); return (bf16_t)(u >> 16); }
__device__ __forceinline__ float bf2f(bf16_t b) { return __uint_as_float(((unsigned)b) << 16); }
typedef __bf16 bf16x2_t __attribute__((ext_vector_type(2)));
typedef float f32x2_t __attribute__((ext_vector_type(2)));
__device__ __forceinline__ unsigned pack2(float a, float b) { f32x2_t v = {a, b}; bf16x2_t r = __builtin_convertvector(v, bf16x2_t); return __builtin_bit_cast(unsigned, r); }
__device__ __forceinline__ void st4bf(bf16_t* p, float a, float b, float c, float d) { u32x2 w; w.x = pack2(a, b); w.y = pack2(c, d); *(u32x2*)p = w; }
__device__ __forceinline__ void ld4bf(const bf16_t* p, float (&o)[4]) { u32x2 w = *(const u32x2*)p; o[0] = __uint_as_float(w.x << 16); o[1] = __uint_as_float(w.x & 0xFFFF0000u); o[2] = __uint_as_float(w.y << 16); o[3] = __uint_as_float(w.y & 0xFFFF0000u); }
__device__ __forceinline__ void ld8bf(const bf16_t* p, float (&o)[8]) { const u32x4 w = *(const u32x4*)p;
    o[0] = __uint_as_float(w.x << 16); o[1] = __uint_as_float(w.x & 0xFFFF0000u); o[2] = __uint_as_float(w.y << 16); o[3] = __uint_as_float(w.y & 0xFFFF0000u);
    o[4] = __uint_as_float(w.z << 16); o[5] = __uint_as_float(w.z & 0xFFFF0000u); o[6] = __uint_as_float(w.w << 16); o[7] = __uint_as_float(w.w & 0xFFFF0000u); }
__device__ __forceinline__ void st8bf(bf16_t* p, const float (&v)[8]) { u32x4 w; w.x = pack2(v[0], v[1]); w.y = pack2(v[2], v[3]); w.z = pack2(v[4], v[5]); w.w = pack2(v[6], v[7]); *(u32x4*)p = w; }
#ifdef OLD_SIGM
__device__ __forceinline__ float sigm(float x) { return 1.0f / (1.0f + __expf(-x)); }
#else
__device__ __forceinline__ float sigm(float x) { return __builtin_amdgcn_rcpf(1.0f + __expf(-x)); }
#endif
__device__ __forceinline__ float softplusf(float x) { return x > 15.f ? x : __logf(1.0f + __expf(x)); }
__device__ __forceinline__ float gelu_t(float x) { float t = tanhf(0.7978845608028654f * (x + 0.044715f * x * x * x)); return 0.5f * x * (1.0f + t); }
__device__ __forceinline__ float silu(float x) { return x * sigm(x); }
__device__ __forceinline__ int tok_of(int dir, int p) { return dir == 0 ? p : (p < 256 ? 255 - p : 16895 - p); }
__device__ __forceinline__ int s5_tok(int p) { if (p < 256) return p; int q = p - 256; return 256 + (q & 255) * 64 + (q >> 8); }
__device__ __forceinline__ float shx(float v, int o, int lane) { return __int_as_float(__builtin_amdgcn_ds_bpermute((lane ^ o) << 2, __float_as_int(v))); }
__device__ __forceinline__ float wave_sum(float v, int lane) {
#pragma unroll
    for (int o = 32; o >= 1; o >>= 1) v += shx(v, o, lane);
    return v;
}
__device__ __forceinline__ float zshift(const bf16_t* ZB, int tk, int col, float mu) {
    const int lo = tk < 256 ? 0 : 256, hi = tk < 256 ? 256 : TOK;
    const float z = bf2f(ZB[(size_t)tk * 2048 + col]);
    const float zp = (tk - 1 >= lo) ? bf2f(ZB[(size_t)(tk - 1) * 2048 + col]) : 0.f;
    const float zn = (tk + 1 < hi) ? bf2f(ZB[(size_t)(tk + 1) * 2048 + col]) : 0.f;
    return z + mu * (0.5f * (zp + zn) - z);
}

constexpr int BM = 256, BK = 64, HALF = 128, HTB = HALF * BK * 2, NXCD = 8, WGM = 8;
__device__ __forceinline__ int lds_byte(int r, int c) { const int st = (r >> 4) * 2 + (c >> 5), rr = r & 15, cc = c & 31, ob = rr * 64 + cc * 2; return st * 1024 + (ob ^ (((ob >> 9) & 1) << 5)); }
__device__ __forceinline__ void stage_rc(int b, int& R, int& C) { const int st = b / 1024, sb = b % 1024, swz = sb ^ (((sb >> 9) & 1) << 5); R = (st >> 1) * 16 + swz / 64; C = (st & 1) * 32 + (swz % 64) / 2; }

struct Unit { int pm, pn, g; };
struct GemmArgs { const bf16_t* A; const bf16_t* Bt; int lda, ldb, K; };

struct StaticOrder {
    int nM, nN, nwg, G, c;
    __device__ void init(int M, int N, int bid_l) { nM = M / BM; nN = N / BM; nwg = nM * nN; G = gridDim.x; c = bid_l; }
    __device__ bool next(int i, Unit& u) const {
        const long L = (long)i * G + c; if (L >= nwg) return false;
        int wgid = (int)L; { const int q = nwg / NXCD, r = nwg % NXCD, xcd = wgid % NXCD, off = wgid / NXCD; wgid = (xcd < r ? xcd * (q + 1) : r * (q + 1) + (xcd - r) * q) + off; }
        const int nig = WGM * nN, gid = wgid / nig, fm = gid * WGM, gsz = (nM - fm) < WGM ? (nM - fm) : WGM;
        u.pm = fm + ((wgid % nig) % gsz); u.pn = (wgid % nig) / gsz; u.g = 0; return true;
    }
    __device__ const char* aptr(const GemmArgs& g, const Unit& u) const { return (const char*)g.A + (size_t)u.pm * 256 * g.lda * 2; }
    __device__ const char* bptr(const GemmArgs& g, const Unit& u) const { return (const char*)g.Bt + (size_t)u.pn * 256 * g.ldb * 2; }
};
struct S5Order {
    int G, c;
    __device__ void init(int shift, int bid_l) { G = gridDim.x; c = (bid_l + shift) % gridDim.x; }
    __device__ bool next(int i, Unit& u) const { const int L = i * G + c; if (L >= 160) return false; u.g = L / 5; u.pm = L % 5; u.pn = 0; return true; }
    __device__ const char* aptr(const GemmArgs& g, const Unit& u) const { return (const char*)g.A + (size_t)(u.g * 1040 + u.pm * 256) * g.lda * 2; }
    __device__ const char* bptr(const GemmArgs& g, const Unit& u) const { return (const char*)g.Bt + (size_t)u.g * 256 * g.ldb * 2; }
};
struct TripleOrder {
    int nM, G, c;
    __device__ void init(int M, int bid_l) { nM = M / BM; G = gridDim.x; c = bid_l; }
    __device__ bool next(int i, Unit& u) const { const int L = (i / 3) * G + c; if (L >= nM * 4) return false; u.pm = L >> 2; u.pn = L & 3; u.g = i % 3; return true; }
    __device__ const char* aptr(const GemmArgs& g, const Unit& u) const { return (const char*)g.A + (size_t)u.g * SZ_TB512 + (size_t)u.pm * 256 * 512 * 2; }
    __device__ const char* bptr(const GemmArgs& g, const Unit& u) const { return (const char*)g.Bt + (size_t)(u.g * 1024 + u.pn * 256) * 512 * 2; }
};

template <class Epi, class Ord>
__device__ __forceinline__ void gemm_phase(LAS unsigned char* lds, const GemmArgs g, const Ord& S, const Epi& E, int tid_l) {
    const int tid = tid_l, wid = __builtin_amdgcn_readfirstlane(tid >> 6), lane = tid & 63, wr = wid >> 2, wc = wid & 3, fr = lane & 15, fq = lane >> 4;
    const int K = g.K, nt = K / BK;
    unsigned voffA, voffB;
    { int R, C; stage_rc(tid * 16, R, C); voffA = (unsigned)(R * g.lda + C) * 2u; voffB = (unsigned)(R * g.ldb + C) * 2u; }
    const size_t p64A = (size_t)64 * g.lda * 2, p64B = (size_t)64 * g.ldb * 2;
    const size_t kstep = (size_t)(BK * 2);
    const size_t hstepA = (size_t)HALF * g.lda * 2, hstepB = (size_t)HALF * g.ldb * 2;
    const unsigned ldsw = (unsigned)wid * 1024u;
    const int aoff = lds_byte(wr * 64 + fr, fq * 8), boff = lds_byte(wc * 32 + fr, fq * 8);
#define PG8_SA(b, h) (((b) * 2 + (h)) * HTB)
#define PG8_SB(b, h) ((4 + (b) * 2 + (h)) * HTB)
#define PG8_STAGE(bufoff, gbase, voff) do { _Pragma("unroll") for (int _i = 0; _i < 2; ++_i) \
        __builtin_amdgcn_global_load_lds((const unsigned*)((const char*)(gbase) + _i * p64_##voff + v_##voff), (LAS unsigned*)(lds + (bufoff) + ldsw + _i * 8192), 16, 0, 0); } while (0)
#define PG8_LDA(dst, b, h) do { _Pragma("unroll") for (int m = 0; m < 4; ++m) _Pragma("unroll") for (int k = 0; k < 2; ++k) dst[m][k] = *(const LAS bf16x8*)(lds + PG8_SA(b, h) + aoff + m * 2048 + k * 1024); } while (0)
#define PG8_LDB(dst, b, h) do { _Pragma("unroll") for (int n = 0; n < 2; ++n) _Pragma("unroll") for (int k = 0; k < 2; ++k) dst[n][k] = *(const LAS bf16x8*)(lds + PG8_SB(b, h) + boff + n * 2048 + k * 1024); } while (0)
#define PG8_MMA(ai, bj, At, Bt) do { __builtin_amdgcn_s_setprio(1); _Pragma("unroll") for (int m = 0; m < 4; ++m) _Pragma("unroll") for (int n = 0; n < 2; ++n) _Pragma("unroll") for (int k = 0; k < 2; ++k) \
        acc[ai][bj][m][n] = __builtin_amdgcn_mfma_f32_16x16x32_bf16(Bt[n][k], At[m][k], acc[ai][bj][m][n], 0, 0, 0); __builtin_amdgcn_s_setprio(0); } while (0)
#define p64_offA p64A
#define p64_offB p64B
#define v_offA voffA
#define v_offB voffB
#define PG8_WAIT_V(n) asm volatile("s_waitcnt vmcnt(" #n ")" ::: "memory")
#define PG8_WAIT_L(n) asm volatile("s_waitcnt lgkmcnt(" #n ")" ::: "memory")
#define PG8_BAR __builtin_amdgcn_s_barrier()
#define PG8_SCHED __builtin_amdgcn_sched_barrier(0)
    Unit cur, nxt; int ui = 0;
    if (!S.next(0, cur)) return;
    f32x4 acc[2][2][4][2];
#pragma unroll
    for (int a = 0; a < 2; ++a)
#pragma unroll
        for (int b = 0; b < 2; ++b)
#pragma unroll
            for (int m = 0; m < 4; ++m)
#pragma unroll
                for (int n = 0; n < 2; ++n) acc[a][b][m][n] = (f32x4){0.f, 0.f, 0.f, 0.f};
    bf16x8 At[4][2], B0[2][2], B1[2][2];
    const char* cA = S.aptr(g, cur); const char* cB = S.bptr(g, cur);
    PG8_STAGE(PG8_SB(0, 0), cB, offB); PG8_STAGE(PG8_SA(0, 0), cA, offA); PG8_STAGE(PG8_SB(0, 1), cB + hstepB, offB); PG8_STAGE(PG8_SA(0, 1), cA + hstepA, offA);
    if (wr == 1) PG8_BAR;
    PG8_WAIT_V(4); PG8_BAR;
    PG8_STAGE(PG8_SB(1, 0), cB + kstep, offB); PG8_STAGE(PG8_SA(1, 0), cA + kstep, offA); PG8_STAGE(PG8_SB(1, 1), cB + hstepB + kstep, offB);
    PG8_WAIT_V(6); PG8_BAR;
    for (;;) {
        const bool has_next = S.next(ui + 1, nxt);
        const char* nA = has_next ? S.aptr(g, nxt) : cA; const char* nB = has_next ? S.bptr(g, nxt) : cB;
        for (int t = 0; t < nt; t += 2) {
            const bool last = (t == nt - 2);
            const char* a1 = cA + (size_t)(t + 1) * kstep;
            const char* a2 = last ? nA : cA + (size_t)(t + 2) * kstep; const char* b2 = last ? nB : cB + (size_t)(t + 2) * kstep;
            const char* a3 = a2 + kstep; const char* b3 = b2 + kstep;
            PG8_LDB(B0, 0, 0); PG8_SCHED; PG8_LDA(At, 0, 0); PG8_STAGE(PG8_SA(1, 1), a1 + hstepA, offA);
            PG8_WAIT_L(8); PG8_BAR; PG8_WAIT_L(0); PG8_MMA(0, 0, At, B0); PG8_BAR; PG8_SCHED;
            PG8_LDB(B1, 0, 1); PG8_STAGE(PG8_SB(0, 0), b2, offB);
            PG8_BAR; PG8_WAIT_L(0); PG8_MMA(0, 1, At, B1); PG8_BAR;
            PG8_LDA(At, 0, 1); PG8_STAGE(PG8_SA(0, 0), a2, offA);
            PG8_BAR; PG8_WAIT_L(0); PG8_MMA(1, 0, At, B0); PG8_BAR; PG8_SCHED;
            PG8_STAGE(PG8_SB(0, 1), b2 + hstepB, offB);
            PG8_WAIT_V(6); PG8_BAR; PG8_MMA(1, 1, At, B1); PG8_BAR;
            PG8_LDB(B0, 1, 0); PG8_SCHED; PG8_LDA(At, 1, 0); PG8_STAGE(PG8_SA(0, 1), a2 + hstepA, offA);
            PG8_WAIT_L(8); PG8_BAR; PG8_WAIT_L(0); PG8_MMA(0, 0, At, B0); PG8_BAR; PG8_SCHED;
            PG8_LDB(B1, 1, 1); PG8_STAGE(PG8_SB(1, 0), b3, offB);
            PG8_BAR; PG8_WAIT_L(0); PG8_MMA(0, 1, At, B1); PG8_BAR;
            PG8_LDA(At, 1, 1); PG8_STAGE(PG8_SA(1, 0), a3, offA);
            PG8_BAR; PG8_WAIT_L(0); PG8_MMA(1, 0, At, B0); PG8_BAR; PG8_SCHED;
            PG8_STAGE(PG8_SB(1, 1), b3 + hstepB, offB);
            PG8_WAIT_V(6); PG8_BAR; PG8_MMA(1, 1, At, B1); PG8_BAR;
        }
        E(acc, cur, wr, wc, fr, fq);
        if (!has_next) break;
#pragma unroll
        for (int a = 0; a < 2; ++a)
#pragma unroll
            for (int b = 0; b < 2; ++b)
#pragma unroll
                for (int m = 0; m < 4; ++m)
#pragma unroll
                    for (int n = 0; n < 2; ++n) acc[a][b][m][n] = (f32x4){0.f, 0.f, 0.f, 0.f};
        cur = nxt; cA = nA; cB = nB; ++ui;
    }
    PG8_WAIT_V(0);
    if (wr == 0) PG8_BAR;
    PG8_BAR;
#undef p64_offA
#undef p64_offB
#undef v_offA
#undef v_offB
#undef PG8_SA
#undef PG8_SB
#undef PG8_STAGE
#undef PG8_LDA
#undef PG8_LDB
#undef PG8_MMA
#undef PG8_WAIT_V
#undef PG8_WAIT_L
#undef PG8_BAR
#undef PG8_SCHED
}

typedef f32x4 AccT[2][2][4][2];
#define EPI_ROWS _Pragma("unroll") for (int ai = 0; ai < 2; ++ai) _Pragma("unroll") for (int m = 0; m < 4; ++m)
#define EPI_BN _Pragma("unroll") for (int bj = 0; bj < 2; ++bj) _Pragma("unroll") for (int n = 0; n < 2; ++n)
#define EPI_B _Pragma("unroll") for (int bj = 0; bj < 2; ++bj)

#define EPI_ROW (__builtin_amdgcn_sched_barrier(0), u.pm * 256 + ai * 128 + wr * 64 + m * 16 + fr)
#define EPI_COL(bj, n) (u.pn * 256 + (bj) * 128 + wc * 32 + (n) * 16 + 4 * fq)

struct EpiZ {
    bf16_t* ZA; bf16_t* ZB;
    __device__ __forceinline__ void operator()(const AccT& acc, const Unit& u, int wr, int wc, int fr, int fq) const {
        EPI_ROWS { const int row = EPI_ROW;
            EPI_BN { const int col = EPI_COL(bj, n); const f32x4 v = acc[ai][bj][m][n];
                bf16_t* dst = col < 1536 ? ZA + (size_t)row * 1536 + col : ZB + (size_t)row * 2048 + (col - 1536);
                st4bf(dst, v[0], v[1], v[2], v[3]); } }
    }
};
struct EpiLruGate {
    const bf16_t* XC; bf16_t* LA; bf16_t* LU; const float* ba; const float* bx; const float* lam;
    __device__ __forceinline__ void operator()(const AccT& acc, const Unit& u, int wr, int wc, int fr, int fq) const {
        EPI_B { __builtin_amdgcn_sched_barrier(0);
            const int g32 = (u.pn * 256 + bj * 128 + wc * 32) >> 5, dir = g32 >> 5, ch = (g32 & 31) * 16 + 4 * fq;
            float pba[4], pbx[4], psp[4];
            UNR for (int j = 0; j < 4; ++j) { const int c = dir * 512 + ch + j; pba[j] = ba[c]; pbx[j] = bx[c]; psp[j] = -8.0f * softplusf(-lam[c]); }
            EPI_ROWS { const int row = EPI_ROW;
                const f32x4 va = acc[ai][bj][m][0], vx = acc[ai][bj][m][1];
                float xc[4]; ld4bf(XC + (size_t)row * 512 + ch, xc);
                float la[4], uu[4];
                UNR for (int j = 0; j < 4; ++j) {
                    const float gr = sigm(va[j] + pba[j]), gi = sigm(vx[j] + pbx[j]);
                    la[j] = gr * psp[j];
                    uu[j] = __fsqrt_rn(fmaxf(1.0f - __expf(2.0f * la[j]), 0.f)) * gi * xc[j]; }
                const size_t o = ((size_t)dir * TOK + row) * 512 + ch;
                st4bf(LA + o, la[0], la[1], la[2], la[3]); st4bf(LU + o, uu[0], uu[1], uu[2], uu[3]); } }
    }
};
struct EpiS5E {
    float* E;
    __device__ __forceinline__ void operator()(const AccT& acc, const Unit& u, int wr, int wc, int fr, int fq) const {
        EPI_ROWS { const int row = EPI_ROW; if (row < 1040) {
            EPI_BN { const int col = EPI_COL(bj, n);
                *(f32x4*)(E + ((size_t)u.g * 1040 + row) * 256 + col) = acc[ai][bj][m][n]; } } }
    }
};
struct EpiS5Y {
    const bf16_t* ZA; bf16_t* YG; const float* dsk;
    __device__ __forceinline__ void operator()(const AccT& acc, const Unit& u, int wr, int wc, int fr, int fq) const {
        EPI_ROWS { const int row = EPI_ROW; if (row < 1040) {
            EPI_BN { const int col = EPI_COL(bj, n); const f32x4 v = acc[ai][bj][m][n];
                const int t = col >> 4, cp = col & 15, tk = s5_tok(row * 16 + t), ch = u.g * 16 + cp;
                float uv[4]; ld4bf(ZA + (size_t)tk * 1536 + 1024 + ch, uv);
                float y[4]; UNR for (int j = 0; j < 4; ++j) y[j] = gelu_t(v[j] + dsk[ch + j] * uv[j]);
                st4bf(YG + (size_t)tk * 512 + ch, y[0], y[1], y[2], y[3]); } } }
    }
};
struct EpiGlu {
    const bf16_t* YG; bf16_t* YC; const float* bg;
    __device__ __forceinline__ void operator()(const AccT& acc, const Unit& u, int wr, int wc, int fr, int fq) const {
        EPI_ROWS { const int row = EPI_ROW;
            EPI_BN { const int col = EPI_COL(bj, n); const f32x4 v = acc[ai][bj][m][n];
                float y[4]; ld4bf(YG + (size_t)row * 512 + col, y);
                UNR for (int j = 0; j < 4; ++j) y[j] *= sigm(v[j] + bg[col + j]);
                st4bf(YC + (size_t)row * 512 + col, y[0], y[1], y[2], y[3]); } }
    }
};
struct EpiLora {
    bf16_t* LW; bf16_t* IC; bf16_t* G; const float* w0; const float* a0;
    __device__ __forceinline__ void operator()(const AccT& acc, const Unit& u, int wr, int wc, int fr, int fq) const {
        const int blk = u.pn >> 1;
        if (blk < 2) {
            EPI_BN { __builtin_amdgcn_sched_barrier(0); const int col = EPI_COL(bj, n); float b[4];
                UNR for (int j = 0; j < 4; ++j) b[j] = w0[col + j];
                EPI_ROWS { const int row = EPI_ROW; const f32x4 v = acc[ai][bj][m][n]; float o[4];
                    UNR for (int j = 0; j < 4; ++j) { const float wl = -softplusf(-(b[j] + v[j])) - 0.5f; o[j] = -__expf(wl); }
                    st4bf(LW + ((size_t)blk * TOK + row) * 512 + (col & 511), o[0], o[1], o[2], o[3]); } }
        } else if (blk < 4) {
            EPI_BN { __builtin_amdgcn_sched_barrier(0); const int col = EPI_COL(bj, n) - 1024; float b[4];
                UNR for (int j = 0; j < 4; ++j) b[j] = a0[col + j];
                EPI_ROWS { const int row = EPI_ROW; const f32x4 v = acc[ai][bj][m][n]; float o[4];
                    UNR for (int j = 0; j < 4; ++j) o[j] = sigm(b[j] + v[j]);
                    st4bf(IC + ((size_t)(blk - 2) * TOK + row) * 512 + (col & 511), o[0], o[1], o[2], o[3]); } }
        } else {
            EPI_ROWS { const int row = EPI_ROW;
                EPI_BN { const int col = EPI_COL(bj, n) - 2048; const f32x4 v = acc[ai][bj][m][n];
                    st4bf(G + (size_t)row * 512 + col, v[0], v[1], v[2], v[3]); } }
        }
    }
};
struct EpiZg {
    bf16_t* ZG; int row0;
    __device__ __forceinline__ void operator()(const AccT& acc, const Unit& u, int wr, int wc, int fr, int fq) const {
        EPI_ROWS { const int row = row0 + EPI_ROW;
            EPI_BN { const int col = EPI_COL(bj, n); const f32x4 v = acc[ai][bj][m][n];
                st4bf(ZG + (size_t)row * 3072 + col, sigm(v[0]), sigm(v[1]), sigm(v[2]), sigm(v[3])); } }
    }
};
struct EpiMerge1 {
    const bf16_t* ZG; bf16_t* M; int row0;
    __device__ __forceinline__ void operator()(const AccT& acc, const Unit& u, int wr, int wc, int fr, int fq) const {
        EPI_ROWS { const int row = row0 + EPI_ROW;
            EPI_BN { const int col = EPI_COL(bj, n); const f32x4 v = acc[ai][bj][m][n];
                float gt[4]; ld4bf(ZG + (size_t)row * 3072 + u.g * 1024 + col, gt);
                float mv[4] = {0.f, 0.f, 0.f, 0.f}; if (u.g) ld4bf(M + (size_t)row * 1024 + col, mv);
                st4bf(M + (size_t)row * 1024 + col, mv[0] + gt[0] * v[0], mv[1] + gt[1] * v[1], mv[2] + gt[2] * v[2], mv[3] + gt[3] * v[3]); } }
    }
};
struct EpiRes {
    float* H; const float* gl; const float* gc; int row0;
    __device__ __forceinline__ void operator()(const AccT& acc, const Unit& u, int wr, int wc, int fr, int fq) const {
        EPI_ROWS { const int row = row0 + EPI_ROW; const float* gv = row < 256 ? gc : gl;
            EPI_BN { const int col = EPI_COL(bj, n); const f32x4 v = acc[ai][bj][m][n];
                float* hp = H + (size_t)row * 1024 + col; f32x4 hv = *(f32x4*)hp; const f32x4 gg = *(const f32x4*)(gv + col);
                hv += gg * v; *(f32x4*)hp = hv; } }
    }
};
struct EpiFfn {
    bf16_t* ACT; int row0;
    __device__ __forceinline__ void operator()(const AccT& acc, const Unit& u, int wr, int wc, int fr, int fq) const {
        EPI_ROWS { const int row = row0 + EPI_ROW;
            EPI_B { const int g32 = (u.pn * 256 + bj * 128 + wc * 32) >> 5, oc = g32 * 16 + 4 * fq;
                const f32x4 g = acc[ai][bj][m][0], up = acc[ai][bj][m][1];
                st4bf(ACT + (size_t)row * 2816 + oc, silu(g[0]) * up[0], silu(g[1]) * up[1], silu(g[2]) * up[2], silu(g[3]) * up[3]); } }
    }
};

template <class Map>
__device__ __forceinline__ void conv_T(const float* src, int src_ld, bf16_t* dst, int Nd, int K, Map map, float* sm, int shift, int tid_l, int bid_l) {
    const int tk = K / 64, ntile = (Nd / 64) * tk;
    for (int t = (bid_l + shift) % gridDim.x; t < ntile; t += gridDim.x) {
        const int n0 = (t / tk) * 64, k0 = (t % tk) * 64;
        { const int n = tid_l & 63, kq = tid_l >> 6; const int col = map(n0 + n);
            for (int e = 0; e < 8; ++e) { const int k = e * 8 + kq; sm[k * 65 + n] = col >= 0 ? src[(size_t)(k0 + k) * src_ld + col] : 0.f; } }
        __syncthreads();
        { const int k = tid_l & 63, nq = tid_l >> 6;
            for (int e = 0; e < 8; ++e) { const int n2 = e * 8 + nq; dst[(size_t)(n0 + n2) * K + k0 + k] = f2bf(sm[k * 65 + n2]); } }
        __syncthreads();
    }
}
struct MapIna { __device__ int operator()(int n) const { return n < 1024 ? n : (n < 1536 ? 2944 + (n - 1024) : (n < 3456 ? 1024 + (n - 1536) : -1)); } };
struct MapOff { int off; __device__ int operator()(int n) const { return off + n; } };
struct MapFfn { __device__ int operator()(int n) const { const int g32 = n >> 5, w = n & 31; return w < 16 ? g32 * 16 + w : 2816 + g32 * 16 + (w - 16); } };

__device__ __forceinline__ void norm_rows(const float* H, const float* nw, const float* modl, const float* modc, int shoff, int scoff, bf16_t* HN, int row_begin, int tid_l, int bid_l) {
    const int wid = tid_l >> 6, lane = tid_l & 63;
    for (int row = row_begin + bid_l * 8 + wid; row < TOK; row += gridDim.x * 8) {
        const float* hp = H + (size_t)row * 1024; const float* mv = row < 256 ? modc : modl;
        f32x4 x[4]; float ss = 0.f;
        UNR for (int e = 0; e < 4; ++e) { x[e] = *(const f32x4*)(hp + e * 256 + lane * 4); ss += x[e][0] * x[e][0] + x[e][1] * x[e][1] + x[e][2] * x[e][2] + x[e][3] * x[e][3]; }
        ss = wave_sum(ss, lane); const float sc = rsqrtf(ss * (1.0f / 1024.0f) + 1e-6f);
        UNR for (int e = 0; e < 4; ++e) { const int c = e * 256 + lane * 4; float y[4];
            UNR for (int j = 0; j < 4; ++j) y[j] = x[e][j] * sc * nw[c + j] * (1.0f + mv[scoff + c + j]) + mv[shoff + c + j];
            st4bf(HN + (size_t)row * 1024 + c, y[0], y[1], y[2], y[3]); }
    }
}

typedef float f32x2 __attribute__((ext_vector_type(2)));
__device__ __forceinline__ float quad_sum(float v) {
    v += __int_as_float(__builtin_amdgcn_mov_dpp(__float_as_int(v), 0xB1, 0xF, 0xF, true));
    v += __int_as_float(__builtin_amdgcn_mov_dpp(__float_as_int(v), 0x4E, 0xF, 0xF, true));
    return v;
}
constexpr int WCH = 260, WNC = 64, WSC = 13, WVEC = 6 * 64;
template <int R, bool WITH_Y>
__device__ __forceinline__ void wkv_steps(f32x2 (&s)[R][8], const float* stg, float* sy, int sys, int nst, int row0, bool hasv, int sub) {
    for (int jj = 0; jj < nst; ++jj) {
        const float* base = stg + jj * WVEC + sub * 16;
        f32x2 kk[8];
#pragma unroll
        for (int i = 0; i < 4; ++i) { const f32x4 t = *(const f32x4*)(base + 64 + i * 4); kk[2 * i] = (f32x2){t[0], t[1]}; kk[2 * i + 1] = (f32x2){t[2], t[3]}; }
        float nsa[R], vv[R];
#pragma unroll
        for (int r = 0; r < R; ++r) { f32x2 a = s[r][0] * kk[0];
#pragma unroll
            for (int i = 1; i < 8; ++i) a = __builtin_elementwise_fma(s[r][i], kk[i], a);
            nsa[r] = -quad_sum(a[0] + a[1]); vv[r] = hasv ? stg[jj * WVEC + 320 + row0 + r] : 0.f; }
        f32x2 w[8], bb[8], kd[8];
#pragma unroll
        for (int i = 0; i < 4; ++i) { const f32x4 t0 = *(const f32x4*)(base + i * 4), t1 = *(const f32x4*)(base + 128 + i * 4), t2 = *(const f32x4*)(base + 192 + i * 4);
            w[2 * i] = (f32x2){t0[0], t0[1]}; w[2 * i + 1] = (f32x2){t0[2], t0[3]}; bb[2 * i] = (f32x2){t1[0], t1[1]}; bb[2 * i + 1] = (f32x2){t1[2], t1[3]};
            kd[2 * i] = (f32x2){t2[0], t2[1]}; kd[2 * i + 1] = (f32x2){t2[2], t2[3]}; }
#pragma unroll
        for (int r = 0; r < R; ++r) { const f32x2 v2 = (f32x2){vv[r], vv[r]}, n2 = (f32x2){nsa[r], nsa[r]};
#pragma unroll
            for (int i = 0; i < 8; ++i) { const f32x2 t = __builtin_elementwise_fma(n2, bb[i], v2 * kd[i]); s[r][i] = __builtin_elementwise_fma(s[r][i], w[i], t); } }
        if (WITH_Y) {
            f32x2 rr[8];
#pragma unroll
            for (int i = 0; i < 4; ++i) { const f32x4 t = *(const f32x4*)(base + 256 + i * 4); rr[2 * i] = (f32x2){t[0], t[1]}; rr[2 * i + 1] = (f32x2){t[2], t[3]}; }
#pragma unroll
            for (int r = 0; r < R; ++r) { f32x2 a = s[r][0] * rr[0];
#pragma unroll
                for (int i = 1; i < 8; ++i) a = __builtin_elementwise_fma(s[r][i], rr[i], a);
                const float y = quad_sum(a[0] + a[1]); if (sub == 0) sy[jj * sys + row0 + r] = y; }
        }
    }
}
__device__ __forceinline__ void wkv_stage_all(float* smem, const bf16_t* ZBp, const bf16_t* LWp, const bf16_t* ICp, float mur, float muk, float muv, float kkwv, float kawv,
                                              int dir, int head, int c0, int sc, int wd, int ln) {
    const int col = head * 64 + ln;
    float zr[7][3], zk[7][3], zv[7][3], lwv[7], icv[7];
#pragma unroll
    for (int it = 0; it < 7; ++it) { const int pr = wd + it * 8;
        if (pr < 4 * WSC) { const int qq = pr / WSC, jj = pr % WSC, tk = tok_of(dir, (c0 + qq) * WCH + sc * WSC + jj);
            const int lo = tk < 256 ? 0 : 256, hi = tk < 256 ? 256 : TOK; const bool hp = tk - 1 >= lo, hn = tk + 1 < hi;
            const bf16_t* z0 = ZBp + (size_t)tk * 2048 + col;
            zr[it][1] = bf2f(z0[0]); zk[it][1] = bf2f(z0[512]); zv[it][1] = bf2f(z0[1024]);
            zr[it][0] = hp ? bf2f(z0[-2048]) : 0.f; zk[it][0] = hp ? bf2f(z0[-2048 + 512]) : 0.f; zv[it][0] = hp ? bf2f(z0[-2048 + 1024]) : 0.f;
            zr[it][2] = hn ? bf2f(z0[2048]) : 0.f; zk[it][2] = hn ? bf2f(z0[2048 + 512]) : 0.f; zv[it][2] = hn ? bf2f(z0[2048 + 1024]) : 0.f;
            const size_t o = ((size_t)dir * TOK + tk) * 512 + col; lwv[it] = bf2f(LWp[o]); icv[it] = bf2f(ICp[o]); } }
#pragma unroll
    for (int it = 0; it < 7; ++it) { const int pr = wd + it * 8;
        if (pr < 4 * WSC) { float* dst = smem + pr * WVEC;
            const float r = zr[it][1] + mur * (0.5f * (zr[it][0] + zr[it][2]) - zr[it][1]);
            const float k = zk[it][1] + muk * (0.5f * (zk[it][0] + zk[it][2]) - zk[it][1]);
            const float v = zv[it][1] + muv * (0.5f * (zv[it][0] + zv[it][2]) - zv[it][1]);
            const float kx = k * kkwv; const float ssq = wave_sum(kx * kx, ln); const float kk = kx * rsqrtf(ssq + 1e-12f);
            const float w = __expf(lwv[it]), ic = icv[it];
            dst[ln] = w; dst[64 + ln] = kk; dst[128 + ln] = kk * ic; dst[192 + ln] = k * (1.0f + (ic - 1.0f) * kawv); dst[256 + ln] = r; dst[320 + ln] = v; } }
}

__device__ __forceinline__ int launder_s(int i) { asm volatile("" : "+s"(i)); return i; }
#define IN(i) (p.in[launder_s(i)])
constexpr int PH_PER_LAYER = 19;
constexpr int NPHASE = 1 + NLAYER * PH_PER_LAYER + 1;

#define ZA ((bf16_t*)(ws + X_ZA))
#define ZB ((bf16_t*)(ws + OFF_ZB))
#define XC ((bf16_t*)(ws + X_XC))
#define LA ((bf16_t*)(ws + X_LA))
#define LU ((bf16_t*)(ws + X_LU))
#define A5 ((bf16_t*)(ws + X_A5))
#define YS ((bf16_t*)(ws + OFF_YS))
#define YA YS
#define YB (YS + (size_t)TOK * 512)
#define YC (YS + (size_t)2 * TOK * 512)
#define S5E ((float*)(ws + OFF_HN))
#define CA ((float*)(ws + M_CA))
#define CB ((float*)(ws + M_CB))
#define HIN ((float*)(ws + M_HIN))
#define LW ((bf16_t*)(ws + X_LW))
#define IC ((bf16_t*)(ws + X_IC))
#define GG ((bf16_t*)(ws + X_G))
#define YD1 ((bf16_t*)(ws + X_YD1))
#define LORAA ((bf16_t*)(ws + X_LORAA))
#define PQ ((float*)(ws + X_PQ))
#define SCS ((float*)(ws + X_SC))
#define RT ((bf16_t*)(ws + X_RT))
#define ZG ((bf16_t*)(ws + X_ZG))
#define ACT ((bf16_t*)(ws + X_ACT))
#define MM ((bf16_t*)(ws + X_M))
template <int KSEL>
__device__ __forceinline__ void run_phase(const Params& p, int ph, unsigned char* shm, int wv) {
    unsigned char* ws = p.ws;
    float* sm = (float*)shm;
    LAS unsigned char* lds = (LAS unsigned char*)shm;
#ifdef TID_MBCNT
    int tid; asm volatile("v_mbcnt_lo_u32_b32 %0, -1, 0\n\tv_mbcnt_hi_u32_b32 %0, -1, %0" : "=v"(tid)); tid += wv * 64;
#else
    int tid = threadIdx.x; asm volatile("" : "+v"(tid)); (void)wv;
#endif
    int bid = blockIdx.x; asm volatile("" : "+s"(bid));
#define wid (tid >> 6)
#define lane (tid & 63)
#define gtid ((size_t)bid * NTHR + tid)
#define gthreads ((size_t)gridDim.x * NTHR)
    float* H = (float*)(ws + OFF_H);
    bf16_t* HN = (bf16_t*)(ws + OFF_HN);
    float* MODV = (float*)(ws + M_MODV);
    float* PW = (float*)(ws + M_PW);
    float* BBT = (float*)(ws + M_BB);

    if (KSEL == 100 && ph != 0) return;
    if (KSEL == 101 && ph != NPHASE - 1) return;
    if (KSEL >= 0 && KSEL < 100 && (ph == 0 || ph == NPHASE - 1)) return;
    if (ph == 0) {
        for (int vb = bid; vb < 48 + 32 + 512; vb += gridDim.x) {
            if (vb < 48) {
                __syncthreads();
                for (int k = tid; k < 1024; k += NTHR) { sm[k] = silu(IN(I_C)[k]); sm[1024 + k] = silu(IN(I_CCTX)[k]); }
                __syncthreads();
                const int idx = vb * NTHR + tid, layer = idx / 6144, n = idx % 6144;
                const float* w = IN(I_WMOD) + (size_t)layer * 1024 * 6144 + n;
                float al = 0.f, ac = 0.f;
                for (int k = 0; k < 1024; ++k) { const float wv = w[(size_t)k * 6144]; al += sm[k] * wv; ac += sm[1024 + k] * wv; }
                const float b = IN(I_BMOD)[layer * 6144 + n];
                MODV[(layer * 2 + 0) * 6144 + n] = al + b; MODV[(layer * 2 + 1) * 6144 + n] = ac + b;
            } else if (vb < 80) {
                const int idx = (vb - 48) * NTHR + tid;
                const int pp = idx & 63, g = (idx >> 6) & 31, ld = idx >> 11;
                const float lre = IN(I_S5LRE)[idx], lim = IN(I_S5LIM)[idx], step = __expf(IN(I_S5STEP)[ld * 32 + g]);
                const float xr = lre * step, ang = lim * step;
                for (int t = 0; t <= 16; ++t) { const float mg = expf(xr * t); PW[((size_t)idx * 17 + t) * 2] = mg * cosf(ang * t); PW[((size_t)idx * 17 + t) * 2 + 1] = mg * sinf(ang * t); }
                const float mg = expf(xr), lbim = mg * sinf(ang), sh = sinf(0.5f * ang);
                const float nr = expm1f(xr) * cosf(ang) - 2.0f * sh * sh, den = lre * lre + lim * lim;
                const float fre = (nr * lre + lbim * lim) / den, fim = (lbim * lre - nr * lim) / den;
                for (int c = 0; c < 16; ++c) { const float br = IN(I_S5BRE)[(size_t)idx * 16 + c], bi = IN(I_S5BIM)[(size_t)idx * 16 + c];
                    BBT[((size_t)idx * 16 + c) * 2] = fre * br - fim * bi; BBT[((size_t)idx * 16 + c) * 2 + 1] = fre * bi + fim * br; }
                (void)pp;
            } else {
                const int cb = vb - 80;
                for (size_t i = (size_t)cb * NTHR + tid; i < (size_t)TOK * 256; i += (size_t)512 * NTHR) {
                    const f32x4 v = i < (size_t)256 * 256 ? ((const f32x4*)IN(I_CTX))[i] : ((const f32x4*)IN(I_X))[i - (size_t)256 * 256];
                    ((f32x4*)H)[i] = v; }
            }
        }
        return;
    }
    if (ph == NPHASE - 1) {
        const float* nw = IN(I_NORMF);
        for (int row = 256 + bid * 8 + wid; row < TOK; row += gridDim.x * 8) {
            const float* hp = H + (size_t)row * 1024; f32x4 x[4]; float ss = 0.f;
            UNR for (int e = 0; e < 4; ++e) { x[e] = *(const f32x4*)(hp + e * 256 + lane * 4); ss += x[e][0] * x[e][0] + x[e][1] * x[e][1] + x[e][2] * x[e][2] + x[e][3] * x[e][3]; }
            ss = wave_sum(ss, lane); const float sc = rsqrtf(ss * (1.0f / 1024.0f) + 1e-6f);
            UNR for (int e = 0; e < 4; ++e) { const int c = e * 256 + lane * 4; f32x4 y; UNR for (int j = 0; j < 4; ++j) y[j] = x[e][j] * sc * nw[c + j];
                *(f32x4*)(p.out + (size_t)(row - 256) * 1024 + c) = y; }
        }
        return;
    }
    const int L = (ph - 1) / PH_PER_LAYER, k = (ph - 1) % PH_PER_LAYER;
    const bool last = (L == NLAYER - 1);
    const float* modl = MODV + (L * 2 + 0) * 6144; const float* modc = MODV + (L * 2 + 1) * 6144;
    const int row0 = last ? 256 : 0, Mrows = last ? 16384 : TOK;

    if (KSEL >= 0 && k != KSEL) return;
    switch (k) {
    case 0: {
        conv_T(IN(I_WIN) + (size_t)L * 1024 * 6528, 6528, (bf16_t*)(ws + W_INA), 3584, 1024, MapIna(), sm, 0, tid, bid);
        conv_T(IN(I_WGLU) + (size_t)L * 512 * 512, 512, (bf16_t*)(ws + W_GLU), 512, 512, MapOff{0}, sm, 128, tid, bid);
        {
            bf16_t* W = (bf16_t*)(ws + W_LRU); const float* pwa = IN(I_WA); const float* pwx = IN(I_WX);
            for (size_t i = gtid; i < (size_t)2048 * 512; i += gthreads) { const int n = (int)(i >> 9), kk = (int)(i & 511);
                const int g32 = n >> 5, which = (n & 31) >> 4, dir = g32 >> 5, ch = (g32 & 31) * 16 + (n & 15), head = ch >> 6, j = ch & 63;
                float v = 0.f; if ((kk >> 6) == head) v = (which ? pwx : pwa)[((((size_t)L * 2 + dir) * 8 + head) * 64 + (kk & 63)) * 64 + j];
                W[i] = f2bf(v); }
        }
        {
            bf16_t* W = (bf16_t*)(ws + W_LORA);
            for (size_t i = gtid; i < (size_t)2560 * 384; i += gthreads) { const int n = (int)(i / 384), kk = (int)(i % 384);
                const int blk = n >> 9, ch = n & 511; float v = 0.f;
                if (blk < 2) { if ((kk >> 6) == blk) v = IN(I_W2)[(((size_t)L * 2 + blk) * 64 + (kk & 63)) * 512 + ch]; }
                else if (blk < 4) { if ((kk >> 6) == blk) v = IN(I_A2)[(((size_t)L * 2 + (blk - 2)) * 64 + (kk & 63)) * 512 + ch]; }
                else { if (kk >= 256) v = IN(I_G2)[((size_t)L * 128 + (kk - 256)) * 512 + ch]; }
                W[i] = f2bf(v); }
        }
        {
            float* KT = (float*)(ws + M_KT);
            const float* cre = IN(I_S5CRE) + (size_t)L * 2 * 32 * 16 * 64; const float* cim = IN(I_S5CIM) + (size_t)L * 2 * 32 * 16 * 64;
            const float* pw = PW + (size_t)L * 2 * 32 * 64 * 17 * 2; const float* bb = BBT + (size_t)L * 2 * 32 * 64 * 16 * 2;
            for (size_t i = gtid; i < (size_t)2 * 32 * 16 * 256; i += gthreads) {
                const int c = (int)(i & 15), cp = (int)((i >> 4) & 15), tau = (int)((i >> 8) & 15), dg = (int)(i >> 12);
                const float* cr = cre + ((size_t)dg * 16 + cp) * 64; const float* ci = cim + ((size_t)dg * 16 + cp) * 64;
                const float* pwd = pw + (size_t)dg * 64 * 34 + tau * 2; const float* bbd = bb + (size_t)dg * 64 * 32 + c * 2;
                float v = 0.f;
#pragma unroll 8
                for (int pp = 0; pp < 64; ++pp) { const float pr = pwd[pp * 34], pi = pwd[pp * 34 + 1], br = bbd[pp * 32], bi = bbd[pp * 32 + 1];
                    v += cr[pp] * (pr * br - pi * bi) - ci[pp] * (pr * bi + pi * br); }
                KT[i] = v; }
        }
        norm_rows(H, IN(I_NORM1) + L * 1024, modl, modc, 0, 1024, HN, 0, tid, bid);
    } break;
    case 1: {
        GemmArgs g{HN, (const bf16_t*)(ws + W_INA), 1024, 1024, 1024}; StaticOrder S; S.init(TOK, 3584, bid);
        gemm_phase(lds, g, S, EpiZ{ZA, ZB}, tid);
    } break;
    case 2: {
        const float* cw = IN(I_CONVW) + L * 2048; const float* cb = IN(I_CONVB) + L * 512;
        { const int cg8 = (int)(gtid & 63) * 8; float w0[8], w1[8], w2[8], w3[8], b8[8];
          UNR for (int e = 0; e < 8; ++e) { w0[e] = cw[cg8 + e]; w1[e] = cw[512 + cg8 + e]; w2[e] = cw[1024 + cg8 + e]; w3[e] = cw[1536 + cg8 + e]; b8[e] = cb[cg8 + e]; }
          for (size_t tk0 = gtid >> 6; tk0 < (size_t)TOK; tk0 += gthreads >> 6) { const int tk = (int)tk0, lo = tk < 256 ? 0 : 256, hi = tk < 256 ? 256 : TOK;
            float x0[8], x1[8], x2[8], x3[8], a[8]; const bf16_t* zp = ZA + (size_t)tk * 1536 + cg8;
            if (tk - 2 >= lo) ld8bf(zp - 2 * 1536, x0); else { UNR for (int e = 0; e < 8; ++e) x0[e] = 0.f; }
            if (tk - 1 >= lo) ld8bf(zp - 1536, x1); else { UNR for (int e = 0; e < 8; ++e) x1[e] = 0.f; }
            ld8bf(zp, x2);
            if (tk + 1 < hi) ld8bf(zp + 1536, x3); else { UNR for (int e = 0; e < 8; ++e) x3[e] = 0.f; }
            UNR for (int e = 0; e < 8; ++e) a[e] = b8[e] + w0[e] * x0[e] + w1[e] * x1[e] + w2[e] * x2[e] + w3[e] * x3[e];
            st8bf(XC + (size_t)tk * 512 + cg8, a); } }
        for (size_t i = gtid; i < (size_t)32 * 1040 * 16; i += gthreads) { const int j = (int)(i & 15); const int s = (int)((i >> 4) % 1040), g = (int)((i >> 4) / 1040);
            const int tk = s5_tok(s * 16 + j); const u32x4* src = (const u32x4*)(ZA + (size_t)tk * 1536 + 1024 + g * 16); u32x4* dst = (u32x4*)(A5 + ((size_t)g * 1040 + s) * 512 + j * 16);
            dst[0] = src[0]; dst[1] = src[1]; }
        {
            bf16_t* WY = (bf16_t*)(ws + W_S5Y); bf16_t* WE = (bf16_t*)(ws + W_S5E); const float* KT = (const float*)(ws + M_KT);
            const float* cre = IN(I_S5CRE) + (size_t)L * 2 * 32 * 16 * 64; const float* cim = IN(I_S5CIM) + (size_t)L * 2 * 32 * 16 * 64;
            const float* pw = PW + (size_t)L * 2 * 32 * 64 * 17 * 2; const float* bb = BBT + (size_t)L * 2 * 32 * 64 * 16 * 2;
            for (size_t i8 = gtid; i8 < (size_t)32 * 256 * 64; i8 += gthreads) {
                const int kk0 = (int)(i8 & 63) * 8, n = (int)((i8 >> 6) & 255), g = (int)(i8 >> 14), t = n >> 4, cp = n & 15; float v[8];
                if (kk0 < 256) { const int j = kk0 >> 4, c0 = kk0 & 15;
                    UNR for (int e = 0; e < 8; ++e) v[e] = 0.f;
                    if (t >= j) { const float* kp = KT + ((((size_t)0 * 32 + g) * 16 + (t - j)) * 16 + cp) * 16 + c0; const f32x4 a0 = *(const f32x4*)kp, a1 = *(const f32x4*)(kp + 4);
                        UNR for (int e = 0; e < 4; ++e) { v[e] += a0[e]; v[4 + e] += a1[e]; } }
                    if (j >= t) { const float* kp = KT + ((((size_t)1 * 32 + g) * 16 + (j - t)) * 16 + cp) * 16 + c0; const f32x4 a0 = *(const f32x4*)kp, a1 = *(const f32x4*)(kp + 4);
                        UNR for (int e = 0; e < 4; ++e) { v[e] += a0[e]; v[4 + e] += a1[e]; } } }
                else { const int d = (kk0 - 256) >> 7, pp0 = ((kk0 - 256) & 127) >> 1; const int ep = d == 0 ? t + 1 : 16 - t;
                    const f32x4 cr = *(const f32x4*)(cre + ((size_t)(d * 32 + g) * 16 + cp) * 64 + pp0), ci = *(const f32x4*)(cim + ((size_t)(d * 32 + g) * 16 + cp) * 64 + pp0);
                    UNR for (int e = 0; e < 4; ++e) { const float* pq = pw + ((size_t)(d * 32 + g) * 64 + pp0 + e) * 34 + ep * 2; const float pr = pq[0], pi = pq[1];
                        v[2 * e] = cr[e] * pr - ci[e] * pi; v[2 * e + 1] = -(cr[e] * pi + ci[e] * pr); } }
                st8bf(WY + i8 * 8, v); }
            for (size_t i8 = gtid; i8 < (size_t)32 * 256 * 32; i8 += gthreads) {
                const int kk0 = (int)(i8 & 31) * 8, n = (int)((i8 >> 5) & 255), g = (int)(i8 >> 13), d = n >> 7, pp = (n & 127) >> 1, ri = n & 1, j = kk0 >> 4, c0 = kk0 & 15;
                const int ep = d == 0 ? 15 - j : j;
                const float pr = pw[((size_t)(d * 32 + g) * 64 + pp) * 34 + ep * 2], pi = pw[((size_t)(d * 32 + g) * 64 + pp) * 34 + ep * 2 + 1];
                const float* bp = bb + ((size_t)(d * 32 + g) * 64 + pp) * 32 + c0 * 2; float v[8];
                UNR for (int e = 0; e < 8; e += 2) { const f32x4 b4 = *(const f32x4*)(bp + e * 2);
                    v[e] = ri == 0 ? pr * b4[0] - pi * b4[1] : pr * b4[1] + pi * b4[0]; v[e + 1] = ri == 0 ? pr * b4[2] - pi * b4[3] : pr * b4[3] + pi * b4[2]; }
                st8bf(WE + i8 * 8, v); }
        }
    } break;
    case 3: {
        { GemmArgs g{XC, (const bf16_t*)(ws + W_LRU), 512, 512, 512}; StaticOrder S; S.init(TOK, 2048, bid);
          gemm_phase(lds, g, S, EpiLruGate{XC, LA, LU, IN(I_BA) + L * 1024, IN(I_BX) + L * 1024, IN(I_LAM) + L * 1024}, tid); }
        asm volatile("" : "+v"(tid));
        { GemmArgs g{A5, (const bf16_t*)(ws + W_S5E), 512, 256, 256}; S5Order S; S.init(248, bid);
          gemm_phase(lds, g, S, EpiS5E{S5E}, tid); }
    } break;
    case 4: {
        for (int task = bid; task < 520 + 256; task += gridDim.x) {
            if (task < 520) { const int c = task >> 1, dir = task & 1, ch = tid; float As = 0.f, Bs = 0.f;
                for (int j0 = 0; j0 < 64; j0 += 16) { float la[16], uu[16];
                    UNR for (int j = 0; j < 16; ++j) { const int tk = tok_of(dir, c * 64 + j0 + j); const size_t o = ((size_t)dir * TOK + tk) * 512 + ch; la[j] = bf2f(LA[o]); uu[j] = bf2f(LU[o]); }
                    UNR for (int j = 0; j < 16; ++j) { As += la[j]; Bs = __expf(la[j]) * Bs + uu[j]; } }
                CA[(dir * 260 + c) * 512 + ch] = As; CB[(dir * 260 + c) * 512 + ch] = Bs;
            } else {
                const int idx = (task - 520) * 32 + (tid & 31), seg = tid >> 5;
                const int pp = idx & 63, dir = (idx >> 6) & 1, g = idx >> 7;
                const float* pw = PW + ((((size_t)L * 2 + dir) * 32 + g) * 64 + pp) * 34; const float ar = pw[32], ai = pw[33];
                const int cb = dir * 128 + pp * 2;
                float hr = 0.f, hi = 0.f, pr = 1.f, pi = 0.f;
                for (int q0 = seg * 65; q0 < seg * 65 + 65; q0 += 13) { float er[13], ei[13];
                    UNR for (int j = 0; j < 13; ++j) { const int q = q0 + j, sx = dir == 0 ? q : (q < 16 ? 15 - q : 1055 - q); const float* ep = S5E + ((size_t)g * 1040 + sx) * 256 + cb; er[j] = ep[0]; ei[j] = ep[1]; }
                    UNR for (int j = 0; j < 13; ++j) { const float nr = ar * hr - ai * hi + er[j], ni = ar * hi + ai * hr + ei[j]; hr = nr; hi = ni;
                        const float qr = ar * pr - ai * pi, qi = ar * pi + ai * pr; pr = qr; pi = qi; } }
                __syncthreads();
                sm[(seg * 32 + (tid & 31)) * 2] = hr; sm[(seg * 32 + (tid & 31)) * 2 + 1] = hi;
                __syncthreads();
                hr = 0.f; hi = 0.f;
                for (int k2 = 0; k2 < seg; ++k2) { const float er = sm[(k2 * 32 + (tid & 31)) * 2], ei = sm[(k2 * 32 + (tid & 31)) * 2 + 1];
                    const float nr = pr * hr - pi * hi + er, ni = pr * hi + pi * hr + ei; hr = nr; hi = ni; }
                for (int q0 = seg * 65; q0 < seg * 65 + 65; q0 += 13) { float er[13], ei[13];
                    UNR for (int j = 0; j < 13; ++j) { const int q = q0 + j, sx = dir == 0 ? q : (q < 16 ? 15 - q : 1055 - q); const float* ep = S5E + ((size_t)g * 1040 + sx) * 256 + cb; er[j] = ep[0]; ei[j] = ep[1]; }
                    UNR for (int j = 0; j < 13; ++j) { const int q = q0 + j, sx = dir == 0 ? q : (q < 16 ? 15 - q : 1055 - q);
                        *(unsigned*)(A5 + ((size_t)g * 1040 + sx) * 512 + 256 + cb) = pack2(hr, hi);
                        const float nr = ar * hr - ai * hi + er[j], ni = ar * hi + ai * hr + ei[j]; hr = nr; hi = ni; } }
                __syncthreads();
            }
        }
    } break;
    case 5: {
        if (bid < 2) { const int dir = bid, ch = tid; float h = 0.f;
            for (int c0 = 0; c0 < 260; c0 += 13) { float a[13], b[13];
                UNR for (int j = 0; j < 13; ++j) { a[j] = CA[(dir * 260 + c0 + j) * 512 + ch]; b[j] = CB[(dir * 260 + c0 + j) * 512 + ch]; }
                UNR for (int j = 0; j < 13; ++j) { HIN[(dir * 260 + c0 + j) * 512 + ch] = h; h = __expf(a[j]) * h + b[j]; } } }
        __syncthreads(); asm volatile("" : "+v"(tid));
        { GemmArgs g{A5, (const bf16_t*)(ws + W_S5Y), 512, 512, 512}; S5Order S; S.init(254, bid);
          gemm_phase(lds, g, S, EpiS5Y{ZA, XC, IN(I_S5D) + L * 512}, tid); }
    } break;
    case 6: {
        for (int ct = bid; ct < 260; ct += gridDim.x) { const int ch = tid;
            float h = HIN[(0 * 260 + ct) * 512 + ch];
            for (int j0 = 0; j0 < 64; j0 += 16) { float la[16], uu[16];
                UNR for (int j = 0; j < 16; ++j) { const size_t o = (size_t)(ct * 64 + j0 + j) * 512 + ch; la[j] = bf2f(LA[o]); uu[j] = bf2f(LU[o]); }
                UNR for (int j = 0; j < 16; ++j) { const size_t o = (size_t)(ct * 64 + j0 + j) * 512 + ch; h = __expf(la[j]) * h + uu[j]; YA[o] = f2bf(h); } }
            const int c1 = ct < 4 ? 3 - ct : 263 - ct; h = HIN[(1 * 260 + c1) * 512 + ch];
            for (int j0 = 0; j0 < 64; j0 += 16) { float la[16], uu[16], ga[16], hf[16];
                UNR for (int j = 0; j < 16; ++j) { const int tk = ct * 64 + 63 - j0 - j; const size_t o = (size_t)tk * 512 + ch, o1 = (size_t)TOK * 512 + o;
                    la[j] = bf2f(LA[o1]); uu[j] = bf2f(LU[o1]); ga[j] = bf2f(ZA[(size_t)tk * 1536 + 512 + ch]); hf[j] = bf2f(YA[o]); }
                UNR for (int j = 0; j < 16; ++j) { const int tk = ct * 64 + 63 - j0 - j; const size_t o = (size_t)tk * 512 + ch;
                    h = __expf(la[j]) * h + uu[j]; YA[o] = f2bf(gelu_t(ga[j]) * (hf[j] + h)); } } }
        __syncthreads(); asm volatile("" : "+v"(tid));
        { GemmArgs g{XC, (const bf16_t*)(ws + W_GLU), 512, 512, 512}; StaticOrder S; S.init(TOK, 512, bid);
          gemm_phase(lds, g, S, EpiGlu{XC, YC, IN(I_BGLU) + L * 512}, tid); }
    } break;
    case 7: {
        const float* mu = IN(I_MU) + L * 1920;
        for (size_t i = gtid; i < (size_t)TOK * 48; i += gthreads) { const int tk = (int)(i / 48), q = (int)(i % 48) * 8;
            const int lo = tk < 256 ? 0 : 256, hi = tk < 256 ? 256 : TOK; const bf16_t* zp = ZB + (size_t)tk * 2048 + 1536 + q;
            float z[8], zp1[8], zn1[8], o[8];
            ld8bf(zp, z);
            if (tk - 1 >= lo) ld8bf(zp - 2048, zp1); else { UNR for (int e = 0; e < 8; ++e) zp1[e] = 0.f; }
            if (tk + 1 < hi) ld8bf(zp + 2048, zn1); else { UNR for (int e = 0; e < 8; ++e) zn1[e] = 0.f; }
            UNR for (int e = 0; e < 8; ++e) { const float zz = z[e] + mu[1536 + q + e] * (0.5f * (zp1[e] + zn1[e]) - z[e]); o[e] = q < 128 ? tanhf(zz) : (q < 256 ? zz : sigm(zz)); }
            st8bf(LORAA + (size_t)tk * 384 + q, o); }
    } break;
    case 8: {
        GemmArgs g{LORAA, (const bf16_t*)(ws + W_LORA), 384, 384, 384}; StaticOrder S; S.init(TOK, 2560, bid);
        gemm_phase(lds, g, S, EpiLora{LW, IC, GG, IN(I_W0) + L * 1024, IN(I_A0) + L * 1024}, tid);
    } break;
    case 9: {
        const float* mu = IN(I_MU) + L * 1920; const float* kkw = IN(I_KK) + L * 512; const float* kaw = IN(I_KA) + L * 512;
        for (int t4 = bid; t4 < 16 * WNC / 4; t4 += gridDim.x) {
            const int q = wid >> 1, half = wid & 1, task = t4 * 4 + q, hd = task / WNC, c = task % WNC;
            const int sub = tid & 3, row0 = ((tid & 63) >> 2) * 4;
            const int pcol = (hd & 7) * 64 + lane; const float mur = mu[pcol], muk = mu[512 + pcol], muv = mu[1024 + pcol], kkwv = kkw[pcol], kawv = kaw[pcol];
            f32x2 s[4][8]; float* sy = sm + 4 * WSC * WVEC;
            UNR for (int r = 0; r < 4; ++r) UNR for (int i = 0; i < 8; ++i) { const int ch = sub * 16 + 2 * i;
                s[r][i] = (f32x2){(half == 1 && row0 + r == ch) ? 1.f : 0.f, (half == 1 && row0 + r == ch + 1) ? 1.f : 0.f}; }
            for (int sc = 0; sc < WCH / WSC; ++sc) {
                __syncthreads();
                wkv_stage_all(sm, ZB, LW, IC, mur, muk, muv, kkwv, kawv, hd >> 3, hd & 7, (t4 * 4) % WNC, sc, wid, lane);
                __syncthreads();
                wkv_steps<4, true>(s, sm + q * WSC * WVEC, sy + q * WSC * 128 + half * 64, 128, WSC, row0, half == 0, sub);
                __syncthreads();
                { const int dir = hd >> 3, head = hd & 7; bf16_t* YD = dir == 0 ? YB : YD1;
                  for (int e = tid; e < 4 * WSC * 128; e += NTHR) { const int qq = e / (WSC * 128), jj = (e >> 7) % WSC, rw = e & 127, tk = tok_of(dir, ((t4 * 4) % WNC + qq) * WCH + sc * WSC + jj);
                      if (rw < 64) YD[(size_t)tk * 512 + head * 64 + rw] = f2bf(sy[e]); else RT[((size_t)dir * TOK + tk) * 512 + head * 64 + (rw - 64)] = f2bf(sy[e]); } }
            }
            UNR for (int r = 0; r < 4; ++r) { float* dst = PQ + ((size_t)hd * WNC + c) * 8192 + half * 4096 + (row0 + r) * 64 + sub * 16;
                UNR for (int i = 0; i < 8; i += 2) *(f32x4*)(dst + 2 * i) = (f32x4){s[r][i][0], s[r][i][1], s[r][i + 1][0], s[r][i + 1][1]}; }
        }
    } break;
    case 10: {
        for (int task = bid; task < 128; task += gridDim.x) { const int hd = task >> 3, rg = task & 7, r = tid >> 6, i = tid & 63, vrow = rg * 8 + r;
            float sv = 0.f; float* Ps = sm + 512;
            const float* P0 = PQ + ((size_t)hd * WNC) * 8192;
            f32x4 pa = *(const f32x4*)(P0 + 4096 + tid * 8), pb = *(const f32x4*)(P0 + 4096 + tid * 8 + 4); float qc = P0[vrow * 64 + i];
            for (int c = 0; c < WNC; ++c) {
                __syncthreads();
                *(f32x4*)(Ps + tid * 8) = pa; *(f32x4*)(Ps + tid * 8 + 4) = pb; sm[r * 64 + i] = sv;
                SCS[((size_t)hd * WNC + c) * 4096 + vrow * 64 + i] = sv;
                float a2 = qc;
                if (c + 1 < WNC) { const float* P1 = PQ + ((size_t)hd * WNC + c + 1) * 8192; pa = *(const f32x4*)(P1 + 4096 + tid * 8); pb = *(const f32x4*)(P1 + 4096 + tid * 8 + 4); qc = P1[vrow * 64 + i]; }
                __syncthreads();
#pragma unroll 16
                for (int a = 0; a < 64; ++a) a2 += sm[r * 64 + a] * Ps[a * 64 + i];
                sv = a2;
            }
            __syncthreads();
        }
    } break;
    case 11: {
        for (int task = bid; task < 16 * WNC; task += gridDim.x) { const int hd = task / WNC, c = task % WNC, dir = hd >> 3, head = hd & 7;
            float sc_[64];
            { const float* src = SCS + ((size_t)hd * WNC + c) * 4096 + lane * 64; UNR for (int i = 0; i < 64; i += 4) { const f32x4 t = *(const f32x4*)(src + i); sc_[i] = t[0]; sc_[i + 1] = t[1]; sc_[i + 2] = t[2]; sc_[i + 3] = t[3]; } }
            __syncthreads();
            for (int e = tid; e < WCH * 8; e += NTHR) { const int t = e >> 3, i8 = (e & 7) * 8; float v8[8];
                ld8bf(RT + ((size_t)dir * TOK + tok_of(dir, c * WCH + t)) * 512 + head * 64 + i8, v8);
                *(f32x4*)(sm + t * 64 + i8) = (f32x4){v8[0], v8[1], v8[2], v8[3]}; *(f32x4*)(sm + t * 64 + i8 + 4) = (f32x4){v8[4], v8[5], v8[6], v8[7]}; }
            __syncthreads();
            bf16_t* YD = dir == 0 ? YB : YD1;
            for (int t = wid; t < WCH; t += 8) { const size_t o = (size_t)tok_of(dir, c * WCH + t) * 512 + head * 64 + lane;
                float a0 = bf2f(YD[o]), a1 = 0.f, a2 = 0.f, a3 = 0.f; const float* rt = sm + t * 64;
                UNR for (int i = 0; i < 64; i += 4) { const f32x4 r4 = *(const f32x4*)(rt + i); a0 = fmaf(sc_[i], r4[0], a0); a1 = fmaf(sc_[i + 1], r4[1], a1); a2 = fmaf(sc_[i + 2], r4[2], a2); a3 = fmaf(sc_[i + 3], r4[3], a3); }
                YD[o] = f2bf((a0 + a1) + (a2 + a3)); }
        }
    } break;
    case 12: {
        const float* mu = IN(I_MU) + L * 1920; const float* kaw = IN(I_KA) + L * 512; const float* rk = IN(I_RK) + L * 512;
        const float* lnw = IN(I_LNW) + L * 512; const float* lnb = IN(I_LNB) + L * 512;
        for (int wt0 = (bid * 8 + wid) * 4; wt0 < TOK * 8; wt0 += gridDim.x * 8 * 4) {
            float yv[4], rz[4][3], kz[4][3], vz[4][3], i0[4], i1[4], gv[4];
            UNR for (int u = 0; u < 4; ++u) { const int wt = wt0 + u, tk = wt >> 3, col = (wt & 7) * 64 + lane; const size_t o = (size_t)tk * 512 + col;
                const int lo = tk < 256 ? 0 : 256, hi = tk < 256 ? 256 : TOK; const bool hp = tk - 1 >= lo, hn = tk + 1 < hi; const bf16_t* z0 = ZB + (size_t)tk * 2048 + col;
                yv[u] = bf2f(YB[o]) + bf2f(YD1[o]); i0[u] = bf2f(IC[o]); i1[u] = bf2f(IC[(size_t)TOK * 512 + o]); gv[u] = bf2f(GG[o]);
                rz[u][1] = bf2f(z0[0]); kz[u][1] = bf2f(z0[512]); vz[u][1] = bf2f(z0[1024]);
                rz[u][0] = hp ? bf2f(z0[-2048]) : 0.f; kz[u][0] = hp ? bf2f(z0[-2048 + 512]) : 0.f; vz[u][0] = hp ? bf2f(z0[-2048 + 1024]) : 0.f;
                rz[u][2] = hn ? bf2f(z0[2048]) : 0.f; kz[u][2] = hn ? bf2f(z0[2048 + 512]) : 0.f; vz[u][2] = hn ? bf2f(z0[2048 + 1024]) : 0.f; }
            UNR for (int u = 0; u < 4; ++u) { const int wt = wt0 + u, tk = wt >> 3, col = (wt & 7) * 64 + lane; const size_t o = (size_t)tk * 512 + col;
                const float y = yv[u];
                const float mean = wave_sum(y, lane) * (1.0f / 64.0f); const float dv = y - mean; const float var = wave_sum(dv * dv, lane) * (1.0f / 64.0f);
                float yn = dv * rsqrtf(var + 64e-5f) * lnw[col] + lnb[col];
                const float r = rz[u][1] + mu[col] * (0.5f * (rz[u][0] + rz[u][2]) - rz[u][1]);
                const float kx = kz[u][1] + mu[512 + col] * (0.5f * (kz[u][0] + kz[u][2]) - kz[u][1]);
                const float v = vz[u][1] + mu[1024 + col] * (0.5f * (vz[u][0] + vz[u][2]) - vz[u][1]);
                const float kd0 = kx * (1.0f + (i0[u] - 1.0f) * kaw[col]), kd1 = kx * (1.0f + (i1[u] - 1.0f) * kaw[col]);
                const float bon = wave_sum(r * (kd0 + kd1) * rk[col], lane);
                yn += bon * v;
                YB[o] = f2bf(yn * gv[u]); } }
        __syncthreads();
        conv_T(IN(I_WIN) + (size_t)L * 1024 * 6528, 6528, (bf16_t*)(ws + W_INZG), 3072, 1024, MapOff{3456}, sm, 0, tid, bid);
        for (int kb = 0; kb < 3; ++kb) conv_T(IN(I_WBR) + ((size_t)L * 3 + kb) * 512 * 1024, 1024, (bf16_t*)(ws + W_BR) + (size_t)kb * 1024 * 512, 1024, 512, MapOff{0}, sm, kb * 64, tid, bid);
        conv_T(IN(I_WOUT) + (size_t)L * 1024 * 1024, 1024, (bf16_t*)(ws + W_OUT), 1024, 1024, MapOff{0}, sm, 192, tid, bid);
        conv_T(IN(I_WFIN) + (size_t)L * 1024 * 5632, 5632, (bf16_t*)(ws + W_FIN), 5632, 1024, MapFfn(), sm, 0, tid, bid);
        conv_T(IN(I_WFOUT) + (size_t)L * 2816 * 1024, 1024, (bf16_t*)(ws + W_FOUT), 1024, 2816, MapOff{0}, sm, 128, tid, bid);
        norm_rows(H, IN(I_NORM1) + L * 1024, modl, modc, 0, 1024, HN, row0, tid, bid);
    } break;
    case 13: {
        GemmArgs g{HN + (size_t)row0 * 1024, (const bf16_t*)(ws + W_INZG), 1024, 1024, 1024}; StaticOrder S; S.init(Mrows, 3072, bid);
        gemm_phase(lds, g, S, EpiZg{ZG, row0}, tid);
    } break;
    case 14: {
        GemmArgs g{YS + (size_t)row0 * 512, (const bf16_t*)(ws + W_BR), 512, 512, 512}; TripleOrder S; S.init(Mrows, bid);
        gemm_phase(lds, g, S, EpiMerge1{ZG, MM, row0}, tid);
    } break;
    case 15: {
        GemmArgs g{MM + (size_t)row0 * 1024, (const bf16_t*)(ws + W_OUT), 1024, 1024, 1024}; StaticOrder S; S.init(Mrows, 1024, bid);
        gemm_phase(lds, g, S, EpiRes{H, modl + 2048, modc + 2048, row0}, tid);
    } break;
    case 16: {
        norm_rows(H, IN(I_NORM2) + L * 1024, modl, modc, 3072, 4096, HN, row0, tid, bid);
    } break;
    case 17: {
        GemmArgs g{HN + (size_t)row0 * 1024, (const bf16_t*)(ws + W_FIN), 1024, 1024, 1024}; StaticOrder S; S.init(Mrows, 5632, bid);
        gemm_phase(lds, g, S, EpiFfn{ACT, row0}, tid);
    } break;
    case 18: {
        GemmArgs g{ACT + (size_t)row0 * 2816, (const bf16_t*)(ws + W_FOUT), 2816, 2816, 2816}; StaticOrder S; S.init(Mrows, 1024, bid);
        gemm_phase(lds, g, S, EpiRes{H, modl + 5120, modc + 5120, row0}, tid);
    } break;
    }
}

#undef wid
#undef lane
#undef gtid
#undef gthreads
#define XB_TMO      128
#define XB_XCNT(j)  (256  + 64 * (j))
#define XB_XSUB(j)  (1280 + 64 * (j))
#define XB_XGEN(j)  (2304 + 64 * (j))
#define XB_TOP      3328
#define XB_TOPGEN   3392
#define XCD_BAR_WORDS 3456
#define XB_SPIN_CAP (1u << 18)
__device__ __forceinline__ unsigned xb_ld(unsigned* p)              { return __hip_atomic_load(p, __ATOMIC_RELAXED, __HIP_MEMORY_SCOPE_AGENT); }
__device__ __forceinline__ unsigned xb_add(unsigned* p, unsigned v) { return __hip_atomic_fetch_add(p, v, __ATOMIC_RELAXED, __HIP_MEMORY_SCOPE_AGENT); }
__device__ __forceinline__ unsigned xb_xcc_id() { return (unsigned)__builtin_amdgcn_s_getreg((3 << 11) | 20) & 0xFu; }
#define XB_SPIN(cond, bar) do { unsigned _sp = 0; while (cond) { __builtin_amdgcn_s_sleep(1); \
    if ((++_sp & 255u) == 0u) { if (xb_ld(&(bar)[XB_TMO])) break; if (_sp > XB_SPIN_CAP) { atomicAdd(&(bar)[XB_TMO], 1u); break; } } } } while (0)
struct XcdBarrier { unsigned* bar; unsigned x; volatile LAS unsigned* st; };
__device__ __forceinline__ XcdBarrier xcd_barrier_post(unsigned* bar, volatile LAS unsigned* st) {
    XcdBarrier b; b.bar = bar; b.x = xb_xcc_id(); b.st = st;
    if (threadIdx.x == 0) (void)xb_add(&bar[XB_XCNT(b.x)], 1u);
    return b;
}
__device__ __forceinline__ void xcd_barrier_complete(unsigned* bar, unsigned x, unsigned& nloc, unsigned& nx) {
    const unsigned G = gridDim.x * gridDim.y * gridDim.z;
    unsigned sum, cnt, mine, sp = 0u;
    for (;;) {
        sum = 0u; cnt = 0u; mine = 0u;
#pragma unroll
        for (unsigned j = 0; j < 16; ++j) { const unsigned c = xb_ld(&bar[XB_XCNT(j)]); sum += c; cnt += (c > 0u) ? 1u : 0u; mine = (j == x) ? c : mine; }
        if (sum == G) break;
        __builtin_amdgcn_s_sleep(1);
        if ((++sp & 255u) == 0u) { if (xb_ld(&bar[XB_TMO])) break; if (sp > XB_SPIN_CAP) { atomicAdd(&bar[XB_TMO], 1u); break; } }
    }
    nloc = mine > 0u ? mine : 1u; nx = cnt > 0u ? cnt : 1u;
}
__device__ __forceinline__ void xcd_barrier(const XcdBarrier& b) {
    asm volatile("s_waitcnt vmcnt(0) lgkmcnt(0)" ::: "memory");
    __syncthreads();
    if (threadIdx.x == 0) {
        unsigned* bar = b.bar;
        __builtin_amdgcn_s_waitcnt(0);
        unsigned nloc = b.st[0], nx = b.st[1];
        if (nloc == 0u) { xcd_barrier_complete(bar, b.x, nloc, nx); b.st[0] = nloc; b.st[1] = nx; }
        const unsigned old = xb_add(&bar[XB_XSUB(b.x)], 1u);
        const unsigned gen = old / nloc;
        if (old + 1u == (gen + 1u) * nloc) {
            __builtin_amdgcn_fence(__ATOMIC_RELEASE, "agent");
            asm volatile("s_waitcnt vmcnt(0)" ::: "memory");
            const unsigned og = xb_add(&bar[XB_TOP], 1u);
            const unsigned tg = og / nx;
            if (og + 1u == (tg + 1u) * nx) xb_add(&bar[XB_TOPGEN], 1u);
            else XB_SPIN(xb_ld(&bar[XB_TOPGEN]) == tg, bar);
            __builtin_amdgcn_fence(__ATOMIC_ACQUIRE, "agent");
            xb_add(&bar[XB_XGEN(b.x)], 1u);
            asm volatile("s_waitcnt vmcnt(0)" ::: "memory");
        } else {
            XB_SPIN(xb_ld(&bar[XB_XGEN(b.x)]) == gen, bar);
            __builtin_amdgcn_fence(__ATOMIC_ACQUIRE, "agent");
            asm volatile("s_waitcnt vmcnt(0)" ::: "memory");
        }
    }
    __syncthreads();
}
__device__ __forceinline__ void grid_bar(unsigned* ctr, unsigned target) {
    asm volatile("s_waitcnt vmcnt(0) lgkmcnt(0)" ::: "memory");
    __syncthreads();
    if (threadIdx.x == 0) {
        __builtin_amdgcn_fence(__ATOMIC_RELEASE, "agent");
        asm volatile("s_waitcnt vmcnt(0)" ::: "memory");
        __hip_atomic_fetch_add(ctr, 1u, __ATOMIC_RELAXED, __HIP_MEMORY_SCOPE_AGENT);
        while (__hip_atomic_load(ctr, __ATOMIC_RELAXED, __HIP_MEMORY_SCOPE_AGENT) < target) __builtin_amdgcn_s_sleep(2);
    }
    if (threadIdx.x < 64) {
        __builtin_amdgcn_fence(__ATOMIC_ACQUIRE, "agent");
        asm volatile("s_waitcnt vmcnt(0)" ::: "memory");
    }
    __syncthreads();
}
#if SINGLE_LAUNCH
__global__ void __launch_bounds__(NTHR, 2) fwd_megakernel(Params p, int ph_lo, int ph_hi) {
    extern __shared__ __attribute__((aligned(16))) unsigned char shm[];
    volatile LAS unsigned* xst = (volatile LAS unsigned*)((LAS unsigned char*)shm + LDS_STAGE);
    if (threadIdx.x < 2) xst[threadIdx.x] = 0u;
    if (blockIdx.x == 0) for (int i = threadIdx.x; i < XCD_BAR_WORDS; i += NTHR) __hip_atomic_store((unsigned*)(p.ws + M_BAR) + i, 0u, __ATOMIC_RELAXED, __HIP_MEMORY_SCOPE_AGENT);
    __syncthreads();
    { cg::grid_group grid = cg::this_grid(); grid.sync(); }
    const int wv = __builtin_amdgcn_readfirstlane(threadIdx.x >> 6);
    const XcdBarrier xb = xcd_barrier_post((unsigned*)(p.ws + M_BAR), xst);
#ifdef USE_CG_SYNC
#define MK_SYNC do { asm volatile("s_waitcnt vmcnt(0) lgkmcnt(0)" ::: "memory"); __syncthreads(); cg::this_grid().sync(); } while (0)
#else
#define MK_SYNC xcd_barrier(xb)
#endif
#ifdef MK_SWITCH
    for (int ph = 0; ph < NPHASE; ++ph) { run_phase<-1>(p, ph, shm, wv); if (ph + 1 < NPHASE) MK_SYNC; }
}
#else
    run_phase<100>(p, 0, shm, wv); MK_SYNC;
#define MK_LAYER(LL) do { const int base = 1 + (LL) * PH_PER_LAYER; \
        run_phase<0>(p, base + 0, shm, wv); MK_SYNC;   run_phase<1>(p, base + 1, shm, wv); MK_SYNC;   run_phase<2>(p, base + 2, shm, wv); MK_SYNC; \
        run_phase<3>(p, base + 3, shm, wv); MK_SYNC;   run_phase<4>(p, base + 4, shm, wv); MK_SYNC;   run_phase<5>(p, base + 5, shm, wv); MK_SYNC; \
        run_phase<6>(p, base + 6, shm, wv); MK_SYNC;   run_phase<7>(p, base + 7, shm, wv); MK_SYNC;   run_phase<8>(p, base + 8, shm, wv); MK_SYNC; \
        run_phase<9>(p, base + 9, shm, wv); MK_SYNC;   run_phase<10>(p, base + 10, shm, wv); MK_SYNC; run_phase<11>(p, base + 11, shm, wv); MK_SYNC; \
        run_phase<12>(p, base + 12, shm, wv); MK_SYNC; run_phase<13>(p, base + 13, shm, wv); MK_SYNC; run_phase<14>(p, base + 14, shm, wv); MK_SYNC; \
        run_phase<15>(p, base + 15, shm, wv); MK_SYNC; run_phase<16>(p, base + 16, shm, wv); MK_SYNC; run_phase<17>(p, base + 17, shm, wv); MK_SYNC; \
        run_phase<18>(p, base + 18, shm, wv); MK_SYNC; } while (0)
    MK_LAYER(0); MK_LAYER(1); MK_LAYER(2); MK_LAYER(3);
    run_phase<101>(p, NPHASE - 1, shm, wv);
}
#endif
#endif
template <int KSEL>
__global__ void __launch_bounds__(NTHR, 2) phase_kernel(Params p, int ph) {
    extern __shared__ __attribute__((aligned(16))) unsigned char shm[];
    run_phase<KSEL>(p, ph, shm, __builtin_amdgcn_readfirstlane(threadIdx.x >> 6));
}
template <int KSEL> static void launch_phase(const Params& p, int ph, int grid, hipStream_t stream) {
    static bool attr = false;
    if (!attr) { (void)hipFuncSetAttribute((const void*)phase_kernel<KSEL>, hipFuncAttributeMaxDynamicSharedMemorySize, LDS_BYTES); attr = true; }
    phase_kernel<KSEL><<<grid, NTHR, LDS_BYTES, stream>>>(p, ph);
}

extern "C" void kernel_launch(void* const* d_in, const int* in_sizes, int n_in, void* d_out, int out_size, void* d_ws, size_t ws_size, hipStream_t stream) {
    static int grid = 0;
    if (grid == 0) {
        if (n_in != 42 || ws_size < WS_END) { fprintf(stderr, "kernel_launch: unexpected n_in %d or ws %zu < %zu\n", n_in, ws_size, (size_t)WS_END); grid = -1; return; }
        int dev = 0, cus = 0;
        (void)hipGetDevice(&dev); (void)hipDeviceGetAttribute(&cus, hipDeviceAttributeMultiprocessorCount, dev);
#if SINGLE_LAUNCH
        if (hipFuncSetAttribute((const void*)fwd_megakernel, hipFuncAttributeMaxDynamicSharedMemorySize, LDS_BYTES) != hipSuccess) { fprintf(stderr, "hipFuncSetAttribute failed\n"); grid = -1; return; }
#endif
        (void)hipGetLastError();
        grid = cus;
    }
    if (grid < 0) return;
    Params p{};
    for (int i = 0; i < 42; ++i) p.in[i] = (const float*)d_in[i];
    p.out = (float*)d_out; p.ws = (unsigned char*)d_ws;
#if SINGLE_LAUNCH
    (void)hipMemsetAsync((unsigned char*)d_ws + M_BAR, 0, 16384, stream);
    int lo = 0, hi = NPHASE;
    void* args[] = {&p, &lo, &hi};
    hipError_t e = hipLaunchCooperativeKernel((const void*)fwd_megakernel, dim3(grid), dim3(NTHR), args, LDS_BYTES, stream);
    if (e != hipSuccess) fprintf(stderr, "cooperative launch failed: %s (grid %d)\n", hipGetErrorString(e), grid);
#else
    for (int ph = 0; ph < NPHASE; ++ph) {
        if (ph == 0) { launch_phase<100>(p, ph, grid, stream); continue; }
        if (ph == NPHASE - 1) { launch_phase<101>(p, ph, grid, stream); continue; }
        switch ((ph - 1) % PH_PER_LAYER) {
        case 0: launch_phase<0>(p, ph, grid, stream); break;   case 1: launch_phase<1>(p, ph, grid, stream); break;
        case 2: launch_phase<2>(p, ph, grid, stream); break;   case 3: launch_phase<3>(p, ph, grid, stream); break;
        case 4: launch_phase<4>(p, ph, grid, stream); break;   case 5: launch_phase<5>(p, ph, grid, stream); break;
        case 6: launch_phase<6>(p, ph, grid, stream); break;   case 7: launch_phase<7>(p, ph, grid, stream); break;
        case 8: launch_phase<8>(p, ph, grid, stream); break;   case 9: launch_phase<9>(p, ph, grid, stream); break;
        case 10: launch_phase<10>(p, ph, grid, stream); break; case 11: launch_phase<11>(p, ph, grid, stream); break;
        case 12: launch_phase<12>(p, ph, grid, stream); break; case 13: launch_phase<13>(p, ph, grid, stream); break;
        case 14: launch_phase<14>(p, ph, grid, stream); break; case 15: launch_phase<15>(p, ph, grid, stream); break;
        case 16: launch_phase<16>(p, ph, grid, stream); break; case 17: launch_phase<17>(p, ph, grid, stream); break;
        case 18: launch_phase<18>(p, ph, grid, stream); break;
        }
    }
#endif
}
```

```cpp
#define TID_MBCNT 1
#include <hip/hip_runtime.h>
#include <hip/hip_cooperative_groups.h>
#include <cstdio>
namespace cg = cooperative_groups;

#define LAS __attribute__((address_space(3)))
#define UNR _Pragma("unroll")
typedef unsigned short bf16_t;
typedef short bf16x8 __attribute__((ext_vector_type(8)));
typedef float f32x4 __attribute__((ext_vector_type(4)));
typedef unsigned u32x2 __attribute__((ext_vector_type(2)));
typedef unsigned u32x4 __attribute__((ext_vector_type(4)));

constexpr int TOK = 16640, NLAYER = 4;
#ifndef SINGLE_LAUNCH
#define SINGLE_LAUNCH 1
#endif
constexpr int NTHR = 512;
constexpr int LDS_STAGE = 131072;
constexpr int LDS_BYTES = LDS_STAGE + 16;

constexpr size_t SZ_TB512 = (size_t)TOK * 512 * 2;
constexpr size_t OFF_H = 0;
constexpr size_t OFF_HN = OFF_H + (size_t)TOK * 1024 * 4;
constexpr size_t OFF_W1 = OFF_HN + (size_t)TOK * 1024 * 2;
constexpr size_t W_INA = OFF_W1;
constexpr size_t W_LRU = W_INA + (size_t)3584 * 1024 * 2;
constexpr size_t W_LORA = W_LRU + (size_t)2048 * 512 * 2;
constexpr size_t W_S5Y = W_LORA + (size_t)2560 * 384 * 2;
constexpr size_t W_S5E = W_S5Y + (size_t)32 * 256 * 512 * 2;
constexpr size_t W_GLU = W_S5E + (size_t)32 * 256 * 256 * 2;
constexpr size_t OFF_YS = W_GLU + (size_t)512 * 512 * 2;
constexpr size_t OFF_ZB = OFF_YS + 3 * SZ_TB512;
constexpr size_t OFF_MISC = OFF_ZB + (size_t)TOK * 2048 * 2;
constexpr size_t M_MODV = OFF_MISC;
constexpr size_t M_PW = M_MODV + (size_t)4 * 2 * 6144 * 4;
constexpr size_t M_BB = M_PW + (size_t)4 * 2 * 32 * 64 * 17 * 2 * 4;
constexpr size_t M_CA = M_BB + (size_t)4 * 2 * 32 * 64 * 16 * 2 * 4;
constexpr size_t M_CB = M_CA + (size_t)2 * 260 * 512 * 4;
constexpr size_t M_HIN = M_CB + (size_t)2 * 260 * 512 * 4;
constexpr size_t M_KT = M_HIN + (size_t)2 * 260 * 512 * 4;
constexpr size_t M_BAR = OFF_MISC + 16777216 - 16384;
constexpr size_t OFF_X = OFF_MISC + 16777216;
constexpr size_t X_ZA = OFF_X;
constexpr size_t X_XC = X_ZA + (size_t)TOK * 1536 * 2;
constexpr size_t X_LA = X_XC + SZ_TB512;
constexpr size_t X_LU = X_LA + 2 * SZ_TB512;
constexpr size_t X_A5 = X_LU + 2 * SZ_TB512;
constexpr size_t X_LW = OFF_X;
constexpr size_t X_IC = X_LW + 2 * SZ_TB512;
constexpr size_t X_G = X_IC + 2 * SZ_TB512;
constexpr size_t X_YD1 = X_G + SZ_TB512;
constexpr size_t X_LORAA = X_YD1 + SZ_TB512;
constexpr size_t X_PQ = X_LORAA + (size_t)TOK * 384 * 2;
constexpr size_t X_SC = X_PQ + (size_t)16 * 64 * 8192 * 4;
constexpr size_t X_ZG = OFF_X;
constexpr size_t X_ACT = OFF_X;
constexpr size_t W_INZG = X_PQ;
constexpr size_t W_BR = W_INZG + (size_t)3072 * 1024 * 2;
constexpr size_t W_OUT = W_BR + (size_t)3 * 1024 * 512 * 2;
constexpr size_t W_FIN = W_OUT + (size_t)1024 * 1024 * 2;
constexpr size_t W_FOUT = W_FIN + (size_t)5632 * 1024 * 2;
constexpr size_t X_M = W_FOUT + (size_t)1024 * 2816 * 2;
constexpr size_t X_RT = X_SC + (size_t)16 * 64 * 4096 * 4;
constexpr size_t WS_END = X_RT + 2 * SZ_TB512 + 1048576;

struct Params { const float* in[42]; float* out; unsigned char* ws; };

enum { I_X = 0, I_C, I_CTX, I_CCTX, I_WMOD, I_BMOD, I_NORM1, I_NORM2, I_NORMF, I_WIN, I_CONVW, I_CONVB, I_WA, I_BA, I_WX, I_BX, I_LAM,
       I_MU, I_W0, I_W2, I_A0, I_A2, I_G2, I_KK, I_KA, I_RK, I_LNW, I_LNB, I_S5LRE, I_S5LIM, I_S5STEP, I_S5BRE, I_S5BIM, I_S5CRE, I_S5CIM,
       I_S5D, I_WGLU, I_BGLU, I_WBR, I_WOUT, I_WFIN, I_WFOUT };

__device__ __forceinline__ bf16_t f2bf(float f) { unsigned u = __float_as_uint(f); u += 0x7FFFu + ((u >> 16) & 1u); return (bf16_t)(u >> 16); }
__device__ __forceinline__ float bf2f(bf16_t b) { return __uint_as_float(((unsigned)b) << 16); }
typedef __bf16 bf16x2_t __attribute__((ext_vector_type(2)));
typedef float f32x2_t __attribute__((ext_vector_type(2)));
__device__ __forceinline__ unsigned pack2(float a, float b) { f32x2_t v = {a, b}; bf16x2_t r = __builtin_convertvector(v, bf16x2_t); return __builtin_bit_cast(unsigned, r); }
__device__ __forceinline__ void st4bf(bf16_t* p, float a, float b, float c, float d) { u32x2 w; w.x = pack2(a, b); w.y = pack2(c, d); *(u32x2*)p = w; }
__device__ __forceinline__ void ld4bf(const bf16_t* p, float (&o)[4]) { u32x2 w = *(const u32x2*)p; o[0] = __uint_as_float(w.x << 16); o[1] = __uint_as_float(w.x & 0xFFFF0000u); o[2] = __uint_as_float(w.y << 16); o[3] = __uint_as_float(w.y & 0xFFFF0000u); }
__device__ __forceinline__ void ld8bf(const bf16_t* p, float (&o)[8]) { const u32x4 w = *(const u32x4*)p;
    o[0] = __uint_as_float(w.x << 16); o[1] = __uint_as_float(w.x & 0xFFFF0000u); o[2] = __uint_as_float(w.y << 16); o[3] = __uint_as_float(w.y & 0xFFFF0000u);
    o[4] = __uint_as_float(w.z << 16); o[5] = __uint_as_float(w.z & 0xFFFF0000u); o[6] = __uint_as_float(w.w << 16); o[7] = __uint_as_float(w.w & 0xFFFF0000u); }
__device__ __forceinline__ void st8bf(bf16_t* p, const float (&v)[8]) { u32x4 w; w.x = pack2(v[0], v[1]); w.y = pack2(v[2], v[3]); w.z = pack2(v[4], v[5]); w.w = pack2(v[6], v[7]); *(u32x4*)p = w; }
#ifdef OLD_SIGM
__device__ __forceinline__ float sigm(float x) { return 1.0f / (1.0f + __expf(-x)); }
#else
__device__ __forceinline__ float sigm(float x) { return __builtin_amdgcn_rcpf(1.0f + __expf(-x)); }
#endif
__device__ __forceinline__ float softplusf(float x) { return x > 15.f ? x : __logf(1.0f + __expf(x)); }
__device__ __forceinline__ float gelu_t(float x) { float t = tanhf(0.7978845608028654f * (x + 0.044715f * x * x * x)); return 0.5f * x * (1.0f + t); }
__device__ __forceinline__ float silu(float x) { return x * sigm(x); }
__device__ __forceinline__ int tok_of(int dir, int p) { return dir == 0 ? p : (p < 256 ? 255 - p : 16895 - p); }
__device__ __forceinline__ int s5_tok(int p) { if (p < 256) return p; int q = p - 256; return 256 + (q & 255) * 64 + (q >> 8); }
__device__ __forceinline__ float shx(float v, int o, int lane) { return __int_as_float(__builtin_amdgcn_ds_bpermute((lane ^ o) << 2, __float_as_int(v))); }
__device__ __forceinline__ float wave_sum(float v, int lane) {
#pragma unroll
    for (int o = 32; o >= 1; o >>= 1) v += shx(v, o, lane);
    return v;
}
__device__ __forceinline__ float zshift(const bf16_t* ZB, int tk, int col, float mu) {
    const int lo = tk < 256 ? 0 : 256, hi = tk < 256 ? 256 : TOK;
    const float z = bf2f(ZB[(size_t)tk * 2048 + col]);
    const float zp = (tk - 1 >= lo) ? bf2f(ZB[(size_t)(tk - 1) * 2048 + col]) : 0.f;
    const float zn = (tk + 1 < hi) ? bf2f(ZB[(size_t)(tk + 1) * 2048 + col]) : 0.f;
    return z + mu * (0.5f * (zp + zn) - z);
}

constexpr int BM = 256, BK = 64, HALF = 128, HTB = HALF * BK * 2, NXCD = 8, WGM = 8;
__device__ __forceinline__ int lds_byte(int r, int c) { const int st = (r >> 4) * 2 + (c >> 5), rr = r & 15, cc = c & 31, ob = rr * 64 + cc * 2; return st * 1024 + (ob ^ (((ob >> 9) & 1) << 5)); }
__device__ __forceinline__ void stage_rc(int b, int& R, int& C) { const int st = b / 1024, sb = b % 1024, swz = sb ^ (((sb >> 9) & 1) << 5); R = (st >> 1) * 16 + swz / 64; C = (st & 1) * 32 + (swz % 64) / 2; }

struct Unit { int pm, pn, g, kt0, nt; };
struct GemmArgs { const bf16_t* A; const bf16_t* Bt; int lda, ldb, K; };

struct StaticOrder {
    int nM, nN, nwg, G, c, KT;
    __device__ void init(int M, int N, int bid_l, int K) { nM = M / BM; nN = N / BM; nwg = nM * nN; G = gridDim.x; c = bid_l; KT = K / BK; }
    __device__ bool next(int i, Unit& u) const {
        const long L = (long)i * G + c; if (L >= nwg) return false;
        int wgid = (int)L; { const int q = nwg / NXCD, r = nwg % NXCD, xcd = wgid % NXCD, off = wgid / NXCD; wgid = (xcd < r ? xcd * (q + 1) : r * (q + 1) + (xcd - r) * q) + off; }
        const int nig = WGM * nN, gid = wgid / nig, fm = gid * WGM, gsz = (nM - fm) < WGM ? (nM - fm) : WGM;
        u.pm = fm + ((wgid % nig) % gsz); u.pn = (wgid % nig) / gsz; u.g = 0; u.kt0 = 0; u.nt = KT; return true;
    }
    __device__ const char* aptr(const GemmArgs& g, const Unit& u) const { return (const char*)g.A + (size_t)u.pm * 256 * g.lda * 2; }
    __device__ const char* bptr(const GemmArgs& g, const Unit& u) const { return (const char*)g.Bt + (size_t)u.pn * 256 * g.ldb * 2; }
};
struct S5Order {
    int G, c, KT;
    __device__ void init(int shift, int bid_l, int K) { G = gridDim.x; c = (bid_l + shift) % gridDim.x; KT = K / BK; }
    __device__ bool next(int i, Unit& u) const { const int L = i * G + c; if (L >= 160) return false; u.g = L / 5; u.pm = L % 5; u.pn = 0; u.kt0 = 0; u.nt = KT; return true; }
    __device__ const char* aptr(const GemmArgs& g, const Unit& u) const { return (const char*)g.A + (size_t)(u.g * 1040 + u.pm * 256) * g.lda * 2; }
    __device__ const char* bptr(const GemmArgs& g, const Unit& u) const { return (const char*)g.Bt + (size_t)u.g * 256 * g.ldb * 2; }
};
struct TripleOrder {
    int nM, G, c;
    __device__ void init(int M, int bid_l) { nM = M / BM; G = gridDim.x; c = bid_l; }
    __device__ bool next(int i, Unit& u) const { const int L = (i / 3) * G + c; if (L >= nM * 4) return false; u.pm = L >> 2; u.pn = L & 3; u.g = i % 3; u.kt0 = 0; u.nt = 8; return true; }
    __device__ const char* aptr(const GemmArgs& g, const Unit& u) const { return (const char*)g.A + (size_t)u.g * SZ_TB512 + (size_t)u.pm * 256 * 512 * 2; }
    __device__ const char* bptr(const GemmArgs& g, const Unit& u) const { return (const char*)g.Bt + (size_t)(u.g * 1024 + u.pn * 256) * 512 * 2; }
};

struct ResOrder {
    StaticOrder so; int nsplit;
    __device__ void init(int nsplit_, int bid_l, int K) { so.init(16384, 1024, bid_l, K); nsplit = nsplit_; }
    __device__ bool next(int i, Unit& u) const {
        const int L = i * so.G + so.c;
        if (L < so.nwg) { so.next(i, u); u.pm += 1; return true; }
        const int sidx = L - so.nwg; if (sidx >= nsplit) return false;
        u.pm = 0; u.pn = sidx & 3; u.kt0 = (sidx >> 2) * 4; u.nt = 4; u.g = 1; return true;
    }
    __device__ const char* aptr(const GemmArgs& g, const Unit& u) const { return (const char*)g.A + (size_t)u.pm * 256 * g.lda * 2 + (size_t)u.kt0 * 128; }
    __device__ const char* bptr(const GemmArgs& g, const Unit& u) const { return (const char*)g.Bt + (size_t)u.pn * 256 * g.ldb * 2 + (size_t)u.kt0 * 128; }
};
template <class Epi, class Ord>
__device__ __forceinline__ void gemm_phase(LAS unsigned char* lds, const GemmArgs g, const Ord& S, const Epi& E, int tid_l) {
    const int tid = tid_l, wid = __builtin_amdgcn_readfirstlane(tid >> 6), lane = tid & 63, wr = wid >> 2, wc = wid & 3, fr = lane & 15, fq = lane >> 4;
    unsigned voffA, voffB;
    { int R, C; stage_rc(tid * 16, R, C); voffA = (unsigned)(R * g.lda + C) * 2u; voffB = (unsigned)(R * g.ldb + C) * 2u; }
    const size_t p64A = (size_t)64 * g.lda * 2, p64B = (size_t)64 * g.ldb * 2;
    const size_t kstep = (size_t)(BK * 2);
    const size_t hstepA = (size_t)HALF * g.lda * 2, hstepB = (size_t)HALF * g.ldb * 2;
    const unsigned ldsw = (unsigned)wid * 1024u;
    const int aoff = lds_byte(wr * 64 + fr, fq * 8), boff = lds_byte(wc * 32 + fr, fq * 8);
#define PG8_SA(b, h) (((b) * 2 + (h)) * HTB)
#define PG8_SB(b, h) ((4 + (b) * 2 + (h)) * HTB)
#define PG8_STAGE(bufoff, gbase, voff) do { _Pragma("unroll") for (int _i = 0; _i < 2; ++_i) \
        __builtin_amdgcn_global_load_lds((const unsigned*)((const char*)(gbase) + _i * p64_##voff + v_##voff), (LAS unsigned*)(lds + (bufoff) + ldsw + _i * 8192), 16, 0, 0); } while (0)
#define PG8_LDA(dst, b, h) do { _Pragma("unroll") for (int m = 0; m < 4; ++m) _Pragma("unroll") for (int k = 0; k < 2; ++k) dst[m][k] = *(const LAS bf16x8*)(lds + PG8_SA(b, h) + aoff + m * 2048 + k * 1024); } while (0)
#define PG8_LDB(dst, b, h) do { _Pragma("unroll") for (int n = 0; n < 2; ++n) _Pragma("unroll") for (int k = 0; k < 2; ++k) dst[n][k] = *(const LAS bf16x8*)(lds + PG8_SB(b, h) + boff + n * 2048 + k * 1024); } while (0)
#define PG8_MMA(ai, bj, At, Bt) do { __builtin_amdgcn_s_setprio(1); _Pragma("unroll") for (int m = 0; m < 4; ++m) _Pragma("unroll") for (int n = 0; n < 2; ++n) _Pragma("unroll") for (int k = 0; k < 2; ++k) \
        acc[ai][bj][m][n] = __builtin_amdgcn_mfma_f32_16x16x32_bf16(Bt[n][k], At[m][k], acc[ai][bj][m][n], 0, 0, 0); __builtin_amdgcn_s_setprio(0); } while (0)
#define p64_offA p64A
#define p64_offB p64B
#define v_offA voffA
#define v_offB voffB
#define PG8_WAIT_V(n) asm volatile("s_waitcnt vmcnt(" #n ")" ::: "memory")
#define PG8_WAIT_L(n) asm volatile("s_waitcnt lgkmcnt(" #n ")" ::: "memory")
#define PG8_BAR __builtin_amdgcn_s_barrier()
#define PG8_SCHED __builtin_amdgcn_sched_barrier(0)
    Unit cur, nxt; int ui = 0;
    if (!S.next(0, cur)) return;
    f32x4 acc[2][2][4][2];
#pragma unroll
    for (int a = 0; a < 2; ++a)
#pragma unroll
        for (int b = 0; b < 2; ++b)
#pragma unroll
            for (int m = 0; m < 4; ++m)
#pragma unroll
                for (int n = 0; n < 2; ++n) acc[a][b][m][n] = (f32x4){0.f, 0.f, 0.f, 0.f};
    bf16x8 At[4][2], B0[2][2], B1[2][2];
    const char* cA = S.aptr(g, cur); const char* cB = S.bptr(g, cur);
    PG8_STAGE(PG8_SB(0, 0), cB, offB); PG8_STAGE(PG8_SA(0, 0), cA, offA); PG8_STAGE(PG8_SB(0, 1), cB + hstepB, offB); PG8_STAGE(PG8_SA(0, 1), cA + hstepA, offA);
    if (wr == 1) PG8_BAR;
    PG8_WAIT_V(4); PG8_BAR;
    PG8_STAGE(PG8_SB(1, 0), cB + kstep, offB); PG8_STAGE(PG8_SA(1, 0), cA + kstep, offA); PG8_STAGE(PG8_SB(1, 1), cB + hstepB + kstep, offB);
    PG8_WAIT_V(6); PG8_BAR;
    for (;;) {
        const bool has_next = S.next(ui + 1, nxt);
        const int nt = cur.nt;
        const char* nA = has_next ? S.aptr(g, nxt) : cA; const char* nB = has_next ? S.bptr(g, nxt) : cB;
        for (int t = 0; t < nt; t += 2) {
            const bool last = (t == nt - 2);
            const char* a1 = cA + (size_t)(t + 1) * kstep;
            const char* a2 = last ? nA : cA + (size_t)(t + 2) * kstep; const char* b2 = last ? nB : cB + (size_t)(t + 2) * kstep;
            const char* a3 = a2 + kstep; const char* b3 = b2 + kstep;
            PG8_LDB(B0, 0, 0); PG8_SCHED; PG8_LDA(At, 0, 0); PG8_STAGE(PG8_SA(1, 1), a1 + hstepA, offA);
            PG8_WAIT_L(8); PG8_BAR; PG8_WAIT_L(0); PG8_MMA(0, 0, At, B0); PG8_BAR; PG8_SCHED;
            PG8_LDB(B1, 0, 1); PG8_STAGE(PG8_SB(0, 0), b2, offB);
            PG8_BAR; PG8_WAIT_L(0); PG8_MMA(0, 1, At, B1); PG8_BAR;
            PG8_LDA(At, 0, 1); PG8_STAGE(PG8_SA(0, 0), a2, offA);
            PG8_BAR; PG8_WAIT_L(0); PG8_MMA(1, 0, At, B0); PG8_BAR; PG8_SCHED;
            PG8_STAGE(PG8_SB(0, 1), b2 + hstepB, offB);
            PG8_WAIT_V(6); PG8_BAR; PG8_MMA(1, 1, At, B1); PG8_BAR;
            PG8_LDB(B0, 1, 0); PG8_SCHED; PG8_LDA(At, 1, 0); PG8_STAGE(PG8_SA(0, 1), a2 + hstepA, offA);
            PG8_WAIT_L(8); PG8_BAR; PG8_WAIT_L(0); PG8_MMA(0, 0, At, B0); PG8_BAR; PG8_SCHED;
            PG8_LDB(B1, 1, 1); PG8_STAGE(PG8_SB(1, 0), b3, offB);
            PG8_BAR; PG8_WAIT_L(0); PG8_MMA(0, 1, At, B1); PG8_BAR;
            PG8_LDA(At, 1, 1); PG8_STAGE(PG8_SA(1, 0), a3, offA);
            PG8_BAR; PG8_WAIT_L(0); PG8_MMA(1, 0, At, B0); PG8_BAR; PG8_SCHED;
            PG8_STAGE(PG8_SB(1, 1), b3 + hstepB, offB);
            PG8_WAIT_V(6); PG8_BAR; PG8_MMA(1, 1, At, B1); PG8_BAR;
        }
        E(acc, cur, wr, wc, fr, fq);
        if (!has_next) break;
#pragma unroll
        for (int a = 0; a < 2; ++a)
#pragma unroll
            for (int b = 0; b < 2; ++b)
#pragma unroll
                for (int m = 0; m < 4; ++m)
#pragma unroll
                    for (int n = 0; n < 2; ++n) acc[a][b][m][n] = (f32x4){0.f, 0.f, 0.f, 0.f};
        cur = nxt; cA = nA; cB = nB; ++ui;
    }
    PG8_WAIT_V(0);
    if (wr == 0) PG8_BAR;
    PG8_BAR;
#undef p64_offA
#undef p64_offB
#undef v_offA
#undef v_offB
#undef PG8_SA
#undef PG8_SB
#undef PG8_STAGE
#undef PG8_LDA
#undef PG8_LDB
#undef PG8_MMA
#undef PG8_WAIT_V
#undef PG8_WAIT_L
#undef PG8_BAR
#undef PG8_SCHED
}

typedef f32x4 AccT[2][2][4][2];
#define EPI_ROWS _Pragma("unroll") for (int ai = 0; ai < 2; ++ai) _Pragma("unroll") for (int m = 0; m < 4; ++m)
#define EPI_BN _Pragma("unroll") for (int bj = 0; bj < 2; ++bj) _Pragma("unroll") for (int n = 0; n < 2; ++n)
#define EPI_B _Pragma("unroll") for (int bj = 0; bj < 2; ++bj)

#define EPI_ROW (__builtin_amdgcn_sched_barrier(0), u.pm * 256 + ai * 128 + wr * 64 + m * 16 + fr)
#define EPI_COL(bj, n) (u.pn * 256 + (bj) * 128 + wc * 32 + (n) * 16 + 4 * fq)

struct EpiZ {
    bf16_t* ZA; bf16_t* ZB;
    __device__ __forceinline__ void operator()(const AccT& acc, const Unit& u, int wr, int wc, int fr, int fq) const {
        EPI_ROWS { const int row = EPI_ROW;
            EPI_BN { const int col = EPI_COL(bj, n); const f32x4 v = acc[ai][bj][m][n];
                bf16_t* dst = col < 1536 ? ZA + (size_t)row * 1536 + col : ZB + (size_t)row * 2048 + (col - 1536);
                st4bf(dst, v[0], v[1], v[2], v[3]); } }
    }
};
struct EpiLruGate {
    const bf16_t* XC; bf16_t* LA; bf16_t* LU; const float* ba; const float* bx; const float* lam;
    __device__ __forceinline__ void operator()(const AccT& acc, const Unit& u, int wr, int wc, int fr, int fq) const {
        EPI_B { __builtin_amdgcn_sched_barrier(0);
            const int g32 = (u.pn * 256 + bj * 128 + wc * 32) >> 5, dir = g32 >> 5, ch = (g32 & 31) * 16 + 4 * fq;
            float pba[4], pbx[4], psp[4];
            UNR for (int j = 0; j < 4; ++j) { const int c = dir * 512 + ch + j; pba[j] = ba[c]; pbx[j] = bx[c]; psp[j] = -8.0f * softplusf(-lam[c]); }
            EPI_ROWS { const int row = EPI_ROW;
                const f32x4 va = acc[ai][bj][m][0], vx = acc[ai][bj][m][1];
                float xc[4]; ld4bf(XC + (size_t)row * 512 + ch, xc);
                float la[4], uu[4];
                UNR for (int j = 0; j < 4; ++j) {
                    const float gr = sigm(va[j] + pba[j]), gi = sigm(vx[j] + pbx[j]);
                    la[j] = gr * psp[j];
                    uu[j] = __fsqrt_rn(fmaxf(1.0f - __expf(2.0f * la[j]), 0.f)) * gi * xc[j]; }
                const size_t o = ((size_t)dir * TOK + row) * 512 + ch;
                st4bf(LA + o, la[0], la[1], la[2], la[3]); st4bf(LU + o, uu[0], uu[1], uu[2], uu[3]); } }
    }
};
struct EpiS5E {
    float* E;
    __device__ __forceinline__ void operator()(const AccT& acc, const Unit& u, int wr, int wc, int fr, int fq) const {
        EPI_ROWS { const int row = EPI_ROW; if (row < 1040) {
            EPI_BN { const int col = EPI_COL(bj, n);
                *(f32x4*)(E + ((size_t)u.g * 1040 + row) * 256 + col) = acc[ai][bj][m][n]; } } }
    }
};
struct EpiS5Y {
    const bf16_t* ZA; bf16_t* YG; const float* dsk;
    __device__ __forceinline__ void operator()(const AccT& acc, const Unit& u, int wr, int wc, int fr, int fq) const {
        EPI_ROWS { const int row = EPI_ROW; if (row < 1040) {
            EPI_BN { const int col = EPI_COL(bj, n); const f32x4 v = acc[ai][bj][m][n];
                const int t = col >> 4, cp = col & 15, tk = s5_tok(row * 16 + t), ch = u.g * 16 + cp;
                float uv[4]; ld4bf(ZA + (size_t)tk * 1536 + 1024 + ch, uv);
                float y[4]; UNR for (int j = 0; j < 4; ++j) y[j] = gelu_t(v[j] + dsk[ch + j] * uv[j]);
                st4bf(YG + (size_t)tk * 512 + ch, y[0], y[1], y[2], y[3]); } } }
    }
};
struct EpiGlu {
    const bf16_t* YG; bf16_t* YC; const float* bg;
    __device__ __forceinline__ void operator()(const AccT& acc, const Unit& u, int wr, int wc, int fr, int fq) const {
        EPI_ROWS { const int row = EPI_ROW;
            EPI_BN { const int col = EPI_COL(bj, n); const f32x4 v = acc[ai][bj][m][n];
                float y[4]; ld4bf(YG + (size_t)row * 512 + col, y);
                UNR for (int j = 0; j < 4; ++j) y[j] *= sigm(v[j] + bg[col + j]);
                st4bf(YC + (size_t)row * 512 + col, y[0], y[1], y[2], y[3]); } }
    }
};
struct EpiLora {
    bf16_t* LW; bf16_t* IC; bf16_t* G; const float* w0; const float* a0;
    __device__ __forceinline__ void operator()(const AccT& acc, const Unit& u, int wr, int wc, int fr, int fq) const {
        const int blk = u.pn >> 1;
        if (blk < 2) {
            EPI_BN { __builtin_amdgcn_sched_barrier(0); const int col = EPI_COL(bj, n); float b[4];
                UNR for (int j = 0; j < 4; ++j) b[j] = w0[col + j];
                EPI_ROWS { const int row = EPI_ROW; const f32x4 v = acc[ai][bj][m][n]; float o[4];
                    UNR for (int j = 0; j < 4; ++j) { const float wl = -softplusf(-(b[j] + v[j])) - 0.5f; o[j] = -__expf(wl); }
                    st4bf(LW + ((size_t)blk * TOK + row) * 512 + (col & 511), o[0], o[1], o[2], o[3]); } }
        } else if (blk < 4) {
            EPI_BN { __builtin_amdgcn_sched_barrier(0); const int col = EPI_COL(bj, n) - 1024; float b[4];
                UNR for (int j = 0; j < 4; ++j) b[j] = a0[col + j];
                EPI_ROWS { const int row = EPI_ROW; const f32x4 v = acc[ai][bj][m][n]; float o[4];
                    UNR for (int j = 0; j < 4; ++j) o[j] = sigm(b[j] + v[j]);
                    st4bf(IC + ((size_t)(blk - 2) * TOK + row) * 512 + (col & 511), o[0], o[1], o[2], o[3]); } }
        } else {
            EPI_ROWS { const int row = EPI_ROW;
                EPI_BN { const int col = EPI_COL(bj, n) - 2048; const f32x4 v = acc[ai][bj][m][n];
                    st4bf(G + (size_t)row * 512 + col, v[0], v[1], v[2], v[3]); } }
        }
    }
};
struct EpiZg {
    bf16_t* ZG; int row0;
    __device__ __forceinline__ void operator()(const AccT& acc, const Unit& u, int wr, int wc, int fr, int fq) const {
        EPI_ROWS { const int row = row0 + EPI_ROW;
            EPI_BN { const int col = EPI_COL(bj, n); const f32x4 v = acc[ai][bj][m][n];
                st4bf(ZG + (size_t)row * 3072 + col, sigm(v[0]), sigm(v[1]), sigm(v[2]), sigm(v[3])); } }
    }
};
struct EpiMerge1 {
    const bf16_t* ZG; bf16_t* M; int row0;
    __device__ __forceinline__ void operator()(const AccT& acc, const Unit& u, int wr, int wc, int fr, int fq) const {
        EPI_ROWS { const int row = row0 + EPI_ROW;
            EPI_BN { const int col = EPI_COL(bj, n); const f32x4 v = acc[ai][bj][m][n];
                float gt[4]; ld4bf(ZG + (size_t)row * 3072 + u.g * 1024 + col, gt);
                float mv[4] = {0.f, 0.f, 0.f, 0.f}; if (u.g) ld4bf(M + (size_t)row * 1024 + col, mv);
                st4bf(M + (size_t)row * 1024 + col, mv[0] + gt[0] * v[0], mv[1] + gt[1] * v[1], mv[2] + gt[2] * v[2], mv[3] + gt[3] * v[3]); } }
    }
};
struct EpiRes {
    float* H; const float* gl; const float* gc; int row0; float* part;
    __device__ __forceinline__ void operator()(const AccT& acc, const Unit& u, int wr, int wc, int fr, int fq) const {
        if (u.g == 0) {
            EPI_ROWS { const int row = row0 + EPI_ROW; const float* gv = row < 256 ? gc : gl;
                EPI_BN { const int col = EPI_COL(bj, n); const f32x4 v = acc[ai][bj][m][n];
                    float* hp = H + (size_t)row * 1024 + col; f32x4 hv = *(f32x4*)hp; const f32x4 gg = *(const f32x4*)(gv + col);
                    hv += gg * v; *(f32x4*)hp = hv; } }
        } else {
            EPI_ROWS { const int row = row0 + EPI_ROW; const float* gv = row < 256 ? gc : gl;
                EPI_BN { const int col = EPI_COL(bj, n); const f32x4 v = acc[ai][bj][m][n];
                    *(f32x4*)(part + ((size_t)(u.kt0 >> 2) * 256 + row) * 1024 + col) = v; (void)gv; } }
        }
    }
};
struct EpiFfn {
    bf16_t* ACT; int row0;
    __device__ __forceinline__ void operator()(const AccT& acc, const Unit& u, int wr, int wc, int fr, int fq) const {
        EPI_ROWS { const int row = row0 + EPI_ROW;
            EPI_B { const int g32 = (u.pn * 256 + bj * 128 + wc * 32) >> 5, oc = g32 * 16 + 4 * fq;
                const f32x4 g = acc[ai][bj][m][0], up = acc[ai][bj][m][1];
                st4bf(ACT + (size_t)row * 2816 + oc, silu(g[0]) * up[0], silu(g[1]) * up[1], silu(g[2]) * up[2], silu(g[3]) * up[3]); } }
    }
};

template <class Map>
__device__ __forceinline__ void conv_T(const float* src, int src_ld, bf16_t* dst, int Nd, int K, Map map, float* sm, int shift, int tid_l, int bid_l) {
    const int tk = K / 64, ntile = (Nd / 64) * tk;
    for (int t = (bid_l + shift) % gridDim.x; t < ntile; t += gridDim.x) {
        const int n0 = (t / tk) * 64, k0 = (t % tk) * 64;
        { const int n = tid_l & 63, kq = tid_l >> 6; const int col = map(n0 + n);
            for (int e = 0; e < 8; ++e) { const int k = e * 8 + kq; sm[k * 65 + n] = col >= 0 ? src[(size_t)(k0 + k) * src_ld + col] : 0.f; } }
        __syncthreads();
        { const int k = tid_l & 63, nq = tid_l >> 6;
            for (int e = 0; e < 8; ++e) { const int n2 = e * 8 + nq; dst[(size_t)(n0 + n2) * K + k0 + k] = f2bf(sm[k * 65 + n2]); } }
        __syncthreads();
    }
}
struct MapIna { __device__ int operator()(int n) const { return n < 1024 ? n : (n < 1536 ? 2944 + (n - 1024) : (n < 3456 ? 1024 + (n - 1536) : -1)); } };
struct MapOff { int off; __device__ int operator()(int n) const { return off + n; } };
struct MapFfn { __device__ int operator()(int n) const { const int g32 = n >> 5, w = n & 31; return w < 16 ? g32 * 16 + w : 2816 + g32 * 16 + (w - 16); } };

__device__ __forceinline__ void norm_rows(float* H, const float* nw, const float* modl, const float* modc, int shoff, int scoff, bf16_t* HN, int row_begin, int tid_l, int bid_l,
                                          const float* part, int nparts, const float* pgate) {
    const int wid = tid_l >> 6, lane = tid_l & 63;
    for (int row = row_begin + bid_l * 8 + wid; row < TOK; row += gridDim.x * 8) {
        float* hp = H + (size_t)row * 1024; const float* mv = row < 256 ? modc : modl;
        f32x4 x[4]; float ss = 0.f;
        UNR for (int e = 0; e < 4; ++e) x[e] = *(const f32x4*)(hp + e * 256 + lane * 4);
        if (part && row < 256) {
            UNR for (int e = 0; e < 4; ++e) { const int c = e * 256 + lane * 4; f32x4 a = (f32x4){0.f, 0.f, 0.f, 0.f};
                for (int k = 0; k < nparts; ++k) a += *(const f32x4*)(part + ((size_t)k * 256 + row) * 1024 + c);
                x[e] += *(const f32x4*)(pgate + c) * a; *(f32x4*)(hp + c) = x[e]; } }
        UNR for (int e = 0; e < 4; ++e) ss += x[e][0] * x[e][0] + x[e][1] * x[e][1] + x[e][2] * x[e][2] + x[e][3] * x[e][3];
        ss = wave_sum(ss, lane); const float sc = rsqrtf(ss * (1.0f / 1024.0f) + 1e-6f);
        UNR for (int e = 0; e < 4; ++e) { const int c = e * 256 + lane * 4; float y[4];
            UNR for (int j = 0; j < 4; ++j) y[j] = x[e][j] * sc * nw[c + j] * (1.0f + mv[scoff + c + j]) + mv[shoff + c + j];
            st4bf(HN + (size_t)row * 1024 + c, y[0], y[1], y[2], y[3]); }
    }
}

typedef float f32x2 __attribute__((ext_vector_type(2)));
__device__ __forceinline__ float quad_sum(float v) {
    v += __int_as_float(__builtin_amdgcn_mov_dpp(__float_as_int(v), 0xB1, 0xF, 0xF, true));
    v += __int_as_float(__builtin_amdgcn_mov_dpp(__float_as_int(v), 0x4E, 0xF, 0xF, true));
    return v;
}
constexpr int WCH = 260, WNC = 64, WSC = 13, WVEC = 6 * 64;
template <int R, bool WITH_Y, bool HASV>
__device__ __forceinline__ void wkv_steps(f32x2 (&s)[R][8], const float* stg, float* sy, int sys, int nst, int row0, int sub) {
    for (int jj = 0; jj < nst; ++jj) {
        const float* base = stg + jj * WVEC + sub * 16;
        f32x2 kk[8];
#pragma unroll
        for (int i = 0; i < 4; ++i) { const f32x4 t = *(const f32x4*)(base + 64 + i * 4); kk[2 * i] = (f32x2){t[0], t[1]}; kk[2 * i + 1] = (f32x2){t[2], t[3]}; }
        float nsa[R], vv[R];
#pragma unroll
        for (int r = 0; r < R; ++r) { f32x2 a = s[r][0] * kk[0];
#pragma unroll
            for (int i = 1; i < 8; ++i) a = __builtin_elementwise_fma(s[r][i], kk[i], a);
            nsa[r] = -quad_sum(a[0] + a[1]); vv[r] = HASV ? stg[jj * WVEC + 320 + row0 + r] : 0.f; }
        f32x2 w[8], bb[8], kd[8];
#pragma unroll
        for (int i = 0; i < 4; ++i) { const f32x4 t0 = *(const f32x4*)(base + i * 4), t1 = *(const f32x4*)(base + 128 + i * 4);
            w[2 * i] = (f32x2){t0[0], t0[1]}; w[2 * i + 1] = (f32x2){t0[2], t0[3]}; bb[2 * i] = (f32x2){t1[0], t1[1]}; bb[2 * i + 1] = (f32x2){t1[2], t1[3]};
            if (HASV) { const f32x4 t2 = *(const f32x4*)(base + 192 + i * 4); kd[2 * i] = (f32x2){t2[0], t2[1]}; kd[2 * i + 1] = (f32x2){t2[2], t2[3]}; } }
#pragma unroll
        for (int r = 0; r < R; ++r) { const f32x2 v2 = (f32x2){vv[r], vv[r]}, n2 = (f32x2){nsa[r], nsa[r]};
#pragma unroll
            for (int i = 0; i < 8; ++i) { const f32x2 t = HASV ? __builtin_elementwise_fma(n2, bb[i], v2 * kd[i]) : n2 * bb[i]; s[r][i] = __builtin_elementwise_fma(s[r][i], w[i], t); } }
        if (WITH_Y) {
            f32x2 rr[8];
#pragma unroll
            for (int i = 0; i < 4; ++i) { const f32x4 t = *(const f32x4*)(base + 256 + i * 4); rr[2 * i] = (f32x2){t[0], t[1]}; rr[2 * i + 1] = (f32x2){t[2], t[3]}; }
#pragma unroll
            for (int r = 0; r < R; ++r) { f32x2 a = s[r][0] * rr[0];
#pragma unroll
                for (int i = 1; i < 8; ++i) a = __builtin_elementwise_fma(s[r][i], rr[i], a);
                const float y = quad_sum(a[0] + a[1]); if (sub == 0) sy[jj * sys + row0 + r] = y; }
        }
    }
}
__device__ __forceinline__ void wkv_stage_all(float* smem, const bf16_t* ZBp, const bf16_t* LWp, const bf16_t* ICp, float mur, float muk, float muv, float kkwv, float kawv,
                                              int dir, int head, int c0, int sc, int wd, int ln) {
    const int col = head * 64 + ln;
    float zr[7][3], zk[7][3], zv[7][3], lwv[7], icv[7];
#pragma unroll
    for (int it = 0; it < 7; ++it) { const int pr = wd + it * 8;
        if (pr < 4 * WSC) { const int qq = pr / WSC, jj = pr % WSC, tk = tok_of(dir, (c0 + qq) * WCH + sc * WSC + jj);
            const int lo = tk < 256 ? 0 : 256, hi = tk < 256 ? 256 : TOK; const bool hp = tk - 1 >= lo, hn = tk + 1 < hi;
            const bf16_t* z0 = ZBp + (size_t)tk * 2048 + col;
            zr[it][1] = bf2f(z0[0]); zk[it][1] = bf2f(z0[512]); zv[it][1] = bf2f(z0[1024]);
            zr[it][0] = hp ? bf2f(z0[-2048]) : 0.f; zk[it][0] = hp ? bf2f(z0[-2048 + 512]) : 0.f; zv[it][0] = hp ? bf2f(z0[-2048 + 1024]) : 0.f;
            zr[it][2] = hn ? bf2f(z0[2048]) : 0.f; zk[it][2] = hn ? bf2f(z0[2048 + 512]) : 0.f; zv[it][2] = hn ? bf2f(z0[2048 + 1024]) : 0.f;
            const size_t o = ((size_t)dir * TOK + tk) * 512 + col; lwv[it] = bf2f(LWp[o]); icv[it] = bf2f(ICp[o]); } }
#pragma unroll
    for (int it = 0; it < 7; ++it) { const int pr = wd + it * 8;
        if (pr < 4 * WSC) { float* dst = smem + pr * WVEC;
            const float r = zr[it][1] + mur * (0.5f * (zr[it][0] + zr[it][2]) - zr[it][1]);
            const float k = zk[it][1] + muk * (0.5f * (zk[it][0] + zk[it][2]) - zk[it][1]);
            const float v = zv[it][1] + muv * (0.5f * (zv[it][0] + zv[it][2]) - zv[it][1]);
            const float kx = k * kkwv; const float ssq = wave_sum(kx * kx, ln); const float kk = kx * rsqrtf(ssq + 1e-12f);
            const float w = __expf(lwv[it]), ic = icv[it];
            dst[ln] = w; dst[64 + ln] = kk; dst[128 + ln] = kk * ic; dst[192 + ln] = k * (1.0f + (ic - 1.0f) * kawv); dst[256 + ln] = r; dst[320 + ln] = v; } }
}

__device__ __forceinline__ int launder_s(int i) { asm volatile("" : "+s"(i)); return i; }
#define IN(i) (p.in[launder_s(i)])
constexpr int PH_PER_LAYER = 19;
constexpr int NPHASE = 1 + NLAYER * PH_PER_LAYER + 1;

#define ZA ((bf16_t*)(ws + X_ZA))
#define ZB ((bf16_t*)(ws + OFF_ZB))
#define XC ((bf16_t*)(ws + X_XC))
#define LA ((bf16_t*)(ws + X_LA))
#define LU ((bf16_t*)(ws + X_LU))
#define A5 ((bf16_t*)(ws + X_A5))
#define YS ((bf16_t*)(ws + OFF_YS))
#define YA YS
#define YB (YS + (size_t)TOK * 512)
#define YC (YS + (size_t)2 * TOK * 512)
#define S5E ((float*)(ws + OFF_HN))
#define CA ((float*)(ws + M_CA))
#define CB ((float*)(ws + M_CB))
#define HIN ((float*)(ws + M_HIN))
#define LW ((bf16_t*)(ws + X_LW))
#define IC ((bf16_t*)(ws + X_IC))
#define GG ((bf16_t*)(ws + X_G))
#define YD1 ((bf16_t*)(ws + X_YD1))
#define LORAA ((bf16_t*)(ws + X_LORAA))
#define PQ ((float*)(ws + X_PQ))
#define SCS ((float*)(ws + X_SC))
#define RT ((bf16_t*)(ws + X_RT))
#define ZG ((bf16_t*)(ws + X_ZG))
#define ACT ((bf16_t*)(ws + X_ACT))
#define MM ((bf16_t*)(ws + X_M))
template <int KSEL>
__device__ __forceinline__ void run_phase(const Params& p, int ph, unsigned char* shm, int wv) {
    unsigned char* ws = p.ws;
    float* sm = (float*)shm;
    LAS unsigned char* lds = (LAS unsigned char*)shm;
#ifdef TID_MBCNT
    int tid; asm volatile("v_mbcnt_lo_u32_b32 %0, -1, 0\n\tv_mbcnt_hi_u32_b32 %0, -1, %0" : "=v"(tid)); tid += wv * 64;
#else
    int tid = threadIdx.x; asm volatile("" : "+v"(tid)); (void)wv;
#endif
    int bid = blockIdx.x; asm volatile("" : "+s"(bid));
#define wid (tid >> 6)
#define lane (tid & 63)
#define gtid ((size_t)bid * NTHR + tid)
#define gthreads ((size_t)gridDim.x * NTHR)
    float* H = (float*)(ws + OFF_H);
    bf16_t* HN = (bf16_t*)(ws + OFF_HN);
    float* MODV = (float*)(ws + M_MODV);
    float* PW = (float*)(ws + M_PW);
    float* BBT = (float*)(ws + M_BB);

    if (KSEL == 100 && ph != 0) return;
    if (KSEL == 101 && ph != NPHASE - 1) return;
    if (KSEL >= 0 && KSEL < 100 && (ph == 0 || ph == NPHASE - 1)) return;
    if (ph == 0) {
        for (int vb = bid; vb < 48 + 32 + 512; vb += gridDim.x) {
            if (vb < 48) {
                __syncthreads();
                for (int k = tid; k < 1024; k += NTHR) { sm[k] = silu(IN(I_C)[k]); sm[1024 + k] = silu(IN(I_CCTX)[k]); }
                __syncthreads();
                const int idx = vb * NTHR + tid, layer = idx / 6144, n = idx % 6144;
                const float* w = IN(I_WMOD) + (size_t)layer * 1024 * 6144 + n;
                float al = 0.f, ac = 0.f;
                for (int k = 0; k < 1024; ++k) { const float wv = w[(size_t)k * 6144]; al += sm[k] * wv; ac += sm[1024 + k] * wv; }
                const float b = IN(I_BMOD)[layer * 6144 + n];
                MODV[(layer * 2 + 0) * 6144 + n] = al + b; MODV[(layer * 2 + 1) * 6144 + n] = ac + b;
            } else if (vb < 80) {
                const int idx = (vb - 48) * NTHR + tid;
                const int pp = idx & 63, g = (idx >> 6) & 31, ld = idx >> 11;
                const float lre = IN(I_S5LRE)[idx], lim = IN(I_S5LIM)[idx], step = __expf(IN(I_S5STEP)[ld * 32 + g]);
                const float xr = lre * step, ang = lim * step;
                for (int t = 0; t <= 16; ++t) { const float mg = expf(xr * t); PW[((size_t)idx * 17 + t) * 2] = mg * cosf(ang * t); PW[((size_t)idx * 17 + t) * 2 + 1] = mg * sinf(ang * t); }
                const float mg = expf(xr), lbim = mg * sinf(ang), sh = sinf(0.5f * ang);
                const float nr = expm1f(xr) * cosf(ang) - 2.0f * sh * sh, den = lre * lre + lim * lim;
                const float fre = (nr * lre + lbim * lim) / den, fim = (lbim * lre - nr * lim) / den;
                for (int c = 0; c < 16; ++c) { const float br = IN(I_S5BRE)[(size_t)idx * 16 + c], bi = IN(I_S5BIM)[(size_t)idx * 16 + c];
                    BBT[((size_t)idx * 16 + c) * 2] = fre * br - fim * bi; BBT[((size_t)idx * 16 + c) * 2 + 1] = fre * bi + fim * br; }
                (void)pp;
            } else {
                const int cb = vb - 80;
                for (size_t i = (size_t)cb * NTHR + tid; i < (size_t)TOK * 256; i += (size_t)512 * NTHR) {
                    const f32x4 v = i < (size_t)256 * 256 ? ((const f32x4*)IN(I_CTX))[i] : ((const f32x4*)IN(I_X))[i - (size_t)256 * 256];
                    ((f32x4*)H)[i] = v; }
            }
        }
        return;
    }
    if (ph == NPHASE - 1) {
        const float* nw = IN(I_NORMF);
        for (int row = 256 + bid * 8 + wid; row < TOK; row += gridDim.x * 8) {
            const float* hp = H + (size_t)row * 1024; f32x4 x[4]; float ss = 0.f;
            UNR for (int e = 0; e < 4; ++e) { x[e] = *(const f32x4*)(hp + e * 256 + lane * 4); ss += x[e][0] * x[e][0] + x[e][1] * x[e][1] + x[e][2] * x[e][2] + x[e][3] * x[e][3]; }
            ss = wave_sum(ss, lane); const float sc = rsqrtf(ss * (1.0f / 1024.0f) + 1e-6f);
            UNR for (int e = 0; e < 4; ++e) { const int c = e * 256 + lane * 4; f32x4 y; UNR for (int j = 0; j < 4; ++j) y[j] = x[e][j] * sc * nw[c + j];
                *(f32x4*)(p.out + (size_t)(row - 256) * 1024 + c) = y; }
        }
        return;
    }
    const int L = (ph - 1) / PH_PER_LAYER, k = (ph - 1) % PH_PER_LAYER;
    const bool last = (L == NLAYER - 1);
    const float* modl = MODV + (L * 2 + 0) * 6144; const float* modc = MODV + (L * 2 + 1) * 6144;
    const int row0 = last ? 256 : 0, Mrows = last ? 16384 : TOK;

    if (KSEL >= 0 && k != KSEL) return;
    switch (k) {
    case 0: {
        conv_T(IN(I_WIN) + (size_t)L * 1024 * 6528, 6528, (bf16_t*)(ws + W_INA), 3584, 1024, MapIna(), sm, 0, tid, bid);
        conv_T(IN(I_WGLU) + (size_t)L * 512 * 512, 512, (bf16_t*)(ws + W_GLU), 512, 512, MapOff{0}, sm, 128, tid, bid);
        {
            bf16_t* W = (bf16_t*)(ws + W_LRU); const float* pwa = IN(I_WA); const float* pwx = IN(I_WX);
            for (size_t i = gtid; i < (size_t)2048 * 512; i += gthreads) { const int n = (int)(i >> 9), kk = (int)(i & 511);
                const int g32 = n >> 5, which = (n & 31) >> 4, dir = g32 >> 5, ch = (g32 & 31) * 16 + (n & 15), head = ch >> 6, j = ch & 63;
                float v = 0.f; if ((kk >> 6) == head) v = (which ? pwx : pwa)[((((size_t)L * 2 + dir) * 8 + head) * 64 + (kk & 63)) * 64 + j];
                W[i] = f2bf(v); }
        }
        {
            bf16_t* W = (bf16_t*)(ws + W_LORA);
            for (size_t i = gtid; i < (size_t)2560 * 384; i += gthreads) { const int n = (int)(i / 384), kk = (int)(i % 384);
                const int blk = n >> 9, ch = n & 511; float v = 0.f;
                if (blk < 2) { if ((kk >> 6) == blk) v = IN(I_W2)[(((size_t)L * 2 + blk) * 64 + (kk & 63)) * 512 + ch]; }
                else if (blk < 4) { if ((kk >> 6) == blk) v = IN(I_A2)[(((size_t)L * 2 + (blk - 2)) * 64 + (kk & 63)) * 512 + ch]; }
                else { if (kk >= 256) v = IN(I_G2)[((size_t)L * 128 + (kk - 256)) * 512 + ch]; }
                W[i] = f2bf(v); }
        }
        {
            float* KT = (float*)(ws + M_KT);
            const float* cre = IN(I_S5CRE) + (size_t)L * 2 * 32 * 16 * 64; const float* cim = IN(I_S5CIM) + (size_t)L * 2 * 32 * 16 * 64;
            const float* pw = PW + (size_t)L * 2 * 32 * 64 * 17 * 2; const float* bb = BBT + (size_t)L * 2 * 32 * 64 * 16 * 2;
            for (size_t i = gtid; i < (size_t)2 * 32 * 16 * 256; i += gthreads) {
                const int c = (int)(i & 15), cp = (int)((i >> 4) & 15), tau = (int)((i >> 8) & 15), dg = (int)(i >> 12);
                const float* cr = cre + ((size_t)dg * 16 + cp) * 64; const float* ci = cim + ((size_t)dg * 16 + cp) * 64;
                const float* pwd = pw + (size_t)dg * 64 * 34 + tau * 2; const float* bbd = bb + (size_t)dg * 64 * 32 + c * 2;
                float v = 0.f;
#pragma unroll 8
                for (int pp = 0; pp < 64; ++pp) { const float pr = pwd[pp * 34], pi = pwd[pp * 34 + 1], br = bbd[pp * 32], bi = bbd[pp * 32 + 1];
                    v += cr[pp] * (pr * br - pi * bi) - ci[pp] * (pr * bi + pi * br); }
                KT[i] = v; }
        }
        norm_rows(H, IN(I_NORM1) + L * 1024, modl, modc, 0, 1024, HN, 0, tid, bid, L > 0 ? (const float*)(ws + X_RT) : nullptr, 11, MODV + ((L > 0 ? L - 1 : 0) * 2 + 1) * 6144 + 5120);
    } break;
    case 1: {
        GemmArgs g{HN, (const bf16_t*)(ws + W_INA), 1024, 1024, 1024}; StaticOrder S; S.init(TOK, 3584, bid, 1024);
        gemm_phase(lds, g, S, EpiZ{ZA, ZB}, tid);
    } break;
    case 2: {
        const float* cw = IN(I_CONVW) + L * 2048; const float* cb = IN(I_CONVB) + L * 512;
        { const int cg8 = (int)(gtid & 63) * 8; float w0[8], w1[8], w2[8], w3[8], b8[8];
          UNR for (int e = 0; e < 8; ++e) { w0[e] = cw[cg8 + e]; w1[e] = cw[512 + cg8 + e]; w2[e] = cw[1024 + cg8 + e]; w3[e] = cw[1536 + cg8 + e]; b8[e] = cb[cg8 + e]; }
          for (size_t tk0 = gtid >> 6; tk0 < (size_t)TOK; tk0 += gthreads >> 6) { const int tk = (int)tk0, lo = tk < 256 ? 0 : 256, hi = tk < 256 ? 256 : TOK;
            float x0[8], x1[8], x2[8], x3[8], a[8]; const bf16_t* zp = ZA + (size_t)tk * 1536 + cg8;
            if (tk - 2 >= lo) ld8bf(zp - 2 * 1536, x0); else { UNR for (int e = 0; e < 8; ++e) x0[e] = 0.f; }
            if (tk - 1 >= lo) ld8bf(zp - 1536, x1); else { UNR for (int e = 0; e < 8; ++e) x1[e] = 0.f; }
            ld8bf(zp, x2);
            if (tk + 1 < hi) ld8bf(zp + 1536, x3); else { UNR for (int e = 0; e < 8; ++e) x3[e] = 0.f; }
            UNR for (int e = 0; e < 8; ++e) a[e] = b8[e] + w0[e] * x0[e] + w1[e] * x1[e] + w2[e] * x2[e] + w3[e] * x3[e];
            st8bf(XC + (size_t)tk * 512 + cg8, a); } }
        for (size_t i = gtid; i < (size_t)32 * 1040 * 16; i += gthreads) { const int j = (int)(i & 15); const int s = (int)((i >> 4) % 1040), g = (int)((i >> 4) / 1040);
            const int tk = s5_tok(s * 16 + j); const u32x4* src = (const u32x4*)(ZA + (size_t)tk * 1536 + 1024 + g * 16); u32x4* dst = (u32x4*)(A5 + ((size_t)g * 1040 + s) * 512 + j * 16);
            dst[0] = src[0]; dst[1] = src[1]; }
        {
            bf16_t* WY = (bf16_t*)(ws + W_S5Y); bf16_t* WE = (bf16_t*)(ws + W_S5E); const float* KT = (const float*)(ws + M_KT);
            const float* cre = IN(I_S5CRE) + (size_t)L * 2 * 32 * 16 * 64; const float* cim = IN(I_S5CIM) + (size_t)L * 2 * 32 * 16 * 64;
            const float* pw = PW + (size_t)L * 2 * 32 * 64 * 17 * 2; const float* bb = BBT + (size_t)L * 2 * 32 * 64 * 16 * 2;
            for (size_t i8 = gtid; i8 < (size_t)32 * 256 * 64; i8 += gthreads) {
                const int kk0 = (int)(i8 & 63) * 8, n = (int)((i8 >> 6) & 255), g = (int)(i8 >> 14), t = n >> 4, cp = n & 15; float v[8];
                if (kk0 < 256) { const int j = kk0 >> 4, c0 = kk0 & 15;
                    UNR for (int e = 0; e < 8; ++e) v[e] = 0.f;
                    if (t >= j) { const float* kp = KT + ((((size_t)0 * 32 + g) * 16 + (t - j)) * 16 + cp) * 16 + c0; const f32x4 a0 = *(const f32x4*)kp, a1 = *(const f32x4*)(kp + 4);
                        UNR for (int e = 0; e < 4; ++e) { v[e] += a0[e]; v[4 + e] += a1[e]; } }
                    if (j >= t) { const float* kp = KT + ((((size_t)1 * 32 + g) * 16 + (j - t)) * 16 + cp) * 16 + c0; const f32x4 a0 = *(const f32x4*)kp, a1 = *(const f32x4*)(kp + 4);
                        UNR for (int e = 0; e < 4; ++e) { v[e] += a0[e]; v[4 + e] += a1[e]; } } }
                else { const int d = (kk0 - 256) >> 7, pp0 = ((kk0 - 256) & 127) >> 1; const int ep = d == 0 ? t + 1 : 16 - t;
                    const f32x4 cr = *(const f32x4*)(cre + ((size_t)(d * 32 + g) * 16 + cp) * 64 + pp0), ci = *(const f32x4*)(cim + ((size_t)(d * 32 + g) * 16 + cp) * 64 + pp0);
                    UNR for (int e = 0; e < 4; ++e) { const float* pq = pw + ((size_t)(d * 32 + g) * 64 + pp0 + e) * 34 + ep * 2; const float pr = pq[0], pi = pq[1];
                        v[2 * e] = cr[e] * pr - ci[e] * pi; v[2 * e + 1] = -(cr[e] * pi + ci[e] * pr); } }
                st8bf(WY + i8 * 8, v); }
            for (size_t i8 = gtid; i8 < (size_t)32 * 256 * 32; i8 += gthreads) {
                const int kk0 = (int)(i8 & 31) * 8, n = (int)((i8 >> 5) & 255), g = (int)(i8 >> 13), d = n >> 7, pp = (n & 127) >> 1, ri = n & 1, j = kk0 >> 4, c0 = kk0 & 15;
                const int ep = d == 0 ? 15 - j : j;
                const float pr = pw[((size_t)(d * 32 + g) * 64 + pp) * 34 + ep * 2], pi = pw[((size_t)(d * 32 + g) * 64 + pp) * 34 + ep * 2 + 1];
                const float* bp = bb + ((size_t)(d * 32 + g) * 64 + pp) * 32 + c0 * 2; float v[8];
                UNR for (int e = 0; e < 8; e += 2) { const f32x4 b4 = *(const f32x4*)(bp + e * 2);
                    v[e] = ri == 0 ? pr * b4[0] - pi * b4[1] : pr * b4[1] + pi * b4[0]; v[e + 1] = ri == 0 ? pr * b4[2] - pi * b4[3] : pr * b4[3] + pi * b4[2]; }
                st8bf(WE + i8 * 8, v); }
        }
    } break;
    case 3: {
        { GemmArgs g{XC, (const bf16_t*)(ws + W_LRU), 512, 512, 512}; StaticOrder S; S.init(TOK, 2048, bid, 512);
          gemm_phase(lds, g, S, EpiLruGate{XC, LA, LU, IN(I_BA) + L * 1024, IN(I_BX) + L * 1024, IN(I_LAM) + L * 1024}, tid); }
        asm volatile("" : "+v"(tid));
        { GemmArgs g{A5, (const bf16_t*)(ws + W_S5E), 512, 256, 256}; S5Order S; S.init(248, bid, 256);
          gemm_phase(lds, g, S, EpiS5E{S5E}, tid); }
    } break;
    case 4: {
        for (int task = bid; task < 520 + 256; task += gridDim.x) {
            if (task < 520) { const int c = task >> 1, dir = task & 1, ch = tid; float As = 0.f, Bs = 0.f;
                for (int j0 = 0; j0 < 64; j0 += 16) { float la[16], uu[16];
                    UNR for (int j = 0; j < 16; ++j) { const int tk = tok_of(dir, c * 64 + j0 + j); const size_t o = ((size_t)dir * TOK + tk) * 512 + ch; la[j] = bf2f(LA[o]); uu[j] = bf2f(LU[o]); }
                    UNR for (int j = 0; j < 16; ++j) { As += la[j]; Bs = __expf(la[j]) * Bs + uu[j]; } }
                CA[(dir * 260 + c) * 512 + ch] = As; CB[(dir * 260 + c) * 512 + ch] = Bs;
            } else {
                const int idx = (task - 520) * 32 + (tid & 31), seg = tid >> 5;
                const int pp = idx & 63, dir = (idx >> 6) & 1, g = idx >> 7;
                const float* pw = PW + ((((size_t)L * 2 + dir) * 32 + g) * 64 + pp) * 34; const float ar = pw[32], ai = pw[33];
                const int cb = dir * 128 + pp * 2;
                float hr = 0.f, hi = 0.f, pr = 1.f, pi = 0.f;
                for (int q0 = seg * 65; q0 < seg * 65 + 65; q0 += 13) { float er[13], ei[13];
                    UNR for (int j = 0; j < 13; ++j) { const int q = q0 + j, sx = dir == 0 ? q : (q < 16 ? 15 - q : 1055 - q); const float* ep = S5E + ((size_t)g * 1040 + sx) * 256 + cb; er[j] = ep[0]; ei[j] = ep[1]; }
                    UNR for (int j = 0; j < 13; ++j) { const float nr = ar * hr - ai * hi + er[j], ni = ar * hi + ai * hr + ei[j]; hr = nr; hi = ni;
                        const float qr = ar * pr - ai * pi, qi = ar * pi + ai * pr; pr = qr; pi = qi; } }
                __syncthreads();
                sm[(seg * 32 + (tid & 31)) * 2] = hr; sm[(seg * 32 + (tid & 31)) * 2 + 1] = hi;
                __syncthreads();
                hr = 0.f; hi = 0.f;
                for (int k2 = 0; k2 < seg; ++k2) { const float er = sm[(k2 * 32 + (tid & 31)) * 2], ei = sm[(k2 * 32 + (tid & 31)) * 2 + 1];
                    const float nr = pr * hr - pi * hi + er, ni = pr * hi + pi * hr + ei; hr = nr; hi = ni; }
                for (int q0 = seg * 65; q0 < seg * 65 + 65; q0 += 13) { float er[13], ei[13];
                    UNR for (int j = 0; j < 13; ++j) { const int q = q0 + j, sx = dir == 0 ? q : (q < 16 ? 15 - q : 1055 - q); const float* ep = S5E + ((size_t)g * 1040 + sx) * 256 + cb; er[j] = ep[0]; ei[j] = ep[1]; }
                    UNR for (int j = 0; j < 13; ++j) { const int q = q0 + j, sx = dir == 0 ? q : (q < 16 ? 15 - q : 1055 - q);
                        *(unsigned*)(A5 + ((size_t)g * 1040 + sx) * 512 + 256 + cb) = pack2(hr, hi);
                        const float nr = ar * hr - ai * hi + er[j], ni = ar * hi + ai * hr + ei[j]; hr = nr; hi = ni; } }
                __syncthreads();
            }
        }
    } break;
    case 5: {
        if (bid < 2) { const int dir = bid, ch = tid; float h = 0.f;
            for (int c0 = 0; c0 < 260; c0 += 13) { float a[13], b[13];
                UNR for (int j = 0; j < 13; ++j) { a[j] = CA[(dir * 260 + c0 + j) * 512 + ch]; b[j] = CB[(dir * 260 + c0 + j) * 512 + ch]; }
                UNR for (int j = 0; j < 13; ++j) { HIN[(dir * 260 + c0 + j) * 512 + ch] = h; h = __expf(a[j]) * h + b[j]; } } }
        __syncthreads(); asm volatile("" : "+v"(tid));
        { GemmArgs g{A5, (const bf16_t*)(ws + W_S5Y), 512, 512, 512}; S5Order S; S.init(254, bid, 512);
          gemm_phase(lds, g, S, EpiS5Y{ZA, XC, IN(I_S5D) + L * 512}, tid); }
    } break;
    case 6: {
        for (int ct = bid; ct < 260; ct += gridDim.x) { const int ch = tid;
            float h = HIN[(0 * 260 + ct) * 512 + ch];
            for (int j0 = 0; j0 < 64; j0 += 16) { float la[16], uu[16];
                UNR for (int j = 0; j < 16; ++j) { const size_t o = (size_t)(ct * 64 + j0 + j) * 512 + ch; la[j] = bf2f(LA[o]); uu[j] = bf2f(LU[o]); }
                UNR for (int j = 0; j < 16; ++j) { const size_t o = (size_t)(ct * 64 + j0 + j) * 512 + ch; h = __expf(la[j]) * h + uu[j]; YA[o] = f2bf(h); } }
            const int c1 = ct < 4 ? 3 - ct : 263 - ct; h = HIN[(1 * 260 + c1) * 512 + ch];
            for (int j0 = 0; j0 < 64; j0 += 16) { float la[16], uu[16], ga[16], hf[16];
                UNR for (int j = 0; j < 16; ++j) { const int tk = ct * 64 + 63 - j0 - j; const size_t o = (size_t)tk * 512 + ch, o1 = (size_t)TOK * 512 + o;
                    la[j] = bf2f(LA[o1]); uu[j] = bf2f(LU[o1]); ga[j] = bf2f(ZA[(size_t)tk * 1536 + 512 + ch]); hf[j] = bf2f(YA[o]); }
                UNR for (int j = 0; j < 16; ++j) { const int tk = ct * 64 + 63 - j0 - j; const size_t o = (size_t)tk * 512 + ch;
                    h = __expf(la[j]) * h + uu[j]; YA[o] = f2bf(gelu_t(ga[j]) * (hf[j] + h)); } } }
        __syncthreads(); asm volatile("" : "+v"(tid));
        { GemmArgs g{XC, (const bf16_t*)(ws + W_GLU), 512, 512, 512}; StaticOrder S; S.init(TOK, 512, bid, 512);
          gemm_phase(lds, g, S, EpiGlu{XC, YC, IN(I_BGLU) + L * 512}, tid); }
    } break;
    case 7: {
        const float* mu = IN(I_MU) + L * 1920;
        for (size_t i = gtid; i < (size_t)TOK * 48; i += gthreads) { const int tk = (int)(i / 48), q = (int)(i % 48) * 8;
            const int lo = tk < 256 ? 0 : 256, hi = tk < 256 ? 256 : TOK; const bf16_t* zp = ZB + (size_t)tk * 2048 + 1536 + q;
            float z[8], zp1[8], zn1[8], o[8];
            ld8bf(zp, z);
            if (tk - 1 >= lo) ld8bf(zp - 2048, zp1); else { UNR for (int e = 0; e < 8; ++e) zp1[e] = 0.f; }
            if (tk + 1 < hi) ld8bf(zp + 2048, zn1); else { UNR for (int e = 0; e < 8; ++e) zn1[e] = 0.f; }
            UNR for (int e = 0; e < 8; ++e) { const float zz = z[e] + mu[1536 + q + e] * (0.5f * (zp1[e] + zn1[e]) - z[e]); o[e] = q < 128 ? tanhf(zz) : (q < 256 ? zz : sigm(zz)); }
            st8bf(LORAA + (size_t)tk * 384 + q, o); }
    } break;
    case 8: {
        GemmArgs g{LORAA, (const bf16_t*)(ws + W_LORA), 384, 384, 384}; StaticOrder S; S.init(TOK, 2560, bid, 384);
        gemm_phase(lds, g, S, EpiLora{LW, IC, GG, IN(I_W0) + L * 1024, IN(I_A0) + L * 1024}, tid);
    } break;
    case 9: {
        const float* mu = IN(I_MU) + L * 1920; const float* kkw = IN(I_KK) + L * 512; const float* kaw = IN(I_KA) + L * 512;
        for (int t4 = bid; t4 < 16 * WNC / 4; t4 += gridDim.x) {
            const int q = wid >> 1, half = wid & 1, task = t4 * 4 + q, hd = task / WNC, c = task % WNC;
            const int sub = tid & 3, row0 = ((tid & 63) >> 2) * 4;
            const int pcol = (hd & 7) * 64 + lane; const float mur = mu[pcol], muk = mu[512 + pcol], muv = mu[1024 + pcol], kkwv = kkw[pcol], kawv = kaw[pcol];
            f32x2 s[4][8]; float* sy = sm + 4 * WSC * WVEC;
            UNR for (int r = 0; r < 4; ++r) UNR for (int i = 0; i < 8; ++i) { const int ch = sub * 16 + 2 * i;
                s[r][i] = (f32x2){(half == 1 && row0 + r == ch) ? 1.f : 0.f, (half == 1 && row0 + r == ch + 1) ? 1.f : 0.f}; }
            for (int sc = 0; sc < WCH / WSC; ++sc) {
                __syncthreads();
                wkv_stage_all(sm, ZB, LW, IC, mur, muk, muv, kkwv, kawv, hd >> 3, hd & 7, (t4 * 4) % WNC, sc, wid, lane);
                __syncthreads();
                if (half == 0) wkv_steps<4, true, true>(s, sm + q * WSC * WVEC, sy + q * WSC * 128, 128, WSC, row0, sub);
                else wkv_steps<4, true, false>(s, sm + q * WSC * WVEC, sy + q * WSC * 128 + 64, 128, WSC, row0, sub);
                __syncthreads();
                { const int dir = hd >> 3, head = hd & 7; bf16_t* YD = dir == 0 ? YB : YD1;
                  for (int e = tid; e < 4 * WSC * 128; e += NTHR) { const int qq = e / (WSC * 128), jj = (e >> 7) % WSC, rw = e & 127, tk = tok_of(dir, ((t4 * 4) % WNC + qq) * WCH + sc * WSC + jj);
                      if (rw < 64) YD[(size_t)tk * 512 + head * 64 + rw] = f2bf(sy[e]); else RT[((size_t)dir * TOK + tk) * 512 + head * 64 + (rw - 64)] = f2bf(sy[e]); } }
            }
            UNR for (int r = 0; r < 4; ++r) { float* dst = PQ + ((size_t)hd * WNC + c) * 8192 + half * 4096 + (row0 + r) * 64 + sub * 16;
                UNR for (int i = 0; i < 8; i += 2) *(f32x4*)(dst + 2 * i) = (f32x4){s[r][i][0], s[r][i][1], s[r][i + 1][0], s[r][i + 1][1]}; }
        }
    } break;
    case 10: {
        for (int task = bid; task < 128; task += gridDim.x) { const int hd = task >> 3, rg = task & 7, r = tid >> 6, i = tid & 63, vrow = rg * 8 + r;
            float sv = 0.f; float* Ps = sm + 512;
            const float* P0 = PQ + ((size_t)hd * WNC) * 8192;
            f32x4 pa = *(const f32x4*)(P0 + 4096 + tid * 8), pb = *(const f32x4*)(P0 + 4096 + tid * 8 + 4); float qc = P0[vrow * 64 + i];
            for (int c = 0; c < WNC; ++c) {
                __syncthreads();
                *(f32x4*)(Ps + tid * 8) = pa; *(f32x4*)(Ps + tid * 8 + 4) = pb; sm[r * 64 + i] = sv;
                SCS[((size_t)hd * WNC + c) * 4096 + vrow * 64 + i] = sv;
                float a2 = qc;
                if (c + 1 < WNC) { const float* P1 = PQ + ((size_t)hd * WNC + c + 1) * 8192; pa = *(const f32x4*)(P1 + 4096 + tid * 8); pb = *(const f32x4*)(P1 + 4096 + tid * 8 + 4); qc = P1[vrow * 64 + i]; }
                __syncthreads();
#pragma unroll 16
                for (int a = 0; a < 64; ++a) a2 += sm[r * 64 + a] * Ps[a * 64 + i];
                sv = a2;
            }
            __syncthreads();
        }
    } break;
    case 11: {
        for (int task = bid; task < 16 * WNC; task += gridDim.x) { const int hd = task / WNC, c = task % WNC, dir = hd >> 3, head = hd & 7;
            float sc_[64];
            { const float* src = SCS + ((size_t)hd * WNC + c) * 4096 + lane * 64; UNR for (int i = 0; i < 64; i += 4) { const f32x4 t = *(const f32x4*)(src + i); sc_[i] = t[0]; sc_[i + 1] = t[1]; sc_[i + 2] = t[2]; sc_[i + 3] = t[3]; } }
            __syncthreads();
            for (int e = tid; e < WCH * 8; e += NTHR) { const int t = e >> 3, i8 = (e & 7) * 8; float v8[8];
                ld8bf(RT + ((size_t)dir * TOK + tok_of(dir, c * WCH + t)) * 512 + head * 64 + i8, v8);
                *(f32x4*)(sm + t * 64 + i8) = (f32x4){v8[0], v8[1], v8[2], v8[3]}; *(f32x4*)(sm + t * 64 + i8 + 4) = (f32x4){v8[4], v8[5], v8[6], v8[7]}; }
            __syncthreads();
            bf16_t* YD = dir == 0 ? YB : YD1;
            for (int t0 = wid; t0 < WCH; t0 += 8 * 5) {
                float yl[5]; size_t oo[5];
                UNR for (int u = 0; u < 5; ++u) { const int t = t0 + u * 8; oo[u] = (size_t)tok_of(dir, c * WCH + (t < WCH ? t : 0)) * 512 + head * 64 + lane; yl[u] = bf2f(YD[oo[u]]); }
                UNR for (int u = 0; u < 5; ++u) { const int t = t0 + u * 8; if (t < WCH) {
                    float a0 = yl[u], a1 = 0.f, a2 = 0.f, a3 = 0.f; const float* rt = sm + t * 64;
                    UNR for (int i = 0; i < 64; i += 4) { const f32x4 r4 = *(const f32x4*)(rt + i); a0 = fmaf(sc_[i], r4[0], a0); a1 = fmaf(sc_[i + 1], r4[1], a1); a2 = fmaf(sc_[i + 2], r4[2], a2); a3 = fmaf(sc_[i + 3], r4[3], a3); }
                    YD[oo[u]] = f2bf((a0 + a1) + (a2 + a3)); } }
            }
        }
    } break;
    case 12: {
        const float* mu = IN(I_MU) + L * 1920; const float* kaw = IN(I_KA) + L * 512; const float* rk = IN(I_RK) + L * 512;
        const float* lnw = IN(I_LNW) + L * 512; const float* lnb = IN(I_LNB) + L * 512;
        for (int wt0 = (bid * 8 + wid) * 4; wt0 < TOK * 8; wt0 += gridDim.x * 8 * 4) {
            float yv[4], rz[4][3], kz[4][3], vz[4][3], i0[4], i1[4], gv[4];
            UNR for (int u = 0; u < 4; ++u) { const int wt = wt0 + u, tk = wt >> 3, col = (wt & 7) * 64 + lane; const size_t o = (size_t)tk * 512 + col;
                const int lo = tk < 256 ? 0 : 256, hi = tk < 256 ? 256 : TOK; const bool hp = tk - 1 >= lo, hn = tk + 1 < hi; const bf16_t* z0 = ZB + (size_t)tk * 2048 + col;
                yv[u] = bf2f(YB[o]) + bf2f(YD1[o]); i0[u] = bf2f(IC[o]); i1[u] = bf2f(IC[(size_t)TOK * 512 + o]); gv[u] = bf2f(GG[o]);
                rz[u][1] = bf2f(z0[0]); kz[u][1] = bf2f(z0[512]); vz[u][1] = bf2f(z0[1024]);
                rz[u][0] = hp ? bf2f(z0[-2048]) : 0.f; kz[u][0] = hp ? bf2f(z0[-2048 + 512]) : 0.f; vz[u][0] = hp ? bf2f(z0[-2048 + 1024]) : 0.f;
                rz[u][2] = hn ? bf2f(z0[2048]) : 0.f; kz[u][2] = hn ? bf2f(z0[2048 + 512]) : 0.f; vz[u][2] = hn ? bf2f(z0[2048 + 1024]) : 0.f; }
            UNR for (int u = 0; u < 4; ++u) { const int wt = wt0 + u, tk = wt >> 3, col = (wt & 7) * 64 + lane; const size_t o = (size_t)tk * 512 + col;
                const float y = yv[u];
                const float mean = wave_sum(y, lane) * (1.0f / 64.0f); const float dv = y - mean; const float var = wave_sum(dv * dv, lane) * (1.0f / 64.0f);
                float yn = dv * rsqrtf(var + 64e-5f) * lnw[col] + lnb[col];
                const float r = rz[u][1] + mu[col] * (0.5f * (rz[u][0] + rz[u][2]) - rz[u][1]);
                const float kx = kz[u][1] + mu[512 + col] * (0.5f * (kz[u][0] + kz[u][2]) - kz[u][1]);
                const float v = vz[u][1] + mu[1024 + col] * (0.5f * (vz[u][0] + vz[u][2]) - vz[u][1]);
                const float kd0 = kx * (1.0f + (i0[u] - 1.0f) * kaw[col]), kd1 = kx * (1.0f + (i1[u] - 1.0f) * kaw[col]);
                const float bon = wave_sum(r * (kd0 + kd1) * rk[col], lane);
                yn += bon * v;
                YB[o] = f2bf(yn * gv[u]); } }
        __syncthreads();
        conv_T(IN(I_WIN) + (size_t)L * 1024 * 6528, 6528, (bf16_t*)(ws + W_INZG), 3072, 1024, MapOff{3456}, sm, 0, tid, bid);
        for (int kb = 0; kb < 3; ++kb) conv_T(IN(I_WBR) + ((size_t)L * 3 + kb) * 512 * 1024, 1024, (bf16_t*)(ws + W_BR) + (size_t)kb * 1024 * 512, 1024, 512, MapOff{0}, sm, kb * 64, tid, bid);
        conv_T(IN(I_WOUT) + (size_t)L * 1024 * 1024, 1024, (bf16_t*)(ws + W_OUT), 1024, 1024, MapOff{0}, sm, 192, tid, bid);
        conv_T(IN(I_WFIN) + (size_t)L * 1024 * 5632, 5632, (bf16_t*)(ws + W_FIN), 5632, 1024, MapFfn(), sm, 0, tid, bid);
        conv_T(IN(I_WFOUT) + (size_t)L * 2816 * 1024, 1024, (bf16_t*)(ws + W_FOUT), 1024, 2816, MapOff{0}, sm, 128, tid, bid);
        norm_rows(H, IN(I_NORM1) + L * 1024, modl, modc, 0, 1024, HN, row0, tid, bid, nullptr, 0, nullptr);
    } break;
    case 13: {
        GemmArgs g{HN + (size_t)row0 * 1024, (const bf16_t*)(ws + W_INZG), 1024, 1024, 1024}; StaticOrder S; S.init(Mrows, 3072, bid, 1024);
        gemm_phase(lds, g, S, EpiZg{ZG, row0}, tid);
    } break;
    case 14: {
        GemmArgs g{YS + (size_t)row0 * 512, (const bf16_t*)(ws + W_BR), 512, 512, 512}; TripleOrder S; S.init(Mrows, bid);
        gemm_phase(lds, g, S, EpiMerge1{ZG, MM, row0}, tid);
    } break;
    case 15: {
        GemmArgs g{MM, (const bf16_t*)(ws + W_OUT), 1024, 1024, 1024}; ResOrder S; S.init(last ? 0 : 16, bid, 1024);
        gemm_phase(lds, g, S, EpiRes{H, modl + 2048, modc + 2048, 0, (float*)(ws + X_RT)}, tid);
    } break;
    case 16: {
        norm_rows(H, IN(I_NORM2) + L * 1024, modl, modc, 3072, 4096, HN, row0, tid, bid, last ? nullptr : (const float*)(ws + X_RT), 4, modc + 2048);
    } break;
    case 17: {
        GemmArgs g{HN + (size_t)row0 * 1024, (const bf16_t*)(ws + W_FIN), 1024, 1024, 1024}; StaticOrder S; S.init(Mrows, 5632, bid, 1024);
        gemm_phase(lds, g, S, EpiFfn{ACT, row0}, tid);
    } break;
    case 18: {
        GemmArgs g{ACT, (const bf16_t*)(ws + W_FOUT), 2816, 2816, 2816}; ResOrder S; S.init(last ? 0 : 44, bid, 2816);
        gemm_phase(lds, g, S, EpiRes{H, modl + 5120, modc + 5120, 0, (float*)(ws + X_RT)}, tid);
    } break;
    }
}

#undef wid
#undef lane
#undef gtid
#undef gthreads
#define XB_TMO      128
#define XB_XCNT(j)  (256  + 64 * (j))
#define XB_XSUB(j)  (1280 + 64 * (j))
#define XB_XGEN(j)  (2304 + 64 * (j))
#define XB_TOP      3328
#define XB_TOPGEN   3392
#define XCD_BAR_WORDS 3456
#define XB_SPIN_CAP (1u << 18)
__device__ __forceinline__ unsigned xb_ld(unsigned* p)              { return __hip_atomic_load(p, __ATOMIC_RELAXED, __HIP_MEMORY_SCOPE_AGENT); }
__device__ __forceinline__ unsigned xb_add(unsigned* p, unsigned v) { return __hip_atomic_fetch_add(p, v, __ATOMIC_RELAXED, __HIP_MEMORY_SCOPE_AGENT); }
__device__ __forceinline__ unsigned xb_xcc_id() { return (unsigned)__builtin_amdgcn_s_getreg((3 << 11) | 20) & 0xFu; }
#define XB_SPIN(cond, bar) do { unsigned _sp = 0; while (cond) { __builtin_amdgcn_s_sleep(1); \
    if ((++_sp & 255u) == 0u) { if (xb_ld(&(bar)[XB_TMO])) break; if (_sp > XB_SPIN_CAP) { atomicAdd(&(bar)[XB_TMO], 1u); break; } } } } while (0)
struct XcdBarrier { unsigned* bar; unsigned x; volatile LAS unsigned* st; };
__device__ __forceinline__ XcdBarrier xcd_barrier_post(unsigned* bar, volatile LAS unsigned* st) {
    XcdBarrier b; b.bar = bar; b.x = xb_xcc_id(); b.st = st;
    if (threadIdx.x == 0) (void)xb_add(&bar[XB_XCNT(b.x)], 1u);
    return b;
}
__device__ __forceinline__ void xcd_barrier_complete(unsigned* bar, unsigned x, unsigned& nloc, unsigned& nx) {
    const unsigned G = gridDim.x * gridDim.y * gridDim.z;
    unsigned sum, cnt, mine, sp = 0u;
    for (;;) {
        sum = 0u; cnt = 0u; mine = 0u;
#pragma unroll
        for (unsigned j = 0; j < 16; ++j) { const unsigned c = xb_ld(&bar[XB_XCNT(j)]); sum += c; cnt += (c > 0u) ? 1u : 0u; mine = (j == x) ? c : mine; }
        if (sum == G) break;
        __builtin_amdgcn_s_sleep(1);
        if ((++sp & 255u) == 0u) { if (xb_ld(&bar[XB_TMO])) break; if (sp > XB_SPIN_CAP) { atomicAdd(&bar[XB_TMO], 1u); break; } }
    }
    nloc = mine > 0u ? mine : 1u; nx = cnt > 0u ? cnt : 1u;
}
__device__ __forceinline__ void xcd_barrier(const XcdBarrier& b) {
    asm volatile("s_waitcnt vmcnt(0) lgkmcnt(0)" ::: "memory");
    __syncthreads();
    if (threadIdx.x == 0) {
        unsigned* bar = b.bar;
        __builtin_amdgcn_s_waitcnt(0);
        unsigned nloc = b.st[0], nx = b.st[1];
        if (nloc == 0u) { xcd_barrier_complete(bar, b.x, nloc, nx); b.st[0] = nloc; b.st[1] = nx; }
        const unsigned old = xb_add(&bar[XB_XSUB(b.x)], 1u);
        const unsigned gen = old / nloc;
        if (old + 1u == (gen + 1u) * nloc) {
            __builtin_amdgcn_fence(__ATOMIC_RELEASE, "agent");
            asm volatile("s_waitcnt vmcnt(0)" ::: "memory");
            const unsigned og = xb_add(&bar[XB_TOP], 1u);
            const unsigned tg = og / nx;
            if (og + 1u == (tg + 1u) * nx) xb_add(&bar[XB_TOPGEN], 1u);
            else XB_SPIN(xb_ld(&bar[XB_TOPGEN]) == tg, bar);
            __builtin_amdgcn_fence(__ATOMIC_ACQUIRE, "agent");
            xb_add(&bar[XB_XGEN(b.x)], 1u);
            asm volatile("s_waitcnt vmcnt(0)" ::: "memory");
        } else {
            XB_SPIN(xb_ld(&bar[XB_XGEN(b.x)]) == gen, bar);
            __builtin_amdgcn_fence(__ATOMIC_ACQUIRE, "agent");
            asm volatile("s_waitcnt vmcnt(0)" ::: "memory");
        }
    }
    __syncthreads();
}
__device__ __forceinline__ void grid_bar(unsigned* ctr, unsigned target) {
    asm volatile("s_waitcnt vmcnt(0) lgkmcnt(0)" ::: "memory");
    __syncthreads();
    if (threadIdx.x == 0) {
        __builtin_amdgcn_fence(__ATOMIC_RELEASE, "agent");
        asm volatile("s_waitcnt vmcnt(0)" ::: "memory");
        __hip_atomic_fetch_add(ctr, 1u, __ATOMIC_RELAXED, __HIP_MEMORY_SCOPE_AGENT);
        while (__hip_atomic_load(ctr, __ATOMIC_RELAXED, __HIP_MEMORY_SCOPE_AGENT) < target) __builtin_amdgcn_s_sleep(2);
    }
    if (threadIdx.x < 64) {
        __builtin_amdgcn_fence(__ATOMIC_ACQUIRE, "agent");
        asm volatile("s_waitcnt vmcnt(0)" ::: "memory");
    }
    __syncthreads();
}
#if SINGLE_LAUNCH
__global__ void __launch_bounds__(NTHR, 2) fwd_megakernel(Params p, int ph_lo, int ph_hi) {
    extern __shared__ __attribute__((aligned(16))) unsigned char shm[];
    volatile LAS unsigned* xst = (volatile LAS unsigned*)((LAS unsigned char*)shm + LDS_STAGE);
    if (threadIdx.x < 2) xst[threadIdx.x] = 0u;
    if (blockIdx.x == 0) for (int i = threadIdx.x; i < XCD_BAR_WORDS; i += NTHR) __hip_atomic_store((unsigned*)(p.ws + M_BAR) + i, 0u, __ATOMIC_RELAXED, __HIP_MEMORY_SCOPE_AGENT);
    __syncthreads();
    { cg::grid_group grid = cg::this_grid(); grid.sync(); }
    const int wv = __builtin_amdgcn_readfirstlane(threadIdx.x >> 6);
    const XcdBarrier xb = xcd_barrier_post((unsigned*)(p.ws + M_BAR), xst);
#ifdef USE_CG_SYNC
#define MK_SYNC do { asm volatile("s_waitcnt vmcnt(0) lgkmcnt(0)" ::: "memory"); __syncthreads(); cg::this_grid().sync(); } while (0)
#else
#define MK_SYNC xcd_barrier(xb)
#endif
#ifdef MK_SWITCH
    for (int ph = 0; ph < NPHASE; ++ph) { run_phase<-1>(p, ph, shm, wv); if (ph + 1 < NPHASE) MK_SYNC; }
}
#else
    run_phase<100>(p, 0, shm, wv); MK_SYNC;
#define MK_LAYER(LL) do { const int base = 1 + (LL) * PH_PER_LAYER; \
        run_phase<0>(p, base + 0, shm, wv); MK_SYNC;   run_phase<1>(p, base + 1, shm, wv); MK_SYNC;   run_phase<2>(p, base + 2, shm, wv); MK_SYNC; \
        run_phase<3>(p, base + 3, shm, wv); MK_SYNC;   run_phase<4>(p, base + 4, shm, wv); MK_SYNC;   run_phase<5>(p, base + 5, shm, wv); MK_SYNC; \
        run_phase<6>(p, base + 6, shm, wv); MK_SYNC;   run_phase<7>(p, base + 7, shm, wv); MK_SYNC;   run_phase<8>(p, base + 8, shm, wv); MK_SYNC; \
        run_phase<9>(p, base + 9, shm, wv); MK_SYNC;   run_phase<10>(p, base + 10, shm, wv); MK_SYNC; run_phase<11>(p, base + 11, shm, wv); MK_SYNC; \
        run_phase<12>(p, base + 12, shm, wv); MK_SYNC; run_phase<13>(p, base + 13, shm, wv); MK_SYNC; run_phase<14>(p, base + 14, shm, wv); MK_SYNC; \
        run_phase<15>(p, base + 15, shm, wv); MK_SYNC; run_phase<16>(p, base + 16, shm, wv); MK_SYNC; run_phase<17>(p, base + 17, shm, wv); MK_SYNC; \
        run_phase<18>(p, base + 18, shm, wv); MK_SYNC; } while (0)
    MK_LAYER(0); MK_LAYER(1); MK_LAYER(2); MK_LAYER(3);
    run_phase<101>(p, NPHASE - 1, shm, wv);
}
#endif
#endif
template <int KSEL>
__global__ void __launch_bounds__(NTHR, 2) phase_kernel(Params p, int ph) {
    extern __shared__ __attribute__((aligned(16))) unsigned char shm[];
    run_phase<KSEL>(p, ph, shm, __builtin_amdgcn_readfirstlane(threadIdx.x >> 6));
}
template <int KSEL> static void launch_phase(const Params& p, int ph, int grid, hipStream_t stream) {
    static bool attr = false;
    if (!attr) { (void)hipFuncSetAttribute((const void*)phase_kernel<KSEL>, hipFuncAttributeMaxDynamicSharedMemorySize, LDS_BYTES); attr = true; }
    phase_kernel<KSEL><<<grid, NTHR, LDS_BYTES, stream>>>(p, ph);
}

extern "C" void kernel_launch(void* const* d_in, const int* in_sizes, int n_in, void* d_out, int out_size, void* d_ws, size_t ws_size, hipStream_t stream) {
    static int grid = 0;
    if (grid == 0) {
        if (n_in != 42 || ws_size < WS_END) { fprintf(stderr, "kernel_launch: unexpected n_in %d or ws %zu < %zu\n", n_in, ws_size, (size_t)WS_END); grid = -1; return; }
        int dev = 0, cus = 0;
        (void)hipGetDevice(&dev); (void)hipDeviceGetAttribute(&cus, hipDeviceAttributeMultiprocessorCount, dev);
#if SINGLE_LAUNCH
        if (hipFuncSetAttribute((const void*)fwd_megakernel, hipFuncAttributeMaxDynamicSharedMemorySize, LDS_BYTES) != hipSuccess) { fprintf(stderr, "hipFuncSetAttribute failed\n"); grid = -1; return; }
#endif
        (void)hipGetLastError();
        grid = cus;
    }
    if (grid < 0) return;
    Params p{};
    for (int i = 0; i < 42; ++i) p.in[i] = (const float*)d_in[i];
    p.out = (float*)d_out; p.ws = (unsigned char*)d_ws;
#if SINGLE_LAUNCH
    (void)hipMemsetAsync((unsigned char*)d_ws + M_BAR, 0, 16384, stream);
    int lo = 0, hi = NPHASE;
    void* args[] = {&p, &lo, &hi};
    hipError_t e = hipLaunchCooperativeKernel((const void*)fwd_megakernel, dim3(grid), dim3(NTHR), args, LDS_BYTES, stream);
    if (e != hipSuccess) fprintf(stderr, "cooperative launch failed: %s (grid %d)\n", hipGetErrorString(e), grid);
#else
    for (int ph = 0; ph < NPHASE; ++ph) {
        if (ph == 0) { launch_phase<100>(p, ph, grid, stream); continue; }
        if (ph == NPHASE - 1) { launch_phase<101>(p, ph, grid, stream); continue; }
        switch ((ph - 1) % PH_PER_LAYER) {
        case 0: launch_phase<0>(p, ph, grid, stream); break;   case 1: launch_phase<1>(p, ph, grid, stream); break;
        case 2: launch_phase<2>(p, ph, grid, stream); break;   case 3: launch_phase<3>(p, ph, grid, stream); break;
        case 4: launch_phase<4>(p, ph, grid, stream); break;   case 5: launch_phase<5>(p, ph, grid, stream); break;
        case 6: launch_phase<6>(p, ph, grid, stream); break;   case 7: launch_phase<7>(p, ph, grid, stream); break;
        case 8: launch_phase<8>(p, ph, grid, stream); break;   case 9: launch_phase<9>(p, ph, grid, stream); break;
        case 10: launch_phase<10>(p, ph, grid, stream); break; case 11: launch_phase<11>(p, ph, grid, stream); break;
        case 12: launch_phase<12>(p, ph, grid, stream); break; case 13: launch_phase<13>(p, ph, grid, stream); break;
        case 14: launch_phase<14>(p, ph, grid, stream); break; case 15: launch_phase<15>(p, ph, grid, stream); break;
        case 16: launch_phase<16>(p, ph, grid, stream); break; case 17: launch_phase<17>(p, ph, grid, stream); break;
        case 18: launch_phase<18>(p, ph, grid, stream); break;
        }
    }
#endif
}
```
